# Optimizing an MI355X kernel written in HIP

```python
import math
import jax, jax.numpy as jnp
from jax import lax
import numpy as np

D_MODEL = 1024
BATCH = 4
SEQ = 8192
DEPTH = 2

ATTN_HEADS = 8
HEAD_DIM = 64
ATTN_WIDTH = ATTN_HEADS * HEAD_DIM
LRU_BLOCKS = 8
LRU_BLOCK_W = 64
LRU_WIDTH = LRU_BLOCKS * LRU_BLOCK_W
MIX_WIDTH = ATTN_WIDTH + LRU_WIDTH
IN_COLS = 3 * ATTN_WIDTH + 2 * LRU_WIDTH

DILATED_PAIRS = ((128, 1), (512, 4), (2048, 16))
Q_BLOCK = 128
ROT_DIM = HEAD_DIM // 4
ROPE_THETA = 500000.0
ATTN_SCALE = 1.0 / math.sqrt(HEAD_DIM)
NEG_INF = -1e30

CONV_W = 4
LRU_C = 8.0

D_FF = 3584
N_EXPERTS = 8
TOP_K = 2
N_DENSE = (DEPTH + 1) // 2
N_MOE = DEPTH // 2

RMS_EPS = 1e-6

kernel_name = "hymba_dilated_rglru_moe_trunk"


def rmsnorm(x, g):
    xf = x.astype(jnp.float32)
    var = jnp.mean(xf * xf, axis=-1, keepdims=True)
    return (xf * lax.rsqrt(var + RMS_EPS) * g.astype(jnp.float32)).astype(x.dtype)


def partial_rotary(t, positions):
    half = ROT_DIM // 2
    inv_freq = ROPE_THETA ** (-jnp.arange(half, dtype=jnp.float32) / half)
    ang = positions.astype(jnp.float32)[..., None] * inv_freq
    cos = jnp.cos(ang)[:, :, None, :]
    sin = jnp.sin(ang)[:, :, None, :]
    tf = t.astype(jnp.float32)
    t1 = tf[..., :half]
    t2 = tf[..., half:ROT_DIM]
    out = jnp.concatenate([t1 * cos - t2 * sin, t2 * cos + t1 * sin, tf[..., ROT_DIM:]], axis=-1)
    return out.astype(t.dtype)


def dilated_branch(q, k, v, window, dilation):
    B, S, H, Dh = q.shape
    L = S // dilation
    w_sub = window // dilation
    nb = -(-L // Q_BLOCK)
    Lp = nb * Q_BLOCK

    def to_sub(t):
        t = t.reshape(B, L, dilation, H, Dh).transpose(0, 2, 1, 3, 4)
        return jnp.pad(t, ((0, 0), (0, 0), (0, Lp - L), (0, 0), (0, 0)))

    qs, ks, vs = to_sub(q), to_sub(k), to_sub(v)
    blk = (B, dilation, nb, Q_BLOCK, H, Dh)
    qb = qs.reshape(blk)

    def band_keys(t):
        prev = jnp.pad(t, ((0, 0), (0, 0), (Q_BLOCK, 0), (0, 0), (0, 0)))[:, :, :Lp]
        return jnp.concatenate([prev.reshape(blk), t.reshape(blk)], axis=3)

    kb, vb = band_keys(ks), band_keys(vs)

    s = jnp.einsum('bgnqhd,bgnkhd->bgnhqk', qb, kb) * ATTN_SCALE
    qi = jnp.arange(Q_BLOCK)[:, None]
    kj = jnp.arange(2 * Q_BLOCK)[None, :]
    delta = Q_BLOCK + qi - kj
    band = (delta >= 0) & (delta <= w_sub)
    blk_id = jnp.arange(nb)[:, None, None]
    valid = band[None] & ((blk_id > 0) | (kj[None] >= Q_BLOCK))
    s = jnp.where(valid[None, None, :, None], s, NEG_INF)

    m = jnp.max(s, axis=-1, keepdims=True)
    p = jnp.exp(s - m)
    den = jnp.sum(p, axis=-1)
    o = jnp.einsum('bgnhqk,bgnkhd->bgnqhd', p, vb)
    o = o / jnp.swapaxes(den, -1, -2)[..., None]
    lse = jnp.swapaxes(m[..., 0] + jnp.log(den), -1, -2)

    o = o.reshape(B, dilation, Lp, H, Dh)[:, :, :L].transpose(0, 2, 1, 3, 4).reshape(B, S, H, Dh)
    lse = lse.reshape(B, dilation, Lp, H)[:, :, :L].transpose(0, 2, 1, 3).reshape(B, S, H)
    return o, lse


def dilated_mixture_attention(q, k, v):
    qf, kf, vf = q.astype(jnp.float32), k.astype(jnp.float32), v.astype(jnp.float32)
    outs, lses = [], []
    for window, dilation in DILATED_PAIRS:
        o, lse = dilated_branch(qf, kf, vf, window, dilation)
        outs.append(o)
        lses.append(lse)
    w = jax.nn.softmax(jnp.stack(lses, axis=0), axis=0)
    o = jnp.sum(w[..., None] * jnp.stack(outs, axis=0), axis=0)
    return o.astype(q.dtype)


def causal_dwconv(u, w, b):
    S = u.shape[1]
    up = jnp.pad(u, ((0, 0), (CONV_W - 1, 0), (0, 0)))
    y = b
    for tap in range(CONV_W):
        y = y + up[:, tap:tap + S] * w[tap]
    return y


def rg_lru(u, w_r, b_r, w_i, b_i, lam):
    B, S, _ = u.shape
    uf = u.astype(jnp.float32)
    ub = uf.reshape(B, S, LRU_BLOCKS, LRU_BLOCK_W)
    r = jax.nn.sigmoid(jnp.einsum('bsgi,gij->bsgj', ub, w_r.astype(jnp.float32)).reshape(B, S, -1)
                       + b_r.astype(jnp.float32))
    i = jax.nn.sigmoid(jnp.einsum('bsgi,gij->bsgj', ub, w_i.astype(jnp.float32)).reshape(B, S, -1)
                       + b_i.astype(jnp.float32))
    log_a = -LRU_C * r * jax.nn.softplus(-lam.astype(jnp.float32))
    a = jnp.exp(log_a)
    mult = jnp.sqrt(-jnp.expm1(2.0 * log_a))
    bterm = mult * i * uf

    def combine(left, right):
        a1, b1 = left
        a2, b2 = right
        return a1 * a2, a2 * b1 + b2

    _, h = lax.associative_scan(combine, (a, bterm), axis=1)
    return h.astype(u.dtype)


def swiglu(t, wg, wu, wd):
    return (jax.nn.silu(t @ wg) * (t @ wu)) @ wd


def moe_ffn(h, router_w, wg, wu, wd):
    B, S, D = h.shape
    t = h.reshape(-1, D)
    logits = t.astype(jnp.float32) @ router_w.astype(jnp.float32)
    vals, idx = lax.top_k(logits, TOP_K)
    probs = jax.nn.softmax(vals, axis=-1)
    gates = jnp.sum(jax.nn.one_hot(idx, N_EXPERTS, dtype=jnp.float32) * probs[..., None], axis=1)
    y = jnp.zeros(t.shape, jnp.float32)
    for e in range(N_EXPERTS):
        y = y + gates[:, e:e + 1] * swiglu(t, wg[e], wu[e], wd[e]).astype(jnp.float32)
    return y.astype(h.dtype).reshape(B, S, D)


def setup_inputs(seed: int = 0) -> dict:
    key = jax.random.key(seed)
    ks = jax.random.split(key, 26)
    f32 = jnp.float32

    def nrm(k, shape, fan_in):
        return jax.random.normal(k, shape, f32) * (fan_in ** -0.5)

    def gain(k, shape):
        return 1.0 + 0.02 * jax.random.normal(k, shape, f32)

    x = jax.random.normal(ks[0], (BATCH, SEQ, D_MODEL), f32)
    offset = jax.random.randint(ks[1], (BATCH, 1), 0, 4096, dtype=jnp.int32)
    positions = (offset + jnp.arange(SEQ, dtype=jnp.int32)[None, :]).astype(jnp.int32)

    u = jax.random.uniform(ks[2], (DEPTH, LRU_WIDTH), f32, 0.9, 0.999)
    a0 = u ** (1.0 / LRU_C)
    lru_lambda = jnp.log(a0) - jnp.log1p(-a0)

    return {
        "x": x,
        "positions": positions,
        "pre_mix_g": gain(ks[3], (DEPTH, D_MODEL)),
        "w_in": nrm(ks[4], (DEPTH, D_MODEL, IN_COLS), D_MODEL),
        "conv_w": nrm(ks[5], (DEPTH, CONV_W, LRU_WIDTH), CONV_W),
        "conv_b": 0.02 * jax.random.normal(ks[6], (DEPTH, LRU_WIDTH), f32),
        "w_rgate": nrm(ks[7], (DEPTH, LRU_BLOCKS, LRU_BLOCK_W, LRU_BLOCK_W), LRU_BLOCK_W),
        "b_rgate": 0.02 * jax.random.normal(ks[8], (DEPTH, LRU_WIDTH), f32),
        "w_igate": nrm(ks[9], (DEPTH, LRU_BLOCKS, LRU_BLOCK_W, LRU_BLOCK_W), LRU_BLOCK_W),
        "b_igate": 0.02 * jax.random.normal(ks[10], (DEPTH, LRU_WIDTH), f32),
        "lru_lambda": lru_lambda,
        "attn_out_g": gain(ks[11], (DEPTH, ATTN_WIDTH)),
        "lru_out_g": gain(ks[12], (DEPTH, LRU_WIDTH)),
        "w_out": nrm(ks[13], (DEPTH, MIX_WIDTH, D_MODEL), MIX_WIDTH),
        "post_mix_g": gain(ks[14], (DEPTH, D_MODEL)),
        "pre_ffn_g": gain(ks[15], (DEPTH, D_MODEL)),
        "post_ffn_g": gain(ks[16], (DEPTH, D_MODEL)),
        "dense_w_gate": nrm(ks[17], (N_DENSE, D_MODEL, D_FF), D_MODEL),
        "dense_w_up": nrm(ks[18], (N_DENSE, D_MODEL, D_FF), D_MODEL),
        "dense_w_down": nrm(ks[19], (N_DENSE, D_FF, D_MODEL), D_FF),
        "router_w": nrm(ks[20], (N_MOE, D_MODEL, N_EXPERTS), D_MODEL),
        "moe_w_gate": nrm(ks[21], (N_MOE, N_EXPERTS, D_MODEL, D_FF), D_MODEL),
        "moe_w_up": nrm(ks[22], (N_MOE, N_EXPERTS, D_MODEL, D_FF), D_MODEL),
        "moe_w_down": nrm(ks[23], (N_MOE, N_EXPERTS, D_FF, D_MODEL), D_FF),
    }


def reference(x, positions, pre_mix_g, w_in, conv_w, conv_b, w_rgate, b_rgate, w_igate, b_igate,
              lru_lambda, attn_out_g, lru_out_g, w_out, post_mix_g, pre_ffn_g, post_ffn_g,
              dense_w_gate, dense_w_up, dense_w_down, router_w, moe_w_gate, moe_w_up, moe_w_down):
    B, S, _ = x.shape
    c1 = ATTN_WIDTH
    c2 = 2 * ATTN_WIDTH
    c3 = 3 * ATTN_WIDTH
    c4 = 3 * ATTN_WIDTH + LRU_WIDTH
    for l in range(DEPTH):
        h = rmsnorm(x, pre_mix_g[l])
        z = h @ w_in[l]
        q = z[..., :c1].reshape(B, S, ATTN_HEADS, HEAD_DIM)
        k = z[..., c1:c2].reshape(B, S, ATTN_HEADS, HEAD_DIM)
        v = z[..., c2:c3].reshape(B, S, ATTN_HEADS, HEAD_DIM)
        u = z[..., c3:c4]
        g = z[..., c4:]

        q = partial_rotary(q, positions)
        k = partial_rotary(k, positions)
        attn = dilated_mixture_attention(q, k, v).reshape(B, S, ATTN_WIDTH)

        uc = causal_dwconv(u, conv_w[l], conv_b[l])
        rec = rg_lru(uc, w_rgate[l], b_rgate[l], w_igate[l], b_igate[l], lru_lambda[l])
        rec = jax.nn.gelu(g) * rec

        mixed = jnp.concatenate([rmsnorm(attn, attn_out_g[l]), rmsnorm(rec, lru_out_g[l])], axis=-1)
        x = x + rmsnorm(mixed @ w_out[l], post_mix_g[l])

        h = rmsnorm(x, pre_ffn_g[l])
        if l % 2 == 0:
            j = l // 2
            f = swiglu(h, dense_w_gate[j], dense_w_up[j], dense_w_down[j])
        else:
            j = l // 2
            f = moe_ffn(h, router_w[j], moe_w_gate[j], moe_w_up[j], moe_w_down[j])
        x = x + rmsnorm(f, post_ffn_g[l])
    return x
```

```cpp
#include <hip/hip_runtime.h>
#include <cstdio>
#include <cstdint>
#include <cmath>
namespace pg8 {
#define PG8_LAS __attribute__((address_space(3)))
typedef unsigned short bf16_t;
typedef short bf16x8 __attribute__((ext_vector_type(8)));
typedef float f32x4 __attribute__((ext_vector_type(4)));
typedef unsigned u32x4 __attribute__((ext_vector_type(4)));
typedef unsigned u32x2 __attribute__((ext_vector_type(2)));
typedef int v4i_t __attribute__((ext_vector_type(4)));
typedef int v8i_t __attribute__((ext_vector_type(8)));
constexpr int BM = 256, BK = 64, HALF = 128, HTB = HALF * BK * 2  , STAGE_BYTES = 8 * HTB, NXCD = 8, WGM = 8;

__host__ __device__ __forceinline__ int lds_byte(int r, int c) { const int st = (r >> 4) * 2 + (c >> 5), rr = r & 15, cc = c & 31, ob = rr * 64 + cc * 2; return st * 1024 + (ob ^ (((ob >> 9) & 1) << 5)); }
__host__ __device__ __forceinline__ void stage_rc(int b, int& R, int& C) { const int st = b / 1024, sb = b % 1024, swz = sb ^ (((sb >> 9) & 1) << 5); R = (st >> 1) * 16 + swz / 64; C = (st & 1) * 32 + (swz % 64) / 2; }
__host__ __device__ __forceinline__ int perm32(int rho) { const int n = rho >> 4, i = rho & 15; return 8 * (i >> 2) + 4 * n + (i & 3); }

struct Unit { int pm, pn, pl, e, gb; };
struct Gemm { const bf16_t* A; const bf16_t* Bt; int M, N, K; size_t bstride  ; const int* rowtok  ; };

__device__ __forceinline__ void tile_of(int wgid, int nM, int nN, int& pm, int& pn) {
    const int nwg = nM * nN;
    { const int q = nwg / NXCD, r = nwg % NXCD, xcd = wgid % NXCD, off = wgid / NXCD; wgid = (xcd < r ? xcd * (q + 1) : r * (q + 1) + (xcd - r) * q) + off; }
    const int nig = WGM * nN, gid = wgid / nig, fm = gid * WGM, gsz = (nM - fm) < WGM ? (nM - fm) : WGM;
    pm = fm + ((wgid % nig) % gsz); pn = (wgid % nig) / gsz;
}
struct StaticOrder {
    int nM, nN, nwg, G, c;
    __device__ void init(int M, int N, int G_, int c_) { nM = M / BM; nN = N / BM; nwg = nM * nN; G = G_; c = c_; }
    __device__ __forceinline__ bool next(int i, Unit& u) const {
        const long L = (long)i * G + c; if (L >= nwg) return false;
        int pm, pn; tile_of((int)L, nM, nN, pm, pn); u.pm = pm; u.pn = pn; u.pl = pm; u.e = 0; u.gb = pm * BM; return true;
    }
};
struct MoeOrder {
    int p0, np, nN, nwg, G, c, seg; int ps1, ps2, ps3, ps4, ps5, ps6, ps7;
    __device__ __forceinline__ bool next(int i, Unit& u) const {
        const long L = (long)i * G + c; if (L >= nwg) return false;
        int pm, pn; tile_of((int)L, np, nN, pm, pn); u.pl = pm; u.pn = pn; pm += p0; u.pm = pm;
        const int e = (pm >= ps1) + (pm >= ps2) + (pm >= ps3) + (pm >= ps4) + (pm >= ps5) + (pm >= ps6) + (pm >= ps7);
        int pse = 0; pse = (pm >= ps1) ? ps1 : pse; pse = (pm >= ps2) ? ps2 : pse; pse = (pm >= ps3) ? ps3 : pse; pse = (pm >= ps4) ? ps4 : pse; pse = (pm >= ps5) ? ps5 : pse; pse = (pm >= ps6) ? ps6 : pse; pse = (pm >= ps7) ? ps7 : pse;
        u.e = e; u.gb = e * seg + (pm - pse) * BM; return true;
    }
};

__device__ __forceinline__ unsigned cvt_pk_bf16(float lo, float hi) { unsigned r; asm volatile("v_cvt_pk_bf16_f32 %0, %1, %2" : "=v"(r) : "v"(lo), "v"(hi)); return r; }

constexpr int SIDE_OFF = STAGE_BYTES, SIDE_BYTES = 17 * 1024;
__device__ __forceinline__ void side_dma(const void* gsrc_lane, PG8_LAS unsigned char* ldst_wave) {
    __builtin_amdgcn_global_load_lds((const unsigned*)gsrc_lane, (PG8_LAS unsigned*)ldst_wave, 16, 0, 0);
}
struct EpiBf16 {
    static constexpr bool PERM = true;
    bf16_t* O; int ldc; float oscale = 1.f;
    __device__ __forceinline__ void stage_side(PG8_LAS unsigned char*, const Unit&, int, int) const {}
    __device__ __forceinline__ void operator()(const f32x4 (&acc)[2][2][4][2], const Unit& u, int wr, int wc, int fr, int fq, const PG8_LAS unsigned char* side) const {
        const int row0 = u.pm * BM + wr * 64 + fr, col0 = u.pn * BM + wc * 32 + 8 * fq;
#pragma unroll
        for (int ai = 0; ai < 2; ++ai)
#pragma unroll
            for (int m = 0; m < 4; ++m) { bf16_t* rowp = O + (size_t)(row0 + ai * HALF + m * 16) * ldc + col0;
#pragma unroll
                for (int bj = 0; bj < 2; ++bj) { const f32x4 v0 = acc[ai][bj][m][0] * oscale, v1 = acc[ai][bj][m][1] * oscale;
                    u32x4 w; w.x = cvt_pk_bf16(v0[0], v0[1]); w.y = cvt_pk_bf16(v0[2], v0[3]); w.z = cvt_pk_bf16(v1[0], v1[1]); w.w = cvt_pk_bf16(v1[2], v1[3]);
                    *(u32x4*)(rowp + bj * HALF) = w; } }
    }
};
struct EpiZ {
    static constexpr bool PERM = true;
    bf16_t* Z; size_t tstride; const float* cosT; const float* sinT; float qscale; const float* rstd;
    __device__ __forceinline__ void stage_side(PG8_LAS unsigned char* side, const Unit& u, int wid, int lane) const {
        if (wid == 0) side_dma(rstd + (size_t)u.pm * BM + 4 * lane, side);
        if (u.pn < 4) { const size_t r0 = ((size_t)u.pm * BM + 32 * wid) * 8 + 4 * lane;
            side_dma(cosT + r0, side + 1024 + wid * 1024); side_dma(sinT + r0, side + 9216 + wid * 1024); }
    }
    __device__ __forceinline__ void operator()(const f32x4 (&acc)[2][2][4][2], const Unit& u, int wr, int wc, int fr, int fq, const PG8_LAS unsigned char* side) const {
        const int t = u.pn >> 1; bf16_t* base = Z + (size_t)t * tstride;
        const int row0 = u.pm * BM + wr * 64 + fr, col0 = (u.pn & 1) * 256 + wc * 32 + 8 * fq;
        const bool rotw = (t < 2) && ((wc & 1) == 0);
        const float sc = (t == 0) ? qscale : 1.f;
#pragma unroll
        for (int ai = 0; ai < 2; ++ai)
#pragma unroll
            for (int m = 0; m < 4; ++m) { const int row = row0 + ai * HALF + m * 16, rl = wr * 64 + fr + ai * HALF + m * 16; const float rs = ((const PG8_LAS float*)side)[rl] * sc;
                f32x4 v[2][2];
#pragma unroll
                for (int bj = 0; bj < 2; ++bj)
#pragma unroll
                    for (int n = 0; n < 2; ++n) v[bj][n] = acc[ai][bj][m][n] * rs;
                if (rotw) {
                    f32x4 c4[2], s4[2];
#pragma unroll
                    for (int n = 0; n < 2; ++n) { c4[n] = *(const PG8_LAS f32x4*)(side + 1024 + rl * 32 + 16 * n); s4[n] = *(const PG8_LAS f32x4*)(side + 9216 + rl * 32 + 16 * n); }
                    const float sg = (fq == 0) ? -1.f : 1.f;
#pragma unroll
                    for (int bj = 0; bj < 2; ++bj)
#pragma unroll
                        for (int n = 0; n < 2; ++n)
#pragma unroll
                            for (int e = 0; e < 4; ++e) { const float mine = v[bj][n][e]; const float other = __shfl_xor(mine, 16);
                                const float r = mine * c4[n][e] + sg * other * s4[n][e]; v[bj][n][e] = (fq < 2) ? r : mine; }
                }
                bf16_t* rowp = base + (size_t)row * 512 + col0;
#pragma unroll
                for (int bj = 0; bj < 2; ++bj) { const f32x4 v0 = v[bj][0], v1 = v[bj][1];
                    u32x4 w; w.x = cvt_pk_bf16(v0[0], v0[1]); w.y = cvt_pk_bf16(v0[2], v0[3]); w.z = cvt_pk_bf16(v1[0], v1[1]); w.w = cvt_pk_bf16(v1[2], v1[3]);
                    *(u32x4*)(rowp + bj * HALF) = w; } }
    }
};
__device__ __forceinline__ float silu_f(float x) { return x * __builtin_amdgcn_rcpf(1.f + __builtin_amdgcn_exp2f(-1.4426950408889634f * x)); }
struct EpiSwiglu {
    static constexpr bool PERM = true;
    bf16_t* O; int ldc; const float* rstd;
    __device__ __forceinline__ void stage_side(PG8_LAS unsigned char* side, const Unit& u, int wid, int lane) const { if (wid == 0) side_dma(rstd + (size_t)u.pl * BM + 4 * lane, side); }
    __device__ __forceinline__ void operator()(const f32x4 (&acc)[2][2][4][2], const Unit& u, int wr, int wc, int fr, int fq, const PG8_LAS unsigned char* side) const {
        const int row0 = u.pl * BM + wr * 64 + fr, col0 = u.pn * HALF + wc * 32 + 8 * fq;
#pragma unroll
        for (int ai = 0; ai < 2; ++ai)
#pragma unroll
            for (int m = 0; m < 4; ++m) { bf16_t* rowp = O + (size_t)(row0 + ai * HALF + m * 16) * ldc + col0; const float rs = ((const PG8_LAS float*)side)[wr * 64 + fr + ai * HALF + m * 16];
                f32x4 v[2];
                const float kg = -1.4426950408889634f * rs, ir2 = __builtin_amdgcn_rcpf(rs * rs);
#pragma unroll
                for (int n = 0; n < 2; ++n) { const f32x4 g = acc[ai][0][m][n], up = acc[ai][1][m][n];
#pragma unroll
                    for (int e = 0; e < 4; ++e) v[n][e] = (g[e] * up[e]) * __builtin_amdgcn_rcpf(__builtin_fmaf(__builtin_amdgcn_exp2f(kg * g[e]), ir2, ir2)); }
                u32x4 w; w.x = cvt_pk_bf16(v[0][0], v[0][1]); w.y = cvt_pk_bf16(v[0][2], v[0][3]); w.z = cvt_pk_bf16(v[1][0], v[1][1]); w.w = cvt_pk_bf16(v[1][2], v[1][3]);
                *(u32x4*)rowp = w; }
    }
};

__device__ __forceinline__ float clamp448(float v) { return __builtin_amdgcn_fmed3f(v, -448.f, 448.f); }
__device__ __forceinline__ unsigned pk4_fp8(float a, float b, float c, float d) { int w = 0; w = __builtin_amdgcn_cvt_pk_fp8_f32(a, b, w, false); w = __builtin_amdgcn_cvt_pk_fp8_f32(c, d, w, true); return (unsigned)w; }
struct EpiSwiglu8 {
    static constexpr bool PERM = true;
    unsigned char* O; int ldc; const float* rstd; float ascale;
    __device__ __forceinline__ void stage_side(PG8_LAS unsigned char* side, const Unit& u, int wid, int lane) const { if (wid == 0) side_dma(rstd + (size_t)u.pl * BM + 4 * lane, side); }
    __device__ __forceinline__ void operator()(const f32x4 (&acc)[2][2][4][2], const Unit& u, int wr, int wc, int fr, int fq, const PG8_LAS unsigned char* side) const {
        const int row0 = u.pl * BM + wr * 64 + fr, col0 = u.pn * HALF + wc * 32 + 8 * fq;
        const float ia = 1.f / ascale;
#pragma unroll
        for (int ai = 0; ai < 2; ++ai)
#pragma unroll
            for (int m = 0; m < 4; ++m) { unsigned char* rowp = O + (size_t)(row0 + ai * HALF + m * 16) * ldc + col0; const float rs = ((const PG8_LAS float*)side)[wr * 64 + fr + ai * HALF + m * 16];
                f32x4 v[2];
                const float kg = -1.4426950408889634f * rs, ir2 = __builtin_amdgcn_rcpf(rs * rs) * ia;
#pragma unroll
                for (int n = 0; n < 2; ++n) { const f32x4 g = acc[ai][0][m][n], up = acc[ai][1][m][n];
                    const f32x4 t = g * kg; const f32x4 ex = (f32x4){__builtin_amdgcn_exp2f(t[0]), __builtin_amdgcn_exp2f(t[1]), __builtin_amdgcn_exp2f(t[2]), __builtin_amdgcn_exp2f(t[3])};
                    const f32x4 dn = ex * ir2 + ir2; const f32x4 rc = (f32x4){__builtin_amdgcn_rcpf(dn[0]), __builtin_amdgcn_rcpf(dn[1]), __builtin_amdgcn_rcpf(dn[2]), __builtin_amdgcn_rcpf(dn[3])};
                    v[n] = (g * up) * rc; }
                u32x2 w; w.x = pk4_fp8(v[0][0], v[0][1], v[0][2], v[0][3]); w.y = pk4_fp8(v[1][0], v[1][1], v[1][2], v[1][3]);
                *(u32x2*)rowp = w; }
    }
};
struct EpiSwigluF8 {
    static constexpr bool PERM = true;
    unsigned char* O; int ldc; float wscale, ascale;
    __device__ __forceinline__ void stage_side(PG8_LAS unsigned char*, const Unit&, int, int) const {}
    __device__ __forceinline__ void operator()(const f32x4 (&acc)[2][2][4][2], const Unit& u, int wr, int wc, int fr, int fq, const PG8_LAS unsigned char* side) const {
        const int row0 = u.pl * BM + wr * 64 + fr, col0 = u.pn * HALF + wc * 32 + 8 * fq;
        const float ic = 1.f / (wscale * wscale * ascale);
#pragma unroll
        for (int ai = 0; ai < 2; ++ai)
#pragma unroll
            for (int m = 0; m < 4; ++m) { unsigned char* rowp = O + (size_t)(row0 + ai * HALF + m * 16) * ldc + col0;
                f32x4 v[2];
#pragma unroll
                for (int n = 0; n < 2; ++n) { const f32x4 g = acc[ai][0][m][n], up = acc[ai][1][m][n];
                    const f32x4 t = g * (-1.4426950408889634f * wscale); const f32x4 ex = (f32x4){__builtin_amdgcn_exp2f(t[0]), __builtin_amdgcn_exp2f(t[1]), __builtin_amdgcn_exp2f(t[2]), __builtin_amdgcn_exp2f(t[3])};
                    const f32x4 dn = ex * ic + ic; const f32x4 rc = (f32x4){__builtin_amdgcn_rcpf(dn[0]), __builtin_amdgcn_rcpf(dn[1]), __builtin_amdgcn_rcpf(dn[2]), __builtin_amdgcn_rcpf(dn[3])};
                    v[n] = (g * up) * rc; }
                u32x2 w; w.x = pk4_fp8(v[0][0], v[0][1], v[0][2], v[0][3]); w.y = pk4_fp8(v[1][0], v[1][1], v[1][2], v[1][3]);
                *(u32x2*)rowp = w; }
    }
};
struct EpiMoeDown {
    static constexpr bool PERM = true;
    bf16_t* F; size_t kstride; const int* rowtok; const float* rowgate; float oscale;
    __device__ __forceinline__ void stage_side(PG8_LAS unsigned char* side, const Unit& u, int wid, int lane) const {
        if (wid == 0) side_dma(rowtok + (size_t)u.gb + 4 * lane, side);
        if (wid == 1) side_dma(rowgate + (size_t)u.gb + 4 * lane, side + 1024);
    }
    __device__ __forceinline__ void operator()(const f32x4 (&acc)[2][2][4][2], const Unit& u, int wr, int wc, int fr, int fq, const PG8_LAS unsigned char* side) const {
        const int col0 = u.pn * BM + wc * 32 + 8 * fq;
#pragma unroll
        for (int ai = 0; ai < 2; ++ai)
#pragma unroll
            for (int m = 0; m < 4; ++m) { const int sl = wr * 64 + fr + ai * HALF + m * 16; const int tk = ((const PG8_LAS int*)side)[sl]; const float gt = ((const PG8_LAS float*)(side + 1024))[sl] * oscale;
                if (tk >= 0) { bf16_t* rowp = F + (size_t)(tk & 1) * kstride + (size_t)(tk >> 1) * 1024 + col0;
#pragma unroll
                    for (int bj = 0; bj < 2; ++bj) { const f32x4 v0 = acc[ai][bj][m][0] * gt, v1 = acc[ai][bj][m][1] * gt;
                        u32x4 w; w.x = cvt_pk_bf16(v0[0], v0[1]); w.y = cvt_pk_bf16(v0[2], v0[3]); w.z = cvt_pk_bf16(v1[0], v1[1]); w.w = cvt_pk_bf16(v1[2], v1[3]);
                        *(u32x4*)(rowp + bj * HALF) = w; } } }
    }
};

template <class Epi, class Sched, bool GATHER, bool FP8 = false, bool PEEL = false>
__device__ __forceinline__ void gemm_phase(PG8_LAS unsigned char* lds, const Gemm g, const Sched& S, const Epi& E) {
    int tid = threadIdx.x; asm volatile("" : "+v"(tid));
    const int wid = __builtin_amdgcn_readfirstlane(tid >> 6), lane = tid & 63, wr = wid >> 2, wc = wid & 3, fr = lane & 15, fq = lane >> 4;
    const int K = g.K, nt = K / BK;
    unsigned voffB[2]; unsigned vc[2][2], vn[2][2]; int RA[2], CA[2];
#pragma unroll
    for (int i = 0; i < 2; ++i) { int R, C; stage_rc(tid * 16 + i * 8192, R, C); const int Rb = Epi::PERM ? ((R & ~31) + perm32(R & 31)) : R;
        RA[i] = R; CA[i] = C; voffB[i] = (unsigned)(Rb * K + C) * 2u;
        vc[0][i] = vc[1][i] = vn[0][i] = vn[1][i] = (unsigned)(R * K + C) * 2u; }
    const size_t kstep = (size_t)(BK * 2);
    const size_t hstep = (size_t)HALF * K * 2;
    const size_t hstepA = GATHER ? 0 : hstep;
    const size_t tstep = 2 * hstep;
    const unsigned ldsw = (unsigned)wid * 1024u;
    const int aoff = lds_byte(wr * 64 + fr, fq * 8), boff = lds_byte(wc * 32 + fr, fq * 8);
#define PG8_SA(b, h) (((b) * 2 + (h)) * HTB)
#define PG8_SB(b, h) ((4 + (b) * 2 + (h)) * HTB)
#define PG8_STAGE(bufoff, gbase, voff) do { _Pragma("unroll") for (int _i = 0; _i < 2; ++_i) { unsigned _o = (voff)[_i]; asm volatile("" : "+v"(_o));     \
        __builtin_amdgcn_global_load_lds((const unsigned*)((const char*)(gbase) + _o), (PG8_LAS unsigned*)(lds + (bufoff) + ldsw + _i * 8192), 16, 0, 0); } } while (0)
#define PG8_STAGE_A(b, h, P, VO) PG8_STAGE(PG8_SA(b, h), (P) + (h) * hstepA, (VO)[h])
#define PG8_LDA(dst, b, h) do { _Pragma("unroll") for (int m = 0; m < 4; ++m) { dst[m].lo = *(const PG8_LAS v4i_t*)(lds + PG8_SA(b, h) + aoff + m * 2048); dst[m].hi = *(const PG8_LAS v4i_t*)(lds + PG8_SA(b, h) + aoff + m * 2048 + 1024); } } while (0)
#define PG8_LDB(dst, b, h) do { _Pragma("unroll") for (int n = 0; n < 2; ++n) { dst[n].lo = *(const PG8_LAS v4i_t*)(lds + PG8_SB(b, h) + boff + n * 2048); dst[n].hi = *(const PG8_LAS v4i_t*)(lds + PG8_SB(b, h) + boff + n * 2048 + 1024); } } while (0)
#define PG8_MMA(ai, bj, At, Bt) do { __builtin_amdgcn_s_setprio(1); _Pragma("unroll") for (int m = 0; m < 4; ++m) _Pragma("unroll") for (int n = 0; n < 2; ++n) { \
        if constexpr (FP8) asm volatile("v_mfma_scale_f32_16x16x128_f8f6f4 %0, %1, %2, %0, %3, %3 op_sel_hi:[0,0,0]" : "+v"(acc[ai][bj][m][n]) : "v"(Bt[n]), "v"(At[m]), "v"(f8one));     \
        else { const v4i_t blo_ = Bt[n].lo, bhi_ = Bt[n].hi, alo_ = At[m].lo, ahi_ = At[m].hi;     \
               acc[ai][bj][m][n] = __builtin_amdgcn_mfma_f32_16x16x32_bf16(__builtin_bit_cast(bf16x8, blo_), __builtin_bit_cast(bf16x8, alo_), acc[ai][bj][m][n], 0, 0, 0); \
               acc[ai][bj][m][n] = __builtin_amdgcn_mfma_f32_16x16x32_bf16(__builtin_bit_cast(bf16x8, bhi_), __builtin_bit_cast(bf16x8, ahi_), acc[ai][bj][m][n], 0, 0, 0); } } \
        __builtin_amdgcn_s_setprio(0); } while (0)
#define PG8_MMA0(ai, bj, At, Bt) do { __builtin_amdgcn_s_setprio(1); \
        if constexpr (FP8) { _Pragma("unroll") for (int m = 0; m < 4; ++m) _Pragma("unroll") for (int n = 0; n < 2; ++n) \
            asm volatile("v_mfma_scale_f32_16x16x128_f8f6f4 %0, %1, %2, 0, %3, %3 op_sel_hi:[0,0,0]" : "=&v"(acc[ai][bj][m][n]) : "v"(Bt[n]), "v"(At[m]), "v"(f8one)); } \
        else { _Pragma("unroll") for (int m = 0; m < 4; ++m) _Pragma("unroll") for (int n = 0; n < 2; ++n) { const v4i_t blo_ = Bt[n].lo, alo_ = At[m].lo; \
                   asm volatile("v_mfma_f32_16x16x32_bf16 %0, %1, %2, 0" : "=&v"(acc[ai][bj][m][n]) : "v"(blo_), "v"(alo_)); }     \
               _Pragma("unroll") for (int m = 0; m < 4; ++m) _Pragma("unroll") for (int n = 0; n < 2; ++n) { const v4i_t bhi_ = Bt[n].hi, ahi_ = At[m].hi; \
                   acc[ai][bj][m][n] = __builtin_amdgcn_mfma_f32_16x16x32_bf16(__builtin_bit_cast(bf16x8, bhi_), __builtin_bit_cast(bf16x8, ahi_), acc[ai][bj][m][n], 0, 0, 0); } } \
        __builtin_amdgcn_s_setprio(0); } while (0)
#define PG8_WAIT_V(n) asm volatile("s_waitcnt vmcnt(" #n ")" ::: "memory")
#define PG8_WAIT_L(n) asm volatile("s_waitcnt lgkmcnt(" #n ")" ::: "memory")
#define PG8_BAR __builtin_amdgcn_s_barrier()
#define PG8_SCHED __builtin_amdgcn_sched_barrier(0)
#define PG8_GATHER_OFFS(dst, U) do { _Pragma("unroll") for (int _h = 0; _h < 2; ++_h) _Pragma("unroll") for (int _i = 0; _i < 2; ++_i) { \
        int _tk = g.rowtok[(U).gb + _h * HALF + RA[_i]]; _tk = _tk < 0 ? 0 : (_tk >> 1); dst[_h][_i] = (unsigned)(_tk * K + CA[_i]) * 2u; } } while (0)
    Unit cur, nxt; int ui = 0;
    if (!S.next(0, cur)) return;
    f32x4 acc[2][2][4][2];
    if constexpr (!PEEL) {
#pragma unroll
    for (int a = 0; a < 2; ++a)
#pragma unroll
        for (int b = 0; b < 2; ++b)
#pragma unroll
            for (int m = 0; m < 4; ++m)
#pragma unroll
                for (int n = 0; n < 2; ++n) acc[a][b][m][n] = (f32x4){0.f, 0.f, 0.f, 0.f};
    }
    const int f8one = 0x7F7F7F7F;
    v8i_t At[4], B0[2], B1[2];
    if constexpr (GATHER) PG8_GATHER_OFFS(vc, cur);
    const char* cA = (const char*)g.A + (GATHER ? (size_t)0 : (size_t)cur.pl * tstep); const char* cB = (const char*)g.Bt + (size_t)cur.e * g.bstride + (size_t)cur.pn * tstep;
    PG8_STAGE(PG8_SB(0, 0), cB, voffB); PG8_STAGE(PG8_SB(0, 1), cB + hstep, voffB); PG8_STAGE_A(0, 0, cA, vc); PG8_STAGE_A(0, 1, cA, vc);
    if (wr == 1) PG8_BAR;
    PG8_WAIT_V(2); PG8_BAR;
    PG8_STAGE(PG8_SB(1, 0), cB + kstep, voffB); PG8_STAGE_A(1, 0, cA + kstep, vc); PG8_STAGE(PG8_SB(1, 1), cB + hstep + kstep, voffB);
    PG8_WAIT_V(6); PG8_BAR;
#pragma nounroll
    for (;;) {
        const bool has_next = S.next(ui + 1, nxt);
        const char* nA = has_next ? (const char*)g.A + (GATHER ? (size_t)0 : (size_t)nxt.pl * tstep) : cA;
        const char* nB = has_next ? (const char*)g.Bt + (size_t)nxt.e * g.bstride + (size_t)nxt.pn * tstep : cB;
        if constexpr (GATHER) { if (has_next) PG8_GATHER_OFFS(vn, nxt); else { _Pragma("unroll") for (int _h = 0; _h < 2; ++_h) _Pragma("unroll") for (int _i = 0; _i < 2; ++_i) vn[_h][_i] = vc[_h][_i]; } }
        if constexpr (PEEL) {
            const int t = 0;
            const bool last = (t == nt - 2);
            const char* a1 = cA + (size_t)(t + 1) * kstep;
            const char* a2 = last ? nA : cA + (size_t)(t + 2) * kstep; const char* b2 = last ? nB : cB + (size_t)(t + 2) * kstep;
            const char* a3 = a2 + kstep; const char* b3 = b2 + kstep;
            unsigned v2[2][2];
#pragma unroll
            for (int _h = 0; _h < 2; ++_h)
#pragma unroll
                for (int _i = 0; _i < 2; ++_i) v2[_h][_i] = (GATHER && last) ? vn[_h][_i] : vc[_h][_i];
            if (t == 2) E.stage_side(lds + SIDE_OFF, cur, wid, lane);
            PG8_LDB(B0, 0, 0); PG8_LDB(B1, 0, 1); PG8_SCHED; PG8_LDA(At, 0, 0); PG8_STAGE_A(1, 1, a1, vc);
            PG8_WAIT_V(8); PG8_WAIT_L(0); PG8_BAR; PG8_MMA0(0, 0, At, B0); PG8_MMA0(0, 1, At, B1); PG8_BAR; PG8_SCHED;
            PG8_LDA(At, 0, 1); PG8_STAGE(PG8_SB(0, 0), b2, voffB); PG8_STAGE(PG8_SB(0, 1), b2 + hstep, voffB); PG8_STAGE_A(0, 0, a2, v2);
            PG8_WAIT_V(8); PG8_WAIT_L(0); PG8_BAR; PG8_MMA0(1, 0, At, B0); PG8_MMA0(1, 1, At, B1); PG8_BAR; PG8_SCHED;
            PG8_LDB(B0, 1, 0); PG8_LDB(B1, 1, 1); PG8_SCHED; PG8_LDA(At, 1, 0); PG8_STAGE_A(0, 1, a2, v2);
            PG8_WAIT_V(8); PG8_WAIT_L(0); PG8_BAR; PG8_MMA(0, 0, At, B0); PG8_MMA(0, 1, At, B1); PG8_BAR; PG8_SCHED;
            PG8_LDA(At, 1, 1); PG8_STAGE(PG8_SB(1, 0), b3, voffB); PG8_STAGE(PG8_SB(1, 1), b3 + hstep, voffB); PG8_STAGE_A(1, 0, a3, v2);
            PG8_WAIT_V(8); PG8_WAIT_L(0); PG8_BAR; PG8_MMA(1, 0, At, B0); PG8_MMA(1, 1, At, B1); PG8_BAR; PG8_SCHED;
        }
#pragma nounroll
        for (int t = PEEL ? 2 : 0; t < nt; t += 2) {
            const bool last = (t == nt - 2);
            const char* a1 = cA + (size_t)(t + 1) * kstep;
            const char* a2 = last ? nA : cA + (size_t)(t + 2) * kstep; const char* b2 = last ? nB : cB + (size_t)(t + 2) * kstep;
            const char* a3 = a2 + kstep; const char* b3 = b2 + kstep;
            unsigned v2[2][2];
#pragma unroll
            for (int _h = 0; _h < 2; ++_h)
#pragma unroll
                for (int _i = 0; _i < 2; ++_i) v2[_h][_i] = (GATHER && last) ? vn[_h][_i] : vc[_h][_i];
            if (t == 2) E.stage_side(lds + SIDE_OFF, cur, wid, lane);
            PG8_LDB(B0, 0, 0); PG8_LDB(B1, 0, 1); PG8_SCHED; PG8_LDA(At, 0, 0); PG8_STAGE_A(1, 1, a1, vc);
            PG8_WAIT_V(8); PG8_WAIT_L(0); PG8_BAR; PG8_MMA(0, 0, At, B0); PG8_MMA(0, 1, At, B1); PG8_BAR; PG8_SCHED;
            PG8_LDA(At, 0, 1); PG8_STAGE(PG8_SB(0, 0), b2, voffB); PG8_STAGE(PG8_SB(0, 1), b2 + hstep, voffB); PG8_STAGE_A(0, 0, a2, v2);
            PG8_WAIT_V(8); PG8_WAIT_L(0); PG8_BAR; PG8_MMA(1, 0, At, B0); PG8_MMA(1, 1, At, B1); PG8_BAR; PG8_SCHED;
            PG8_LDB(B0, 1, 0); PG8_LDB(B1, 1, 1); PG8_SCHED; PG8_LDA(At, 1, 0); PG8_STAGE_A(0, 1, a2, v2);
            PG8_WAIT_V(8); PG8_WAIT_L(0); PG8_BAR; PG8_MMA(0, 0, At, B0); PG8_MMA(0, 1, At, B1); PG8_BAR; PG8_SCHED;
            PG8_LDA(At, 1, 1); PG8_STAGE(PG8_SB(1, 0), b3, voffB); PG8_STAGE(PG8_SB(1, 1), b3 + hstep, voffB); PG8_STAGE_A(1, 0, a3, v2);
            PG8_WAIT_V(8); PG8_WAIT_L(0); PG8_BAR; PG8_MMA(1, 0, At, B0); PG8_MMA(1, 1, At, B1); PG8_BAR; PG8_SCHED;
        }
        if constexpr (FP8) asm volatile("s_nop 15\n\ts_nop 15" ::: "memory");
        if (wr == 0) PG8_BAR;
        E(acc, cur, wr, wc, fr, fq, lds + SIDE_OFF);
        if (!has_next) break;
        if constexpr (!PEEL) {
#pragma unroll
        for (int a = 0; a < 2; ++a)
#pragma unroll
            for (int b = 0; b < 2; ++b)
#pragma unroll
                for (int m = 0; m < 4; ++m)
#pragma unroll
                    for (int n = 0; n < 2; ++n) acc[a][b][m][n] = (f32x4){0.f, 0.f, 0.f, 0.f};
        }
        cur = nxt; cA = nA; cB = nB; ++ui;
        if constexpr (GATHER) { _Pragma("unroll") for (int _h = 0; _h < 2; ++_h) _Pragma("unroll") for (int _i = 0; _i < 2; ++_i) vc[_h][_i] = vn[_h][_i]; }
        if (wr == 1) PG8_BAR;
    }
    PG8_WAIT_V(0);
    PG8_BAR;
#undef PG8_SA
#undef PG8_SB
#undef PG8_STAGE
#undef PG8_STAGE_A
#undef PG8_LDA
#undef PG8_LDB
#undef PG8_MMA
#undef PG8_MMA0
#undef PG8_WAIT_V
#undef PG8_WAIT_L
#undef PG8_BAR
#undef PG8_SCHED
#undef PG8_GATHER_OFFS
}
}
constexpr int NWAVES = 8;
constexpr int BATCH = 4, SEQ = 8192, D = 1024, T = BATCH * SEQ;
constexpr int AW = 512, NH = 8, HD = 64, LW = 512, INC = 2560, FF = 3584, NE = 8;
constexpr float RMS_EPS = 1e-6f;
constexpr float QSCALE = 0.125f * 1.4426950408889634f;
constexpr int MAXPAN = 264;
constexpr int CHPAN = 146;
constexpr float MOE_WGU_SCALE = 32.f, MOE_WD_SCALE = 64.f, MOE_ACT_SCALE = 16.f;

constexpr size_t MiB = 1u << 20;
constexpr size_t WS_CTL = 0, CTL_ZERO_BYTES = 1 * MiB;
constexpr size_t WS_SUM = 1 * MiB;
constexpr size_t WS_TOKE = 3 * MiB, WS_TOKP = WS_TOKE + 256 * 1024, WS_TOKR = WS_TOKP + 256 * 1024;
constexpr size_t WS_RSTDA = 513 * MiB, WS_RSTDF = WS_RSTDA + 128 * 1024;
constexpr size_t WS_CCV = 3 * MiB;
constexpr size_t WS_ROWTOK = 514 * MiB, WS_ROWGATE = 515 * MiB;
constexpr size_t WS_WFR = 4 * MiB + 640 * 1024;
constexpr size_t WS_ROPE = 5 * MiB;
constexpr size_t WS_LSE = 7 * MiB;
constexpr size_t WS_WIN = 10 * MiB, WS_WOUT = 20 * MiB, WS_WGU = 24 * MiB, WS_WD = 38 * MiB;
constexpr size_t WS_RA = 45 * MiB;
constexpr size_t WS_RB = 109 * MiB;
constexpr size_t WS_RC = 269 * MiB;
constexpr size_t WS_MOEW = 365 * MiB;
constexpr size_t WS_XB = 449 * MiB;
constexpr size_t WS_END = 533 * MiB;
constexpr size_t WS_ACTM = WS_RB, WS_FSLOT = WS_RB + 128 * MiB;
static_assert((size_t)CHPAN * 256 * FF <= 128 * MiB && WS_FSLOT + 128 * MiB <= WS_MOEW && WS_RB + 224 * MiB <= WS_MOEW && WS_RC + 96 * MiB <= WS_MOEW && WS_MOEW + 84 * MiB <= WS_XB && WS_XB + 64 * MiB <= WS_END, "ws map");
constexpr int CW_BAR = 4096;
constexpr int CW_LRU = 20480;
constexpr int CW_CNT = 16384;

constexpr int LDS_BYTES = 159744;
constexpr int LDSCTL_OFF = 158720;

#define GAS __attribute__((address_space(1)))
#define LAS __attribute__((address_space(3)))
typedef unsigned short bf16;
typedef unsigned v4u __attribute__((ext_vector_type(4)));
typedef unsigned v2u __attribute__((ext_vector_type(2)));
typedef float f32x4 __attribute__((ext_vector_type(4)));
typedef float f32x2 __attribute__((ext_vector_type(2)));
typedef float f32x16 __attribute__((ext_vector_type(16)));
typedef short bf16x8 __attribute__((ext_vector_type(8)));
typedef short v4i16_t __attribute__((ext_vector_type(4)));
typedef GAS unsigned gu32;
#define RLX_AGENT __ATOMIC_RELAXED, __HIP_MEMORY_SCOPE_AGENT
#define LDS_WAIT() asm volatile("s_waitcnt lgkmcnt(0)" ::: "memory")
#define VM_WAIT() asm volatile("s_waitcnt vmcnt(0)" ::: "memory")
__device__ __forceinline__ unsigned f2bf(float f) { unsigned u = __builtin_bit_cast(unsigned, f); return (u + 0x7fffu + ((u >> 16) & 1u)) >> 16; }
__device__ __forceinline__ unsigned pk2(float lo, float hi) { typedef float f2_t __attribute__((ext_vector_type(2))); typedef __bf16 b2_t __attribute__((ext_vector_type(2))); const f2_t v = {lo, hi}; return __builtin_bit_cast(unsigned, __builtin_convertvector(v, b2_t)); }
__device__ __forceinline__ float bf_lo(unsigned w) { return __builtin_bit_cast(float, w << 16); }
__device__ __forceinline__ float bf_hi(unsigned w) { return __builtin_bit_cast(float, w & 0xffff0000u); }

#define XB_TMO      128
#define XB_XCNT(j)  (256  + 64 * (j))
#define XB_XSUB(j)  (1280 + 64 * (j))
#define XB_XGEN(j)  (2304 + 64 * (j))
#define XB_TOP      3328
#define XB_TOPGEN   3392
#define XCD_BAR_WORDS 3456
#define XB_SPIN_CAP (1u << 18)

__device__ __forceinline__ unsigned xb_ld(unsigned* p)              { return __hip_atomic_load(p, __ATOMIC_RELAXED, __HIP_MEMORY_SCOPE_AGENT); }
__device__ __forceinline__ unsigned xb_add(unsigned* p, unsigned v) { return __hip_atomic_fetch_add(p, v, __ATOMIC_RELAXED, __HIP_MEMORY_SCOPE_AGENT); }
__device__ __forceinline__ unsigned xb_xcc_id() { return (unsigned)__builtin_amdgcn_s_getreg((3 << 11) | 20) & 0xFu; }
#define XB_SPIN(cond, bar) do { unsigned _sp = 0; while (cond) { __builtin_amdgcn_s_sleep(1); \
    if ((++_sp & 255u) == 0u) { if (xb_ld(&(bar)[XB_TMO])) break; if (_sp > XB_SPIN_CAP) { atomicAdd(&(bar)[XB_TMO], 1u); break; } } } } while (0)

struct XcdBarrier {
    unsigned* bar; unsigned x;
    volatile LAS unsigned* st;
};
__device__ __forceinline__ XcdBarrier xcd_barrier_post(unsigned* bar, volatile LAS unsigned* st) {
    XcdBarrier b; b.bar = bar; b.x = xb_xcc_id(); b.st = st;
    if (threadIdx.x == 0) (void)xb_add(&bar[XB_XCNT(b.x)], 1u);
    return b;
}
__device__ __forceinline__ void xcd_barrier_complete(unsigned* bar, unsigned x, unsigned& nloc, unsigned& nx) {
    const unsigned G = gridDim.x * gridDim.y * gridDim.z;
    unsigned sum, cnt, mine, sp = 0u;
    for (;;) {
        sum = 0u; cnt = 0u; mine = 0u;
#pragma unroll
        for (unsigned j = 0; j < 16; ++j) { const unsigned c = xb_ld(&bar[XB_XCNT(j)]); sum += c; cnt += (c > 0u) ? 1u : 0u; mine = (j == x) ? c : mine; }
        if (sum == G) break;
        __builtin_amdgcn_s_sleep(1);
        if ((++sp & 255u) == 0u) { if (xb_ld(&bar[XB_TMO])) break; if (sp > XB_SPIN_CAP) { atomicAdd(&bar[XB_TMO], 1u); break; } }
    }
    nloc = mine > 0u ? mine : 1u; nx = cnt > 0u ? cnt : 1u;
}
__device__ __forceinline__ void xcd_barrier(const XcdBarrier& b) {
    asm volatile("s_waitcnt vmcnt(0)" ::: "memory");
    __syncthreads();
    if (threadIdx.x == 0) {
        unsigned* bar = b.bar; { const unsigned long long u_ = (unsigned long long)bar; bar = (unsigned*)(((unsigned long long)(unsigned)__builtin_amdgcn_readfirstlane((int)(u_ >> 32)) << 32) | (unsigned)__builtin_amdgcn_readfirstlane((int)u_)); } asm volatile("" : "+s"(bar));
        __builtin_amdgcn_s_waitcnt(0);
        unsigned nloc = b.st[0], nx = b.st[1];
        unsigned bx_ = b.x; asm volatile("" : "+s"(bx_));
        if (nloc == 0u) { xcd_barrier_complete(bar, bx_, nloc, nx); b.st[0] = nloc; b.st[1] = nx; }
        const unsigned old = xb_add(&bar[XB_XSUB(bx_)], 1u);
        const unsigned gen = old / nloc;
        if (old + 1u == (gen + 1u) * nloc) {
            __builtin_amdgcn_fence(__ATOMIC_RELEASE, "agent");
            asm volatile("s_waitcnt vmcnt(0)" ::: "memory");
            const unsigned og = xb_add(&bar[XB_TOP], 1u);
            const unsigned tg = og / nx;
            if (og + 1u == (tg + 1u) * nx) xb_add(&bar[XB_TOPGEN], 1u);
            else XB_SPIN(xb_ld(&bar[XB_TOPGEN]) == tg, bar);
            __builtin_amdgcn_fence(__ATOMIC_ACQUIRE, "agent");
            xb_add(&bar[XB_XGEN(bx_)], 1u);
            asm volatile("s_waitcnt vmcnt(0)" ::: "memory");
        } else {
            XB_SPIN(xb_ld(&bar[XB_XGEN(bx_)]) == gen, bar);
            __builtin_amdgcn_fence(__ATOMIC_ACQUIRE, "agent");
            asm volatile("s_waitcnt vmcnt(0)" ::: "memory");
        }
    }
    __syncthreads();
}

struct Args {
    const float* x; const int* pos; const float* pre_mix_g; const float* w_in; const float* conv_w; const float* conv_b;
    const float* w_rgate; const float* b_rgate; const float* w_igate; const float* b_igate; const float* lam;
    const float* attn_out_g; const float* lru_out_g; const float* w_out; const float* post_mix_g; const float* pre_ffn_g; const float* post_ffn_g;
    const float* dw_gate; const float* dw_up; const float* dw_down; const float* router_w; const float* mw_gate; const float* mw_up; const float* mw_down;
    float* out; unsigned char* ws;
};
struct Frame {
    LAS unsigned char* lds;
    int vcu, G;
};
#define DPP_ADD(v, ctrl) ((v) + __builtin_bit_cast(float, __builtin_amdgcn_update_dpp(0, __builtin_bit_cast(int, (v)), (ctrl), 0xF, 0xF, true)))
__device__ __forceinline__ float wave_sum(float v) {
    v = DPP_ADD(v, 0xB1);
    v = DPP_ADD(v, 0x4E);
    v = DPP_ADD(v, 0x141);
    v = DPP_ADD(v, 0x140);
    const int b = __builtin_bit_cast(int, v);
    const float r0 = __builtin_bit_cast(float, __builtin_amdgcn_readlane(b, 0)), r1 = __builtin_bit_cast(float, __builtin_amdgcn_readlane(b, 16));
    const float r2 = __builtin_bit_cast(float, __builtin_amdgcn_readlane(b, 32)), r3 = __builtin_bit_cast(float, __builtin_amdgcn_readlane(b, 48));
    return (r0 + r1) + (r2 + r3);
}
__device__ __forceinline__ void p0_transpose_item(const float* W, int K, int N, bf16* WT, int k0, int n0, int drow0, LAS float* scr, int lane) {
    float ld_[32];
#pragma unroll
    for (int i = 0; i < 32; ++i) { const int kk = 2 * i + (lane >> 5); ld_[i] = W[(size_t)(k0 + kk) * N + n0 + (lane & 31)]; }
#pragma unroll
    for (int i = 0; i < 32; ++i) { const int kk = 2 * i + (lane >> 5); scr[kk * 33 + (lane & 31)] = ld_[i]; }
    LDS_WAIT(); asm volatile("" ::: "memory");
    const int c = lane & 7;
#pragma unroll
    for (int j = 0; j < 4; ++j) { const int n = (lane >> 3) + 8 * j; const LAS float* s = scr + (8 * c) * 33 + n;
        v4u o; o.x = pk2(s[0 * 33], s[1 * 33]); o.y = pk2(s[2 * 33], s[3 * 33]); o.z = pk2(s[4 * 33], s[5 * 33]); o.w = pk2(s[6 * 33], s[7 * 33]);
        *(GAS v4u*)(WT + (size_t)(drow0 + n) * K + k0 + 8 * c) = o; }
    LDS_WAIT(); asm volatile("" ::: "memory");
}
__device__ __forceinline__ unsigned pk4f8(float a, float b, float c, float d) { int w = 0; w = __builtin_amdgcn_cvt_pk_fp8_f32(a, b, w, false); w = __builtin_amdgcn_cvt_pk_fp8_f32(c, d, w, true); return (unsigned)w; }
__device__ __forceinline__ void p0_transpose_item_f8(const float* W, int K, int N, unsigned char* WT, int k0, int n0, int drow0, float scale, LAS float* scr, int lane) {
    float ld_[64];
#pragma unroll
    for (int i = 0; i < 64; ++i) { const int kk = 2 * i + (lane >> 5); ld_[i] = W[(size_t)(k0 + kk) * N + n0 + (lane & 31)]; }
#pragma unroll
    for (int i = 0; i < 64; ++i) { const int kk = 2 * i + (lane >> 5); scr[kk * 33 + (lane & 31)] = ld_[i]; }
    LDS_WAIT(); asm volatile("" ::: "memory");
    const int c = lane & 7;
#pragma unroll
    for (int j = 0; j < 4; ++j) { const int n = (lane >> 3) + 8 * j; const LAS float* s = scr + (16 * c) * 33 + n;
        v4u o; o.x = pk4f8(s[0 * 33] * scale, s[1 * 33] * scale, s[2 * 33] * scale, s[3 * 33] * scale); o.y = pk4f8(s[4 * 33] * scale, s[5 * 33] * scale, s[6 * 33] * scale, s[7 * 33] * scale);
        o.z = pk4f8(s[8 * 33] * scale, s[9 * 33] * scale, s[10 * 33] * scale, s[11 * 33] * scale); o.w = pk4f8(s[12 * 33] * scale, s[13 * 33] * scale, s[14 * 33] * scale, s[15 * 33] * scale);
        *(GAS v4u*)(WT + (size_t)(drow0 + n) * K + k0 + 16 * c) = o; }
    LDS_WAIT(); asm volatile("" ::: "memory");
}
__device__ __forceinline__ void tr_plain_f8(const float* W, int K, int N, unsigned char* WT, int item, float scale, LAS float* scr, int lane) {
    const int nblk = N / 32, kb = item / nblk, nb = item % nblk; p0_transpose_item_f8(W, K, N, WT, 128 * kb, 32 * nb, 32 * nb, scale, scr, lane);
}
__device__ __forceinline__ void tr_gu_f8(const float* W, unsigned char* WT, int isup, int item, float scale, LAS float* scr, int lane) {
    const int nblk = FF / 32, kb = item / nblk, nb = item % nblk, n0 = 32 * nb; p0_transpose_item_f8(W, D, FF, WT, 128 * kb, n0, 256 * (n0 >> 7) + 128 * isup + (n0 & 127), scale, scr, lane);
}
__device__ __forceinline__ void tr_plain(const float* W, int K, int N, bf16* WT, int item, LAS float* scr, int lane) {
    const int nblk = N / 32, kb = item / nblk, nb = item % nblk; p0_transpose_item(W, K, N, WT, 64 * kb, 32 * nb, 32 * nb, scr, lane);
}
__device__ __forceinline__ void tr_gu(const float* W, bf16* WT, int isup, int item, LAS float* scr, int lane) {
    const int nblk = FF / 32, kb = item / nblk, nb = item % nblk, n0 = 32 * nb; p0_transpose_item(W, D, FF, WT, 64 * kb, n0, 256 * (n0 >> 7) + 128 * isup + (n0 & 127), scr, lane);
}
template <bool F8>
__device__ __forceinline__ void coop_item(const float* W, int K, int N, void* WT, int k0, int n0, int GU, float scale, LAS unsigned char* lds, int wave, int lane, const float* gk = nullptr) {
    LAS float* tl = (LAS float*)lds;
    float ld_[64];
#pragma unroll
    for (int r = 0; r < 16; ++r) { const float gr = gk ? gk[k0 + 16 * wave + r] : 1.f;
#pragma unroll
        for (int j = 0; j < 4; ++j) ld_[4 * r + j] = W[(size_t)(k0 + 16 * wave + r) * N + n0 + lane + 64 * j] * gr; }
#pragma unroll
    for (int r = 0; r < 16; ++r)
#pragma unroll
        for (int j = 0; j < 4; ++j) tl[(16 * wave + r) * 257 + lane + 64 * j] = ld_[4 * r + j];
    __syncthreads();
    if (F8) {
        const int c = lane & 7;
#pragma unroll
        for (int it = 0; it < 4; ++it) { const int nl = 32 * wave + 8 * it + (lane >> 3), n = n0 + nl; const LAS float* s = tl + (16 * c) * 257 + nl;
            const int drow = (GU < 0) ? n : 256 * (n >> 7) + 128 * GU + (n & 127);
            v4u o; o.x = pk4f8(s[0 * 257] * scale, s[1 * 257] * scale, s[2 * 257] * scale, s[3 * 257] * scale); o.y = pk4f8(s[4 * 257] * scale, s[5 * 257] * scale, s[6 * 257] * scale, s[7 * 257] * scale);
            o.z = pk4f8(s[8 * 257] * scale, s[9 * 257] * scale, s[10 * 257] * scale, s[11 * 257] * scale); o.w = pk4f8(s[12 * 257] * scale, s[13 * 257] * scale, s[14 * 257] * scale, s[15 * 257] * scale);
            *(GAS v4u*)((unsigned char*)WT + (size_t)drow * K + k0 + 16 * c) = o; }
    } else {
        const int c = lane & 15;
#pragma unroll
        for (int it = 0; it < 8; ++it) { const int nl = 32 * wave + 4 * it + (lane >> 4), n = n0 + nl; const LAS float* s = tl + (8 * c) * 257 + nl;
            const int drow = (GU < 0) ? n : 256 * (n >> 7) + 128 * GU + (n & 127);
            v4u o; o.x = pk2(s[0 * 257], s[1 * 257]); o.y = pk2(s[2 * 257], s[3 * 257]); o.z = pk2(s[4 * 257], s[5 * 257]); o.w = pk2(s[6 * 257], s[7 * 257]);
            *(GAS v4u*)((bf16*)WT + (size_t)drow * K + k0 + 8 * c) = o; }
    }
    __syncthreads();
}
constexpr int WGAIN_OFF = 135168;
struct WItem { const float* W; unsigned char* WT; int K, N, k0, n0, GU, f8, gko; float scale; };
struct WRegs { float v[64]; };
__device__ __forceinline__ void w_load(const WItem& q, WRegs& r, int wave, int lane) {
    const GAS float* src = (const GAS float*)q.W + (size_t)(q.k0 + 16 * wave) * q.N + q.n0 + lane;
#pragma unroll
    for (int i = 0; i < 16; ++i)
#pragma unroll
        for (int j = 0; j < 4; ++j) r.v[4 * i + j] = src[(size_t)i * q.N + 64 * j];
}
__device__ __forceinline__ void w_finish(const WItem& q, WRegs& r, LAS unsigned char* lds, int wave, int lane) {
    LAS float* tl = (LAS float*)lds;
    if (q.gko >= 0) {
        const LAS float* gl = (const LAS float*)(lds + WGAIN_OFF) + q.gko + q.k0 + 16 * wave;
#pragma unroll
        for (int i = 0; i < 16; ++i) { const float gi = gl[i];
#pragma unroll
            for (int j = 0; j < 4; ++j) tl[(16 * wave + i) * 257 + lane + 64 * j] = r.v[4 * i + j] * gi; }
    } else {
#pragma unroll
        for (int i = 0; i < 16; ++i)
#pragma unroll
            for (int j = 0; j < 4; ++j) tl[(16 * wave + i) * 257 + lane + 64 * j] = r.v[4 * i + j];
    }
    LDS_WAIT(); __builtin_amdgcn_s_barrier();
    const int K = q.K, GU = q.GU;
    if (q.f8) {
        const float scale = q.scale;
#pragma unroll
        for (int it = 0; it < 4; ++it) { const int c = (lane >> 4) + 4 * (it & 1), nl = 32 * wave + 16 * (it >> 1) + (lane & 15), n = q.n0 + nl; const LAS float* s = tl + (16 * c) * 257 + nl;
            const int drow = (GU < 0) ? n : 256 * (n >> 7) + 128 * GU + (n & 127);
            v4u o; o.x = pk4f8(s[0 * 257] * scale, s[1 * 257] * scale, s[2 * 257] * scale, s[3 * 257] * scale); o.y = pk4f8(s[4 * 257] * scale, s[5 * 257] * scale, s[6 * 257] * scale, s[7 * 257] * scale);
            o.z = pk4f8(s[8 * 257] * scale, s[9 * 257] * scale, s[10 * 257] * scale, s[11 * 257] * scale); o.w = pk4f8(s[12 * 257] * scale, s[13 * 257] * scale, s[14 * 257] * scale, s[15 * 257] * scale);
            *(GAS v4u*)(q.WT + (size_t)drow * K + q.k0 + 16 * c) = o; }
    } else {
#pragma unroll
        for (int it = 0; it < 8; ++it) { const int c = (lane >> 3) + 8 * (it & 1), nl = 32 * wave + 8 * (it >> 1) + (lane & 7), n = q.n0 + nl; const LAS float* s = tl + (8 * c) * 257 + nl;
            const int drow = (GU < 0) ? n : 256 * (n >> 7) + 128 * GU + (n & 127);
            v4u o; o.x = pk2(s[0 * 257], s[1 * 257]); o.y = pk2(s[2 * 257], s[3 * 257]); o.z = pk2(s[4 * 257], s[5 * 257]); o.w = pk2(s[6 * 257], s[7 * 257]);
            *(GAS v4u*)((bf16*)q.WT + (size_t)drow * K + q.k0 + 8 * c) = o; }
    }
    LDS_WAIT(); __builtin_amdgcn_s_barrier();
}
__device__ __forceinline__ void rms_store_bf16(const f32x4 (&v)[4], const float* g, bf16* orow, int lane) {
    float s = 0.f;
#pragma unroll
    for (int j = 0; j < 4; ++j) s += (v[j].x * v[j].x + v[j].y * v[j].y) + (v[j].z * v[j].z + v[j].w * v[j].w);
    const float rstd = __builtin_amdgcn_rsqf(wave_sum(s) * (1.f / D) + RMS_EPS);
    GAS unsigned long long* o8 = (GAS unsigned long long*)orow + lane;
#pragma unroll
    for (int j = 0; j < 4; ++j) { const f32x4 gg = *((const GAS f32x4*)g + lane + 64 * j);
        o8[64 * j] = (unsigned long long)pk2(v[j].x * rstd * gg.x, v[j].y * rstd * gg.y) | ((unsigned long long)pk2(v[j].z * rstd * gg.z, v[j].w * rstd * gg.w) << 32); }
}
template <class S, class L, class P>
__device__ __forceinline__ void row_pipe(int r0, int step, int end, L load, P proc) {
    if (r0 >= end) return;
    const int last = r0 + ((end - 1 - r0) / step) * step;
#define RP_CL(x) ((x) < last ? (x) : last)
    S s0, s1, s2, s3;
    load(r0, s0); load(RP_CL(r0 + step), s1); load(RP_CL(r0 + 2 * step), s2);
    for (int r = r0; ; r += 4 * step) {
        load(RP_CL(r + 3 * step), s3);
        proc(r, s0);
        if (r + step > last) break;
        load(RP_CL(r + 4 * step), s0);
        proc(r + step, s1);
        if (r + 2 * step > last) break;
        load(RP_CL(r + 5 * step), s1);
        proc(r + 2 * step, s2);
        if (r + 3 * step > last) break;
        load(RP_CL(r + 6 * step), s2);
        proc(r + 3 * step, s3);
        if (r + 4 * step > last) break;
    }
#undef RP_CL
}
struct Gain4 { f32x4 g[4]; };
__device__ __forceinline__ Gain4 ld_gain(const float* g, int lane) { Gain4 r;
#pragma unroll
    for (int j = 0; j < 4; ++j) r.g[j] = *((const GAS f32x4*)g + lane + 64 * j);
    return r; }
struct RawRow { v2u a[4]; };
__device__ __forceinline__ void ld_raw(const bf16* row, RawRow& r, int lane) {
    const GAS v2u* r8 = (const GAS v2u*)row + lane;
#pragma unroll
    for (int j = 0; j < 4; ++j) r.a[j] = r8[64 * j];
}
__device__ __forceinline__ void unpack_raw(const RawRow& r, f32x4 (&v)[4]) {
#pragma unroll
    for (int j = 0; j < 4; ++j) v[j] = (f32x4){bf_lo(r.a[j].x), bf_hi(r.a[j].x), bf_lo(r.a[j].y), bf_hi(r.a[j].y)};
}
__device__ __forceinline__ void load_bf16_row(const bf16* row, f32x4 (&v)[4], int lane) {
    const GAS v2u* r8 = (const GAS v2u*)row + lane;
#pragma unroll
    for (int j = 0; j < 4; ++j) { const v2u w = r8[64 * j]; v[j] = (f32x4){bf_lo(w.x), bf_hi(w.x), bf_lo(w.y), bf_hi(w.y)}; }
}
namespace att {
constexpr int KSLOT = 16384, VRING = 4 * KSLOT, RING = 8 * KSLOT;
static_assert(RING <= LDSCTL_OFF, "attention LDS");
__device__ __forceinline__ int crow(int r, int hi) { return (r & 3) + 8 * (r >> 2) + 4 * hi; }
typedef float f32x4_t __attribute__((ext_vector_type(4)));
__device__ __forceinline__ float max3f(float a, float b, float c) { float r; asm("v_max3_f32 %0, %1, %2, %3" : "=v"(r) : "v"(a), "v"(b), "v"(c)); return r; }
__device__ __forceinline__ void glds16(const void* gsrc, unsigned lds_dst) { unsigned keep; lds_dst = (unsigned)__builtin_amdgcn_readfirstlane((int)lds_dst);

    asm volatile("s_mov_b32 %0, m0\n\ts_mov_b32 m0, %2\n\ts_nop 0\n\tglobal_load_lds_dwordx4 %1, off\n\ts_mov_b32 m0, %0" : "=&s"(keep) : "v"(gsrc), "s"(lds_dst) : "memory"); }
__device__ __forceinline__ void dma_block(const bf16* K, const bf16* V, size_t rowbase  , int dsh, int h, LAS unsigned char* lds, int blk, int wid, int lane) {
    const unsigned sb = (unsigned)__builtin_amdgcn_readfirstlane((int)(unsigned)(uintptr_t)lds) + (unsigned)(blk & 3) * KSLOT;
#pragma unroll
    for (int i = 0; i < 2; ++i) { const int p = 2 * wid + i; const int key = 8 * p + (lane >> 3), ch = (lane & 7) ^ ((lane >> 3) & 7);
        const size_t eo = (rowbase + ((size_t)key << dsh)) * AW + h * HD + 8 * ch;
        glds16(K + eo, sb + p * 1024); glds16(V + eo, sb + VRING + p * 1024); }
}
__device__ __forceinline__ void item(int idx, const bf16* Q, const bf16* K, const bf16* V, bf16* O, float* LSE, LAS unsigned char* lds) {
    int tid = threadIdx.x; asm volatile("" : "+v"(tid));
    const int lane = tid & 63, wid = __builtin_amdgcn_readfirstlane(tid >> 6), r16 = lane & 15, g4 = lane >> 4;
    int br, b, h, g, n0, nblk;
    if (idx < 256) { br = 0; b = idx >> 6; h = (idx >> 3) & 7; g = 0; n0 = 8 * (idx & 7); nblk = 8; }
    else if (idx < 512) { const int j = idx - 256; br = 1; b = j >> 6; h = (j >> 3) & 7; g = (j & 7) >> 1; n0 = 8 * (j & 1); nblk = 8; }
    else { const int j = idx - 512; br = 2; b = j >> 7; h = (j >> 4) & 7; g = j & 15; n0 = 0; nblk = 4; }
    const int dsh = 2 * br;
    const size_t seq0 = (size_t)b * SEQ + g;
    const int nend = n0 + nblk;
    if (n0 > 0) dma_block(K, V, seq0 + ((size_t)(128 * (n0 - 1)) << dsh), dsh, h, lds, n0 - 1, wid, lane);
    else {
#pragma unroll
        for (int i = 0; i < 2; ++i) { *(LAS v4u*)(lds + 3 * KSLOT + tid * 16 + i * 8192) = (v4u){0u, 0u, 0u, 0u}; *(LAS v4u*)(lds + VRING + 3 * KSLOT + tid * 16 + i * 8192) = (v4u){0u, 0u, 0u, 0u}; }
    }
    dma_block(K, V, seq0 + ((size_t)(128 * n0) << dsh), dsh, h, lds, n0, wid, lane);
    dma_block(K, V, seq0 + ((size_t)(128 * (n0 + 1)) << dsh), dsh, h, lds, n0 + 1, wid, lane);
    const int qi = 16 * wid + r16;
    bf16x8 qf[2];
    { const size_t rowq = seq0 + ((size_t)(128 * n0 + qi) << dsh);
#pragma unroll
      for (int ks = 0; ks < 2; ++ks) qf[ks] = *(const GAS bf16x8*)(Q + rowq * AW + h * HD + 32 * ks + 8 * g4); }
    asm volatile("s_waitcnt vmcnt(0) lgkmcnt(0)\n\ts_barrier" ::: "memory");
    int kl[2], vl[4];
#pragma unroll
    for (int ks = 0; ks < 2; ++ks) kl[ks] = r16 * 128 + 16 * ((4 * ks + g4) ^ (r16 & 7));
#pragma unroll
    for (int dt = 0; dt < 4; ++dt) vl[dt] = VRING + (4 * g4 + (r16 >> 2)) * 128 + (((2 * dt + ((r16 & 3) >> 1)) ^ ((4 * g4 + (r16 >> 2)) & 7)) * 16) + (r16 & 1) * 8;
#define ATT_STEP(n, SPH, QC0, QC1, QX0, QX1) do { \
        const bool more = ((n) + 1 < nend), more2 = ((n) + 2 < nend); \
        { const bf16* qp = Q + (seq0 + ((size_t)(128 * ((n) + (more ? 1 : 0)) + qi) << dsh)) * AW + h * HD + 8 * g4; \
          asm volatile("global_load_dwordx4 %0, %2, off\n\tglobal_load_dwordx4 %1, %2, off offset:64" : "=&v"(QX0), "=&v"(QX1) : "v"(qp) : "memory"); } \
        if (more2) dma_block(K, V, seq0 + ((size_t)(128 * ((n) + 2)) << dsh), dsh, h, lds, (n) + 2, wid, lane); \
          \
        const int wbase = 128 * (SPH) + 16 * wid; \
        f32x4_t sc[9]; bf16x8 kf[9][2]; \
        _Pragma("unroll") \
        for (int j = 0; j < 9; ++j) { \
        _Pragma("unroll") \
            for (int ks = 0; ks < 2; ++ks) kf[j][ks] = ((SPH) < 3) ? *(const LAS bf16x8*)(lds + kbs[ks] + (128 * (SPH) + 16 * j) * 128) : *(const LAS bf16x8*)(lds + ((wbase + 16 * j) & 511) * 128 + kl[ks]); } \
        __builtin_amdgcn_sched_barrier(0); \
        _Pragma("unroll") \
        for (int j = 0; j < 9; ++j) sc[j] = __builtin_amdgcn_mfma_f32_16x16x32_bf16(kf[j][0], QC0, (f32x4_t){0.f, 0.f, 0.f, 0.f}, 0, 0, 0);     \
        _Pragma("unroll") \
        for (int j = 0; j < 9; ++j) sc[j] = __builtin_amdgcn_mfma_f32_16x16x32_bf16(kf[j][1], QC1, sc[j], 0, 0, 0); \
        __builtin_amdgcn_sched_barrier(0); \
        if ((n) == 0) {                                                  \
        _Pragma("unroll") \
            for (int j = 0; j < 8; ++j) if (wid + j < 8) sc[j] = (f32x4_t){-1e30f, -1e30f, -1e30f, -1e30f}; } \
        _Pragma("unroll") \
        for (int r = 0; r < 4; ++r) { if (4 * g4 + r < r16) sc[0][r] = -1e30f; if (4 * g4 + r > r16) sc[8][r] = -1e30f; }     \
        float mx = -1e30f; \
        _Pragma("unroll") \
        for (int j = 0; j < 9; ++j) { mx = max3f(mx, sc[j][0], sc[j][1]); mx = max3f(mx, sc[j][2], sc[j][3]); } \
        mx = max3f(mx, __shfl_xor(mx, 16), mx); mx = max3f(mx, __shfl_xor(mx, 32), mx); \
        float l = 0.f; \
        _Pragma("unroll") \
        for (int j = 0; j < 9; ++j) \
        _Pragma("unroll") \
            for (int r = 0; r < 4; ++r) { const float e = __builtin_amdgcn_exp2f(sc[j][r] - mx); sc[j][r] = e; l += e; } \
        l += __shfl_xor(l, 16); l += __shfl_xor(l, 32); \
        f32x4_t o[4]; \
        v4i16_t vlo[5][4], vh8[5][4]; bf16x8 pf[5]; \
        _Pragma("unroll") \
        for (int kk = 0; kk < 5; ++kk) { \
        _Pragma("unroll") \
            for (int dt = 0; dt < 4; ++dt) { \
                if ((SPH) < 3) { vlo[kk][dt] = __builtin_amdgcn_ds_read_tr16_b64_v4i16((LAS v4i16_t*)(lds + vbs[dt] + (128 * (SPH) + 32 * kk) * 128)); \
                                 vh8[kk][dt] = __builtin_amdgcn_ds_read_tr16_b64_v4i16((LAS v4i16_t*)(lds + vbs[dt] + (128 * (SPH) + 32 * kk + (kk < 4 ? 16 : 0)) * 128)); } \
                else { LAS unsigned char* va = lds + ((wbase + 32 * kk) & 511) * 128; \
                       LAS unsigned char* vb = (kk < 4) ? lds + ((wbase + 32 * kk + 16) & 511) * 128 : va;         \
                       vlo[kk][dt] = __builtin_amdgcn_ds_read_tr16_b64_v4i16((LAS v4i16_t*)(va + vl[dt])); vh8[kk][dt] = __builtin_amdgcn_ds_read_tr16_b64_v4i16((LAS v4i16_t*)(vb + vl[dt])); } } \
            v4u pw; pw.x = pk2(sc[2 * kk][0], sc[2 * kk][1]); pw.y = pk2(sc[2 * kk][2], sc[2 * kk][3]); \
            if (kk < 4) { pw.z = pk2(sc[2 * kk + 1][0], sc[2 * kk + 1][1]); pw.w = pk2(sc[2 * kk + 1][2], sc[2 * kk + 1][3]); } else { pw.z = 0u; pw.w = 0u; } \
            pf[kk] = __builtin_bit_cast(bf16x8, pw); } \
        __builtin_amdgcn_sched_barrier(0); \
        _Pragma("unroll") \
        for (int kk = 0; kk < 5; ++kk) \
        _Pragma("unroll") \
            for (int dt = 0; dt < 4; ++dt) { const bf16x8 vf = (bf16x8){vlo[kk][dt][0], vlo[kk][dt][1], vlo[kk][dt][2], vlo[kk][dt][3], vh8[kk][dt][0], vh8[kk][dt][1], vh8[kk][dt][2], vh8[kk][dt][3]}; \
                o[dt] = (kk == 0) ? __builtin_amdgcn_mfma_f32_16x16x32_bf16(vf, pf[kk], (f32x4_t){0.f, 0.f, 0.f, 0.f}, 0, 0, 0) : __builtin_amdgcn_mfma_f32_16x16x32_bf16(vf, pf[kk], o[dt], 0, 0, 0); } \
        __builtin_amdgcn_sched_barrier(0); \
        if (more2) asm volatile("s_waitcnt vmcnt(4)" ::: "memory");     \
        else asm volatile("s_waitcnt vmcnt(0)" ::: "memory"); \
        const float inv = __builtin_amdgcn_rcpf(l); \
        const size_t rowq = seq0 + ((size_t)(128 * (n) + qi) << dsh); \
        bf16* orow = O + ((size_t)br * T + rowq) * AW + h * HD; \
        _Pragma("unroll") \
        for (int dt = 0; dt < 4; ++dt) { v2u w; w.x = pk2(o[dt][0] * inv, o[dt][1] * inv); w.y = pk2(o[dt][2] * inv, o[dt][3] * inv); *(GAS v2u*)(orow + 16 * dt + 4 * g4) = w; } \
        if (g4 == 0) LSE[((size_t)br * T + rowq) * NH + h] = mx + __builtin_amdgcn_logf(l); \
        asm volatile("s_waitcnt lgkmcnt(0)\n\ts_barrier" ::: "memory"); } while (0)
    int kbs[2], vbs[4];
#pragma unroll
    for (int ks = 0; ks < 2; ++ks) kbs[ks] = kl[ks] + 16 * wid * 128;
#pragma unroll
    for (int dt = 0; dt < 4; ++dt) vbs[dt] = vl[dt] + 16 * wid * 128;
    bf16x8 qb0, qb1;
    for (int n4 = n0; n4 < nend; n4 += 4) { ATT_STEP(n4, 3, qf[0], qf[1], qb0, qb1); ATT_STEP(n4 + 1, 0, qb0, qb1, qf[0], qf[1]); ATT_STEP(n4 + 2, 1, qf[0], qf[1], qb0, qb1); ATT_STEP(n4 + 3, 2, qb0, qb1, qf[0], qf[1]); }
#undef ATT_STEP
}
}

namespace lru {
constexpr int USTR = 144, U_BYTES = 67 * USTR, C_BYTES = 64 * USTR, W_BYTES = U_BYTES + C_BYTES;
constexpr int OFF_SSQ = 8 * W_BYTES, OFF_CAR = OFF_SSQ + 8 * 64 * 4, OFF_RSL = OFF_CAR + 512 * 4, LDS_END = OFF_RSL + 64 * 4;
static_assert(W_BYTES % 16 == 0 && LDS_END <= LDSCTL_OFF, "lru LDS");
__device__ __forceinline__ float sigmoid_f(float x) { return __builtin_amdgcn_rcpf(1.f + __builtin_amdgcn_exp2f(-1.4426950408889634f * x)); }
__device__ __forceinline__ float gelu_tanh(float x) { const float t = __builtin_fmaf(-0.10294323972f, x * x, -2.30220819813f); return x * __builtin_amdgcn_rcpf(1.f + __builtin_amdgcn_exp2f(x * t)); }
__device__ __forceinline__ float bf2f(unsigned short h) { return __builtin_bit_cast(float, (unsigned)h << 16); }
__device__ __forceinline__ f32x2 pair_xy(float v) { const float o = __shfl_xor(v, 32); const bool up = (threadIdx.x & 32) != 0; return (f32x2){up ? o : v, up ? v : o}; }
struct LruConst { bf16x8 fr[16]; float w0, w1, w2, w3, cb, brv[2], biv[2], ccv[2]; };
__device__ __forceinline__ void load_const(int layer, const bf16* WFR, const float* conv_w, const float* conv_b, const float* b_r, const float* b_i, const float* lam, LruConst& k) {
    int tid = threadIdx.x; asm volatile("" : "+v"(tid));
    const int lane = tid & 63, wid = __builtin_amdgcn_readfirstlane(tid >> 6), r32 = lane & 31;
    const GAS bf16x8* wfr = (const GAS bf16x8*)(WFR + ((size_t)(layer * 8 + wid) * 16) * 512) + lane;
#pragma unroll
    for (int i = 0; i < 16; ++i) k.fr[i] = wfr[i * 64];
    const int gch = layer * LW + wid * 64 + lane;
    k.w0 = conv_w[layer * 4 * LW + 0 * LW + wid * 64 + lane]; k.w1 = conv_w[layer * 4 * LW + 1 * LW + wid * 64 + lane]; k.w2 = conv_w[layer * 4 * LW + 2 * LW + wid * 64 + lane]; k.w3 = conv_w[layer * 4 * LW + 3 * LW + wid * 64 + lane];
    k.cb = conv_b[gch];
#pragma unroll
    for (int nb = 0; nb < 2; ++nb) { const int ch = wid * 64 + 32 * nb + r32; k.brv[nb] = -1.4426950408889634f * b_r[layer * LW + ch]; k.biv[nb] = -1.4426950408889634f * b_i[layer * LW + ch];
        k.ccv[nb] = lam[layer * LW + ch]; }
}
struct URegs { v4u uv[9]; };
__device__ __forceinline__ void u_load(int cu, const bf16* U, URegs& q) {
    int tid = threadIdx.x; asm volatile("" : "+v"(tid));
    const int lane = tid & 63, wid = __builtin_amdgcn_readfirstlane(tid >> 6);
    const int b = cu >> 7, t0 = 64 * (cu & 127);
#pragma unroll
    for (int j = 0; j < 9; ++j) { const int i = lane + 64 * j, r = i >> 3, ch = i & 7; int t = t0 - 3 + r; t = t < 0 ? 0 : (t > SEQ - 1 ? SEQ - 1 : t);
        q.uv[j] = *(const GAS v4u*)(U + ((size_t)b * SEQ + t) * LW + wid * 64 + ch * 8); }
    __builtin_amdgcn_sched_barrier(0);
}
__device__ __forceinline__ void local_unit(int cu, int layer, const LruConst& kc, const URegs& uq, const bf16* Gt, f32x2* SUM, unsigned* cnt, const float* gout, bf16* MIX, LAS unsigned char* lds) {
    int tid = threadIdx.x; asm volatile("" : "+v"(tid));
    const int lane = tid & 63, wid = __builtin_amdgcn_readfirstlane(tid >> 6), r32 = lane & 31, hi = lane >> 5;
    const int b = cu >> 7, c = cu & 127, t0 = 64 * c;
    const size_t row0 = (size_t)b * SEQ + t0;
    LAS unsigned char* ul = lds + wid * W_BYTES; LAS unsigned char* cl = ul + U_BYTES;
    {
#pragma unroll
      for (int j = 0; j < 9; ++j) { const int i = lane + 64 * j, r = i >> 3, ch = i & 7; const int t = t0 - 3 + r;
          *(LAS v4u*)(ul + r * USTR + ch * 16) = (t >= 0) ? uq.uv[j] : (v4u){0u, 0u, 0u, 0u}; } }
    {
        const float w0 = kc.w0, w1 = kc.w1, w2 = kc.w2, w3 = kc.w3, cb = kc.cb;
        float u0 = bf2f(*(const LAS unsigned short*)(ul + 0 * USTR + 2 * lane)), u1 = bf2f(*(const LAS unsigned short*)(ul + 1 * USTR + 2 * lane)), u2 = bf2f(*(const LAS unsigned short*)(ul + 2 * USTR + 2 * lane));
#pragma unroll 16
        for (int t = 0; t < 64; ++t) { const float u3 = bf2f(*(const LAS unsigned short*)(ul + (t + 3) * USTR + 2 * lane));
            const float y = cb + w0 * u0 + w1 * u1 + w2 * u2 + w3 * u3;
            *(LAS unsigned short*)(cl + t * USTR + 2 * lane) = (unsigned short)pk2(y, 0.f);
            u0 = u1; u1 = u2; u2 = u3; }
    }
    float brv[2], biv[2], ccv[2], hrun[2], ptot[2];
#pragma unroll
    for (int nb = 0; nb < 2; ++nb) { brv[nb] = kc.brv[nb]; biv[nb] = kc.biv[nb]; ccv[nb] = kc.ccv[nb]; hrun[nb] = 0.f; ptot[nb] = 1.f; }
    asm volatile("s_waitcnt lgkmcnt(0)" ::: "memory");
#pragma unroll
    for (int tt = 0; tt < 2; ++tt) {
        bf16x8 ucf[4];
#pragma unroll
        for (int s = 0; s < 4; ++s) ucf[s] = *(const LAS bf16x8*)(cl + (32 * tt + r32) * USTR + (16 * s + 8 * hi) * 2);
#pragma unroll
        for (int nb = 0; nb < 2; ++nb) {
            f32x16 aR, aI;
#pragma unroll
            for (int r = 0; r < 16; ++r) { aR[r] = 0.f; aI[r] = 0.f; }
#pragma unroll
            for (int s = 0; s < 4; ++s) { const bf16x8 fr_ = kc.fr[(0 * 2 + nb) * 4 + s], fi_ = kc.fr[(1 * 2 + nb) * 4 + s];
                aR = __builtin_amdgcn_mfma_f32_32x32x16_bf16(ucf[s], fr_, aR, 0, 0, 0); aI = __builtin_amdgcn_mfma_f32_32x32x16_bf16(ucf[s], fi_, aI, 0, 0, 0); }
#pragma unroll
            for (int q = 0; q < 4; ++q) {
                float a4[4], b4[4];
#pragma unroll
                for (int k = 0; k < 4; ++k) { const int r = 4 * q + k, tl = 32 * tt + 8 * q + 4 * hi + k;
                    const float ucv = bf2f(*(const LAS unsigned short*)(cl + tl * USTR + 2 * (32 * nb + r32)));
                    const float rg = __builtin_amdgcn_rcpf(1.f + __builtin_amdgcn_exp2f(aR[r] + brv[nb])), ig = __builtin_amdgcn_rcpf(1.f + __builtin_amdgcn_exp2f(aI[r] + biv[nb]));
                    const float A = __builtin_amdgcn_exp2f(ccv[nb] * rg);
                    a4[k] = A; b4[k] = __builtin_amdgcn_sqrtf(fmaxf(1.f - A * A, 0.f)) * ig * ucv; }
                const float Ag = (a4[0] * a4[1]) * (a4[2] * a4[3]);
                const float Bg = ((b4[0] * a4[1] + b4[1]) * a4[2] + b4[2]) * a4[3] + b4[3];
                const f32x2 Ax = pair_xy(Ag), Bx = pair_xy(Bg);
                const float hA = Ax.x * hrun[nb] + Bx.x, hB = Ax.y * hA + Bx.y;
                float h = hi ? hA : hrun[nb];
                float p = hi ? ptot[nb] * Ax.x : ptot[nb];
                hrun[nb] = hB; ptot[nb] *= Ax.x * Ax.y;
#pragma unroll
                for (int k = 0; k < 4; ++k) { const int tl = 32 * tt + 8 * q + 4 * hi + k;
                    h = a4[k] * h + b4[k]; p = a4[k] * p;
                    *(LAS unsigned short*)(cl + tl * USTR + 2 * (32 * nb + r32)) = (unsigned short)pk2(h, 0.f);
                    *(LAS unsigned short*)(ul + tl * USTR + 2 * (32 * nb + r32)) = (unsigned short)pk2(p, 0.f); }
                __builtin_amdgcn_sched_barrier(0);
            }
        }
    }
    if (hi == 0) {
#pragma unroll
        for (int nb = 0; nb < 2; ++nb) { const f32x2 sv = (f32x2){ptot[nb], hrun[nb]};
            __hip_atomic_store((unsigned long long*)(SUM + ((size_t)b * 128 + c) * 512 + wid * 64 + 32 * nb + r32), __builtin_bit_cast(unsigned long long, sv), __ATOMIC_RELAXED, __HIP_MEMORY_SCOPE_AGENT); }
    }
    asm volatile("s_waitcnt vmcnt(0) lgkmcnt(0)" ::: "memory");
    const int ch8 = lane & 7;
    v4u gg[8];
#pragma unroll
    for (int i = 0; i < 8; ++i) gg[i] = *(const GAS v4u*)(Gt + (row0 + 8 * i + (lane >> 3)) * LW + wid * 64 + 8 * ch8);
    const f32x4 g0 = *(const GAS f32x4*)(gout + layer * LW + wid * 64 + 8 * ch8), g1 = *(const GAS f32x4*)(gout + layer * LW + wid * 64 + 8 * ch8 + 4);
    __syncthreads();
    if (tid == 0) {
        (void)__hip_atomic_fetch_add(cnt, 1u, __ATOMIC_RELAXED, __HIP_MEMORY_SCOPE_AGENT);
        unsigned sp = 0;
        while (__hip_atomic_load(cnt, __ATOMIC_RELAXED, __HIP_MEMORY_SCOPE_AGENT) < 128u) { __builtin_amdgcn_s_sleep(2); if (++sp > (1u << 20)) break; }
        __builtin_amdgcn_fence(__ATOMIC_ACQUIRE, "agent");
        asm volatile("s_waitcnt vmcnt(0)" ::: "memory");
    }
    __syncthreads();
    {
        float hc = 0.f; const f32x2* spq = SUM + ((size_t)b * 128) * 512 + tid;
        for (int cc = 0; cc < c; cc += 32) { f32x2 ab[32];
#pragma unroll
            for (int k = 0; k < 32; ++k) { const int i = cc + k; ab[k] = spq[(size_t)(i < c ? i : 0) * 512]; }
#pragma unroll
            for (int k = 0; k < 32; ++k) { const int i = cc + k; const f32x2 u_ = (i < c) ? ab[k] : (f32x2){1.f, 0.f}; hc = u_.x * hc + u_.y; } }
        ((LAS float*)(lds + OFF_CAR))[tid] = hc;
    }
    __syncthreads();
    {
        LAS float* ssq = (LAS float*)(lds + OFF_SSQ); LAS float* rsl = (LAS float*)(lds + OFF_RSL); const LAS float* car = (const LAS float*)(lds + OFF_CAR);
        const f32x4 c0 = *(const LAS f32x4*)(car + wid * 64 + 8 * ch8), c1 = *(const LAS f32x4*)(car + wid * 64 + 8 * ch8 + 4);
        float rec[8][8];
#pragma unroll
        for (int i = 0; i < 8; ++i) { const int tk = 8 * i + (lane >> 3); float s = 0.f;
            const v4u hl = *(const LAS v4u*)(cl + tk * USTR + ch8 * 16), pc = *(const LAS v4u*)(ul + tk * USTR + ch8 * 16);
#pragma unroll
            for (int e = 0; e < 4; ++e) { const float ca = (e == 0) ? c0.x : (e == 1) ? c0.z : (e == 2) ? c1.x : c1.z, cb_ = (e == 0) ? c0.y : (e == 1) ? c0.w : (e == 2) ? c1.y : c1.w;
                const float h0 = bf_lo(hl[e]) + bf_lo(pc[e]) * ca, h1 = bf_hi(hl[e]) + bf_hi(pc[e]) * cb_;
                const float r0 = gelu_tanh(bf_lo(gg[i][e])) * h0, r1 = gelu_tanh(bf_hi(gg[i][e])) * h1;
                rec[i][2 * e] = r0; rec[i][2 * e + 1] = r1; s += r0 * r0 + r1 * r1; }
            s = DPP_ADD(s, 0xB1); s = DPP_ADD(s, 0x4E); s = DPP_ADD(s, 0x141);
            if (ch8 == 0) ssq[wid * 64 + tk] = s; }
        __syncthreads();
        if (tid < 64) { float s = 0.f;
#pragma unroll
            for (int w = 0; w < 8; ++w) s += ssq[w * 64 + tid];
            rsl[tid] = __builtin_amdgcn_rsqf(s * (1.f / LW) + RMS_EPS); }
        __syncthreads();
#pragma unroll
        for (int i = 0; i < 8; ++i) { const int tk = 8 * i + (lane >> 3); const float rs = rsl[tk];
            v4u o; o.x = pk2(rec[i][0] * rs * g0.x, rec[i][1] * rs * g0.y); o.y = pk2(rec[i][2] * rs * g0.z, rec[i][3] * rs * g0.w);
            o.z = pk2(rec[i][4] * rs * g1.x, rec[i][5] * rs * g1.y); o.w = pk2(rec[i][6] * rs * g1.z, rec[i][7] * rs * g1.w);
            *(GAS v4u*)(MIX + (row0 + tk) * D + AW + wid * 64 + 8 * ch8) = o; }
    }
    __syncthreads();
}
constexpr int OFF_CARA = 8 * 64 * 4, OFF_CARB = OFF_CARA + 512 * 4 + 64 * 4;
__device__ __forceinline__ void carry2(int cuA, int cuB, const f32x2* SUM, LAS unsigned char* lds) {
    int tid = threadIdx.x; asm volatile("" : "+v"(tid));
    const int cA = cuA & 127, cB = (cuB >= 0) ? (cuB & 127) : 0, cmax = cA > cB ? cA : cB;
    const f32x2* spA = SUM + ((size_t)(cuA >> 7) * 128) * 512 + tid; const f32x2* spB = SUM + ((size_t)((cuB >= 0 ? cuB : cuA) >> 7) * 128) * 512 + tid;
    float hA = 0.f, hB = 0.f;
    for (int cc = 0; cc < cmax; cc += 32) { f32x2 a[32], b[32];
#pragma unroll
        for (int k = 0; k < 32; ++k) { const int i = cc + k; a[k] = spA[(size_t)(i < cA ? i : 0) * 512]; b[k] = spB[(size_t)(i < cB ? i : 0) * 512]; }
#pragma unroll
        for (int k = 0; k < 32; ++k) { const int i = cc + k; const f32x2 ua = (i < cA) ? a[k] : (f32x2){1.f, 0.f}, ub = (i < cB) ? b[k] : (f32x2){1.f, 0.f};
            hA = ua.x * hA + ua.y; hB = ub.x * hB + ub.y; } }
    ((LAS float*)(lds + OFF_CARA))[tid] = hA; ((LAS float*)(lds + OFF_CARB))[tid] = hB;
}
struct FinRegs { v4u hl[8], pc[8], gg[8]; f32x4 g0, g1; };
__device__ __forceinline__ void finish_load(int cu, int layer, const bf16* HL, const bf16* PC, const bf16* Gt, const float* gout, FinRegs& q) {
    int tid = threadIdx.x; asm volatile("" : "+v"(tid));
    const int lane = tid & 63, wid = __builtin_amdgcn_readfirstlane(tid >> 6), ch8 = lane & 7;
    const size_t row0 = (size_t)(cu >> 7) * SEQ + 64 * (cu & 127);
#pragma unroll
    for (int i = 0; i < 8; ++i) { const size_t e = (row0 + 8 * i + (lane >> 3)) * LW + wid * 64 + 8 * ch8;
        q.hl[i] = *(const GAS v4u*)(HL + e); q.pc[i] = *(const GAS v4u*)(PC + e); q.gg[i] = *(const GAS v4u*)(Gt + e); }
    q.g0 = *(const GAS f32x4*)(gout + layer * LW + wid * 64 + 8 * ch8); q.g1 = *(const GAS f32x4*)(gout + layer * LW + wid * 64 + 8 * ch8 + 4);
    __builtin_amdgcn_sched_barrier(0);
}
__device__ __forceinline__ void finish_unit(int cu, int layer, const FinRegs& q, const LAS float* car, const float* gout, bf16* MIX, LAS unsigned char* lds) {
    int tid = threadIdx.x; asm volatile("" : "+v"(tid));
    const int lane = tid & 63, wid = __builtin_amdgcn_readfirstlane(tid >> 6), ch8 = lane & 7;
    const int b = cu >> 7, c = cu & 127;
    const size_t row0 = (size_t)b * SEQ + 64 * c;
    LAS float* ssq = (LAS float*)lds; LAS float* rsl = ssq + 8 * 64 + 512;
    const v4u (&hl)[8] = q.hl; const v4u (&pc)[8] = q.pc; const v4u (&gg)[8] = q.gg;
    const f32x4 c0 = *(const LAS f32x4*)(car + wid * 64 + 8 * ch8), c1 = *(const LAS f32x4*)(car + wid * 64 + 8 * ch8 + 4);
    float rec[8][8];
#pragma unroll
    for (int i = 0; i < 8; ++i) { float s = 0.f;
#pragma unroll
        for (int e = 0; e < 4; ++e) { const float ca = (e == 0) ? c0.x : (e == 1) ? c0.z : (e == 2) ? c1.x : c1.z, cb_ = (e == 0) ? c0.y : (e == 1) ? c0.w : (e == 2) ? c1.y : c1.w;
            const float h0 = bf_lo(hl[i][e]) + bf_lo(pc[i][e]) * ca, h1 = bf_hi(hl[i][e]) + bf_hi(pc[i][e]) * cb_;
            const float r0 = gelu_tanh(bf_lo(gg[i][e])) * h0, r1 = gelu_tanh(bf_hi(gg[i][e])) * h1;
            rec[i][2 * e] = r0; rec[i][2 * e + 1] = r1; s += r0 * r0 + r1 * r1; }
        s = DPP_ADD(s, 0xB1); s = DPP_ADD(s, 0x4E); s = DPP_ADD(s, 0x141);
        if (ch8 == 0) ssq[wid * 64 + 8 * i + (lane >> 3)] = s; }
    __syncthreads();
    if (tid < 64) { float s = 0.f;
#pragma unroll
        for (int w = 0; w < 8; ++w) s += ssq[w * 64 + tid];
        rsl[tid] = __builtin_amdgcn_rsqf(s * (1.f / LW) + RMS_EPS); }
    __syncthreads();
    const f32x4 g0 = q.g0, g1 = q.g1;
#pragma unroll
    for (int i = 0; i < 8; ++i) { const int tk = 8 * i + (lane >> 3); const float rs = rsl[tk];
        v4u o; o.x = pk2(rec[i][0] * rs * g0.x, rec[i][1] * rs * g0.y); o.y = pk2(rec[i][2] * rs * g0.z, rec[i][3] * rs * g0.w);
        o.z = pk2(rec[i][4] * rs * g1.x, rec[i][5] * rs * g1.y); o.w = pk2(rec[i][6] * rs * g1.z, rec[i][7] * rs * g1.w);
        *(GAS v4u*)(MIX + (row0 + tk) * D + AW + wid * 64 + 8 * ch8) = o; }
    __syncthreads();
}
}

__device__ __forceinline__ void attn_combine(int cu, int layer, const bf16* OBR, const float* LSE, const float* gain, bf16* MIX) {
    int tid = threadIdx.x; asm volatile("" : "+v"(tid));
    const int lane = tid & 63, wid = __builtin_amdgcn_readfirstlane(tid >> 6), head = lane >> 3;
    const f32x4 g0 = *(const GAS f32x4*)(gain + layer * AW + 8 * lane), g1 = *(const GAS f32x4*)(gain + layer * AW + 8 * lane + 4);
    const size_t rowb = (size_t)(cu >> 7) * SEQ + 64 * (cu & 127) + wid;
#pragma unroll
    for (int bt = 0; bt < 2; ++bt) {
        float l0[4], l1[4], l2[4]; v4u a[4], b[4], d[4];
#pragma unroll
        for (int k = 0; k < 4; ++k) { const size_t row = rowb + 8 * (4 * bt + k);
            l0[k] = LSE[((size_t)0 * T + row) * NH + head]; l1[k] = LSE[((size_t)1 * T + row) * NH + head]; l2[k] = LSE[((size_t)2 * T + row) * NH + head];
            a[k] = *(const GAS v4u*)(OBR + ((size_t)0 * T + row) * AW + 8 * lane); b[k] = *(const GAS v4u*)(OBR + ((size_t)1 * T + row) * AW + 8 * lane); d[k] = *(const GAS v4u*)(OBR + ((size_t)2 * T + row) * AW + 8 * lane); }
        __builtin_amdgcn_sched_barrier(0);
#pragma unroll
        for (int k = 0; k < 4; ++k) { const size_t row = rowb + 8 * (4 * bt + k);
            const float mx = fmaxf(l0[k], fmaxf(l1[k], l2[k]));
            float w0 = __builtin_amdgcn_exp2f(l0[k] - mx), w1 = __builtin_amdgcn_exp2f(l1[k] - mx), w2 = __builtin_amdgcn_exp2f(l2[k] - mx);
            const float iw = __builtin_amdgcn_rcpf(w0 + w1 + w2); w0 *= iw; w1 *= iw; w2 *= iw;
            float acc[8]; float ss = 0.f;
#pragma unroll
            for (int e = 0; e < 4; ++e) { const float lo = w0 * bf_lo(a[k][e]) + w1 * bf_lo(b[k][e]) + w2 * bf_lo(d[k][e]), hh = w0 * bf_hi(a[k][e]) + w1 * bf_hi(b[k][e]) + w2 * bf_hi(d[k][e]);
                acc[2 * e] = lo; acc[2 * e + 1] = hh; ss += lo * lo + hh * hh; }
            const float rstd = __builtin_amdgcn_rsqf(wave_sum(ss) * (1.f / AW) + RMS_EPS);
            v4u w; w.x = pk2(acc[0] * rstd * g0.x, acc[1] * rstd * g0.y); w.y = pk2(acc[2] * rstd * g0.z, acc[3] * rstd * g0.w);
            w.z = pk2(acc[4] * rstd * g1.x, acc[5] * rstd * g1.y); w.w = pk2(acc[6] * rstd * g1.z, acc[7] * rstd * g1.w);
            *(GAS v4u*)(MIX + row * D + 8 * lane) = w; }
    }
}

__device__ __forceinline__ void mix_unit(int cu, int layer, const bf16* OBR, const float* LSE, const float* again, const bf16* HL, const bf16* PC, const bf16* Gt, const LAS float* car, const float* lgain, bf16* MIX) {
    int tid = threadIdx.x; asm volatile("" : "+v"(tid));
    const int lane = tid & 63, wid = __builtin_amdgcn_readfirstlane(tid >> 6), head = lane >> 3;
    const f32x4 g0 = *(const GAS f32x4*)(again + layer * AW + 8 * lane), g1 = *(const GAS f32x4*)(again + layer * AW + 8 * lane + 4);
    const f32x4 h0 = *(const GAS f32x4*)(lgain + layer * LW + 8 * lane), h1 = *(const GAS f32x4*)(lgain + layer * LW + 8 * lane + 4);
    const f32x4 c0 = *(const LAS f32x4*)(car + 8 * lane), c1 = *(const LAS f32x4*)(car + 8 * lane + 4);
    const size_t rowb = (size_t)(cu >> 7) * SEQ + 64 * (cu & 127) + 8 * wid;
#pragma unroll
    for (int bt = 0; bt < 2; ++bt) {
        float l0[4], l1[4], l2[4]; v4u a[4], b[4], d[4], hl[4], pc[4], gg[4];
#pragma unroll
        for (int k = 0; k < 4; ++k) { const size_t row = rowb + 4 * bt + k;
            l0[k] = LSE[((size_t)0 * T + row) * NH + head]; l1[k] = LSE[((size_t)1 * T + row) * NH + head]; l2[k] = LSE[((size_t)2 * T + row) * NH + head];
            a[k] = *(const GAS v4u*)(OBR + ((size_t)0 * T + row) * AW + 8 * lane); b[k] = *(const GAS v4u*)(OBR + ((size_t)1 * T + row) * AW + 8 * lane); d[k] = *(const GAS v4u*)(OBR + ((size_t)2 * T + row) * AW + 8 * lane);
            hl[k] = *(const GAS v4u*)(HL + row * LW + 8 * lane); pc[k] = *(const GAS v4u*)(PC + row * LW + 8 * lane); gg[k] = *(const GAS v4u*)(Gt + row * LW + 8 * lane); }
        __builtin_amdgcn_sched_barrier(0);
#pragma unroll
        for (int k = 0; k < 4; ++k) { const size_t row = rowb + 4 * bt + k;
            const float mx = fmaxf(l0[k], fmaxf(l1[k], l2[k]));
            float w0 = __builtin_amdgcn_exp2f(l0[k] - mx), w1 = __builtin_amdgcn_exp2f(l1[k] - mx), w2 = __builtin_amdgcn_exp2f(l2[k] - mx);
            const float iw = __builtin_amdgcn_rcpf(w0 + w1 + w2); w0 *= iw; w1 *= iw; w2 *= iw;
            float acc[8], rec[8]; float ss = 0.f, s2 = 0.f;
#pragma unroll
            for (int e = 0; e < 4; ++e) { const float lo = w0 * bf_lo(a[k][e]) + w1 * bf_lo(b[k][e]) + w2 * bf_lo(d[k][e]), hh = w0 * bf_hi(a[k][e]) + w1 * bf_hi(b[k][e]) + w2 * bf_hi(d[k][e]);
                acc[2 * e] = lo; acc[2 * e + 1] = hh; ss += lo * lo + hh * hh;
                const float ca = (e == 0) ? c0.x : (e == 1) ? c0.z : (e == 2) ? c1.x : c1.z, cb_ = (e == 0) ? c0.y : (e == 1) ? c0.w : (e == 2) ? c1.y : c1.w;
                const float x0 = bf_lo(hl[k][e]) + bf_lo(pc[k][e]) * ca, x1 = bf_hi(hl[k][e]) + bf_hi(pc[k][e]) * cb_;
                const float r0 = lru::gelu_tanh(bf_lo(gg[k][e])) * x0, r1 = lru::gelu_tanh(bf_hi(gg[k][e])) * x1;
                rec[2 * e] = r0; rec[2 * e + 1] = r1; s2 += r0 * r0 + r1 * r1; }
            const float rstd = __builtin_amdgcn_rsqf(wave_sum(ss) * (1.f / AW) + RMS_EPS), rstd2 = __builtin_amdgcn_rsqf(wave_sum(s2) * (1.f / LW) + RMS_EPS);
            v4u w; w.x = pk2(acc[0] * rstd * g0.x, acc[1] * rstd * g0.y); w.y = pk2(acc[2] * rstd * g0.z, acc[3] * rstd * g0.w);
            w.z = pk2(acc[4] * rstd * g1.x, acc[5] * rstd * g1.y); w.w = pk2(acc[6] * rstd * g1.z, acc[7] * rstd * g1.w);
            *(GAS v4u*)(MIX + row * D + 8 * lane) = w;
            v4u o; o.x = pk2(rec[0] * rstd2 * h0.x, rec[1] * rstd2 * h0.y); o.y = pk2(rec[2] * rstd2 * h0.z, rec[3] * rstd2 * h0.w);
            o.z = pk2(rec[4] * rstd2 * h1.x, rec[5] * rstd2 * h1.y); o.w = pk2(rec[6] * rstd2 * h1.z, rec[7] * rstd2 * h1.w);
            *(GAS v4u*)(MIX + row * D + AW + 8 * lane) = o; }
    }
}
__device__ __forceinline__ void post_mix_row(const RawRow& mraw, const RawRow& xraw, bf16* xout, const Gain4& gpost, const Gain4& gpre2, bf16* hrow, unsigned char* h8row, float* rstd_out, f32x4 (&hn)[4], int lane) {
    f32x4 m[4], xv[4]; unpack_raw(mraw, m); unpack_raw(xraw, xv);
    float s = 0.f;
#pragma unroll
    for (int j = 0; j < 4; ++j) s += (m[j].x * m[j].x + m[j].y * m[j].y) + (m[j].z * m[j].z + m[j].w * m[j].w);
    const float rstd = __builtin_amdgcn_rsqf(wave_sum(s) * (1.f / D) + RMS_EPS);
    float s2 = 0.f;
    GAS unsigned long long* x8 = (GAS unsigned long long*)xout + lane;
#pragma unroll
    for (int j = 0; j < 4; ++j) { const f32x4 gg = gpost.g[j];
        f32x4 y; y.x = xv[j].x + m[j].x * rstd * gg.x; y.y = xv[j].y + m[j].y * rstd * gg.y; y.z = xv[j].z + m[j].z * rstd * gg.z; y.w = xv[j].w + m[j].w * rstd * gg.w;
        x8[64 * j] = (unsigned long long)pk2(y.x, y.y) | ((unsigned long long)pk2(y.z, y.w) << 32); hn[j] = y; s2 += (y.x * y.x + y.y * y.y) + (y.z * y.z + y.w * y.w); }
    const float rstd2 = __builtin_amdgcn_rsqf(wave_sum(s2) * (1.f / D) + RMS_EPS);
    if (rstd_out && lane == 0) *rstd_out = rstd2;
    GAS unsigned long long* o8 = (GAS unsigned long long*)hrow + lane;
#pragma unroll
    for (int j = 0; j < 4; ++j) { const f32x4 gg = gpre2.g[j];
        hn[j].x *= rstd2 * gg.x; hn[j].y *= rstd2 * gg.y; hn[j].z *= rstd2 * gg.z; hn[j].w *= rstd2 * gg.w;
        if (hrow) o8[64 * j] = (unsigned long long)pk2(hn[j].x, hn[j].y) | ((unsigned long long)pk2(hn[j].z, hn[j].w) << 32);
        if (h8row) *((GAS unsigned*)h8row + lane + 64 * j) = pg8::pk4_fp8(hn[j].x, hn[j].y, hn[j].z, hn[j].w); }
}
__device__ __forceinline__ void post_ffn_row(f32x4 (&f)[4], const RawRow& xraw, bf16* xout, float* orow32, const Gain4& gpost, const float* gnext, bf16* hrow, float* rstd_out, int lane) {
    f32x4 xv[4]; unpack_raw(xraw, xv);
    float s = 0.f;
#pragma unroll
    for (int j = 0; j < 4; ++j) s += (f[j].x * f[j].x + f[j].y * f[j].y) + (f[j].z * f[j].z + f[j].w * f[j].w);
    const float rstd = __builtin_amdgcn_rsqf(wave_sum(s) * (1.f / D) + RMS_EPS);
    f32x4 y[4];
    GAS unsigned long long* x8 = (GAS unsigned long long*)xout + lane;
#pragma unroll
    for (int j = 0; j < 4; ++j) { const f32x4 gg = gpost.g[j];
        y[j].x = xv[j].x + f[j].x * rstd * gg.x; y[j].y = xv[j].y + f[j].y * rstd * gg.y; y[j].z = xv[j].z + f[j].z * rstd * gg.z; y[j].w = xv[j].w + f[j].w * rstd * gg.w;
        if (orow32) *((GAS f32x4*)orow32 + lane + 64 * j) = y[j];
        if (xout) x8[64 * j] = (unsigned long long)pk2(y[j].x, y[j].y) | ((unsigned long long)pk2(y[j].z, y[j].w) << 32); }
    if (gnext) rms_store_bf16(y, gnext, hrow, lane);
    if (rstd_out) { float s2 = 0.f;
#pragma unroll
        for (int j = 0; j < 4; ++j) s2 += (y[j].x * y[j].x + y[j].y * y[j].y) + (y[j].z * y[j].z + y[j].w * y[j].w);
        const float r2 = __builtin_amdgcn_rsqf(wave_sum(s2) * (1.f / D) + RMS_EPS); if (lane == 0) *rstd_out = r2; }
}

constexpr int I_IN = 8 * 10, I_OUT = 8 * 4, I_G = 8 * 14, I_D = 28 * 4, I_E = 2 * I_G + I_D, NIT_DENSE = 2 * I_IN + 2 * I_OUT + 2 * I_G + I_D;
constexpr int EDEF = 5, NIT_P0 = NIT_DENSE + EDEF * I_E, NIT_DEF = (NE - EDEF) * I_E;
__device__ __forceinline__ WItem w_item_of(const Args& a, unsigned char* ws, int it) {
            WItem q; q.gko = -1; q.GU = -1; q.f8 = 0; q.scale = 1.f; int r = it;
            if (r < 2 * I_IN) { const int l = r / I_IN, s = r % I_IN; q.W = a.w_in + (size_t)l * D * INC; q.K = D; q.N = INC; q.WT = (unsigned char*)((bf16*)(ws + WS_WIN) + (size_t)l * INC * D); q.k0 = 128 * (s / 10); q.n0 = 256 * (s % 10); q.gko = l * D; return q; } r -= 2 * I_IN;
            if (r < 2 * I_OUT) { const int l = r / I_OUT, s = r % I_OUT; q.W = a.w_out + (size_t)l * D * D; q.K = D; q.N = D; q.WT = (unsigned char*)((bf16*)(ws + WS_WOUT) + (size_t)l * D * D); q.k0 = 128 * (s / 4); q.n0 = 256 * (s % 4); return q; } r -= 2 * I_OUT;
            if (r < 2 * I_G) { const int up = r / I_G, s = r % I_G; q.W = up ? a.dw_up : a.dw_gate; q.K = D; q.N = FF; q.WT = (unsigned char*)(ws + WS_WGU); q.k0 = 128 * (s / 14); q.n0 = 256 * (s % 14); q.GU = up; q.gko = 2 * D; return q; } r -= 2 * I_G;
            if (r < I_D) { q.W = a.dw_down; q.K = FF; q.N = D; q.WT = (unsigned char*)(ws + WS_WD); q.k0 = 128 * (r / 4); q.n0 = 256 * (r % 4); q.f8 = 1; q.scale = MOE_WD_SCALE; return q; } r -= I_D;
            const int e = r / (2 * I_G + I_D); r -= e * (2 * I_G + I_D);
            unsigned char* we = (unsigned char*)(ws + WS_MOEW) + (size_t)e * (3 * (size_t)D * FF);
            q.f8 = 1;
            if (r < 2 * I_G) { const int up = r / I_G, s = r % I_G; q.W = (up ? a.mw_up : a.mw_gate) + (size_t)e * D * FF; q.K = D; q.N = FF; q.WT = we; q.k0 = 128 * (s / 14); q.n0 = 256 * (s % 14); q.GU = up; q.scale = MOE_WGU_SCALE; return q; } r -= 2 * I_G;
            q.W = a.mw_down + (size_t)e * FF * D; q.K = FF; q.N = D; q.WT = we + (size_t)2 * D * FF; q.k0 = 128 * (r / 4); q.n0 = 256 * (r % 4); q.scale = MOE_WD_SCALE; return q; }
__device__ __forceinline__ void convert_items(const Args& a, unsigned char* ws, LAS unsigned char* lds, int first, int cnt, int slot, int nslots, int wave, int lane) {
        if (slot < 0 || slot >= cnt) return;
        const int n = (cnt - slot + nslots - 1) / nslots;
        WRegs ra, rb; WItem ia = w_item_of(a, ws, first + slot), ib = ia;
        w_load(ia, ra, wave, lane);
        int k = 0;
        for (;;) {
            if (k + 1 >= n) { w_finish(ia, ra, lds, wave, lane); break; }
            ib = w_item_of(a, ws, first + slot + (k + 1) * nslots); w_load(ib, rb, wave, lane);
            w_finish(ia, ra, lds, wave, lane);
            if (k + 2 >= n) { w_finish(ib, rb, lds, wave, lane); break; }
            ia = w_item_of(a, ws, first + slot + (k + 2) * nslots); w_load(ia, ra, wave, lane);
            w_finish(ib, rb, lds, wave, lane);
            k += 2;
        }
}


#ifndef ONLY
#define PH(n) 1
#else
#define PH(n) (ONLY == (n))
#endif
#define CAS __attribute__((address_space(4)))
__global__ void __launch_bounds__(NWAVES * 64, 2) hymba_fwd(Args a) {
    extern __shared__ __attribute__((aligned(16))) unsigned char lds_raw[];
    Frame F;
    F.lds = (LAS unsigned char*)lds_raw;
    F.G = gridDim.x; { const int bx = blockIdx.x; F.vcu = (F.G % 8 == 0) ? (bx % 8) * (F.G / 8) + bx / 8 : bx; }
    unsigned char* const ws0 = a.ws; size_t wso = 0; unsigned char* ws = ws0;
#define ctl ((gu32*)(ws + WS_CTL))
    volatile LAS unsigned* MISC = (volatile LAS unsigned*)(F.lds + LDSCTL_OFF);
    for (int u = threadIdx.x; u < (LDS_BYTES - LDSCTL_OFF) / 4; u += NWAVES * 64) ((LAS unsigned*)(F.lds + LDSCTL_OFF))[u] = 0u;
    __syncthreads();
    __builtin_amdgcn_s_setreg(1 | (23 << 6) | (0 << 11), 1);
    XcdBarrier bar = xcd_barrier_post((unsigned*)(ctl + CW_BAR), MISC + 8);
#define GRID_BAR() xcd_barrier(bar)
#define FRESH() int tid_ = threadIdx.x; asm volatile("" : "+v"(tid_)); const int lane_ = tid_ & 63, wave_ = __builtin_amdgcn_readfirstlane(tid_ >> 6); \
    int vcu_ = F.vcu, G_ = F.G, bidx_ = blockIdx.x; asm volatile("" : "+s"(vcu_), "+s"(G_), "+s"(bidx_)); const int gw = vcu_ * NWAVES + wave_, NGW = G_ * NWAVES; (void)lane_; (void)gw; (void)NGW; (void)bidx_
#define SUM ((f32x2*)(ws + WS_SUM))
#define ROWTOK ((int*)(ws + WS_ROWTOK))
#define ROWGATE ((float*)(ws + WS_ROWGATE))
#define COST ((float*)(ws + WS_ROPE))
#define SINT ((float*)(ws + WS_ROPE) + (size_t)T * 8)
#define LSE ((float*)(ws + WS_LSE))
#define WFR ((bf16*)(ws + WS_WFR))
#define WIN ((bf16*)(ws + WS_WIN))
#define WOUT ((bf16*)(ws + WS_WOUT))
#define WGU ((bf16*)(ws + WS_WGU))
#define WD ((bf16*)(ws + WS_WD))
#define MOEW ((bf16*)(ws + WS_MOEW))
#define RA ((bf16*)(ws + WS_RA))
#define ZB ((bf16*)(ws + WS_RB))
#define OBR ((bf16*)(ws + WS_RC))
#define QB ZB
#define KB (ZB + (size_t)T * 512)
#define VB (ZB + (size_t)2 * T * 512)
#define UB (ZB + (size_t)3 * T * 512)
#define GB (ZB + (size_t)4 * T * 512)
#define MIXB RA
#define MB VB
#define HLB RA
#define PCB (RA + (size_t)T * 512)
#define ACT ZB
#define ACTM ((bf16*)(ws + WS_ACTM))
#define FSLOT ((bf16*)(ws + WS_FSLOT))
#define RSTDA ((float*)(ws + WS_RSTDA))
#define RSTDF ((float*)(ws + WS_RSTDF))
#define XB ((bf16*)(ws + WS_XB))

#if PH(0)
    {
        FRESH();
        for (int i = tid_; i < 3 * D; i += NWAVES * 64) ((LAS float*)(F.lds + WGAIN_OFF))[i] = (i < 2 * D) ? a.pre_mix_g[i] : a.pre_ffn_g[i - 2 * D];
        __syncthreads();
        convert_items(a, ws, F.lds, 0, NIT_P0, vcu_, G_, wave_, lane_);
        const int gt = vcu_ * (NWAVES * 64) + tid_, NGT = G_ * NWAVES * 64;
        for (int i = gt; i < T * 8; i += NGT) { const int row = i >> 3, f = i & 7;
            const float inv = powf(500000.0f, -(float)f * 0.125f); const float ang = (float)a.pos[row] * inv; float sn, cs; sincosf(ang, &sn, &cs); COST[i] = cs; SINT[i] = sn; }
        for (int i = gt; i < NE * T; i += NGT) ROWTOK[i] = -1;
        for (int i = gt; i < 2 * LW; i += NGT) { const float lm = a.lam[i]; const float sp = (lm > 15.f) ? __expf(-lm) : log1pf(__expf(-lm));
            ((float*)(ws + WS_CCV))[i] = -8.f * sp * 1.4426950408889634f; }
        for (int i = gt; i < 2 * 8 * 16 * 64; i += NGT) {
            const int ln = i & 63, s_ = (i >> 6) & 3, mb = (i >> 8) & 1, gate = (i >> 9) & 1, lg = i >> 10;
            const float* w = (gate ? a.w_igate : a.w_rgate) + (size_t)lg * 64 * 64; const int i0 = 16 * s_ + 8 * (ln >> 5), j = 32 * mb + (ln & 31);
            const float sg = -1.4426950408889634f;
            v4u o; o.x = pk2(sg * w[(i0 + 0) * 64 + j], sg * w[(i0 + 1) * 64 + j]); o.y = pk2(sg * w[(i0 + 2) * 64 + j], sg * w[(i0 + 3) * 64 + j]); o.z = pk2(sg * w[(i0 + 4) * 64 + j], sg * w[(i0 + 5) * 64 + j]); o.w = pk2(sg * w[(i0 + 6) * 64 + j], sg * w[(i0 + 7) * 64 + j]);
            *(GAS v4u*)(WFR + (size_t)i * 8) = o; }
        {
            struct XS { f32x4 v[4]; };
            const float* xin = a.x;
            row_pipe<XS>(gw, NGW, T,
                [&](int m, XS& q) {
#pragma unroll
                    for (int j = 0; j < 4; ++j) q.v[j] = *((const GAS f32x4*)(xin + (size_t)m * D) + lane_ + 64 * j); },
                [&](int m, XS& q) { float s = 0.f;
#pragma unroll
                    for (int j = 0; j < 4; ++j) s += (q.v[j].x * q.v[j].x + q.v[j].y * q.v[j].y) + (q.v[j].z * q.v[j].z + q.v[j].w * q.v[j].w);
                    const float rs = __builtin_amdgcn_rsqf(wave_sum(s) * (1.f / D) + RMS_EPS); if (lane_ == 0) RSTDA[m] = rs;
                    GAS unsigned long long* x8 = (GAS unsigned long long*)(XB + (size_t)m * D) + lane_;
#pragma unroll
                    for (int j = 0; j < 4; ++j) x8[64 * j] = (unsigned long long)pk2(q.v[j].x, q.v[j].y) | ((unsigned long long)pk2(q.v[j].z, q.v[j].w) << 32); });
        }
    }
#endif
    GRID_BAR();

    for (int layer = 0; layer < 2; ++layer) {
        asm volatile("" : "+s"(wso)); ws = ws0 + wso;
#if PH(2)
        {
            FRESH();
            pg8::Gemm g{XB, WIN + (size_t)layer * INC * D, T, INC, D, 0, nullptr}; pg8::StaticOrder S; S.init(T, INC, G_, bidx_);
            pg8::EpiZ E{ZB, (size_t)T * 512, COST, SINT, QSCALE, RSTDA};
            pg8::gemm_phase<pg8::EpiZ, pg8::StaticOrder, false>(F.lds, g, S, E);
        }
#endif
        GRID_BAR();
#if PH(3)
        {
            FRESH();
            lru::LruConst kc; lru::load_const(layer, WFR, a.conv_w, a.conv_b, a.b_rgate, a.b_igate, (const float*)(ws + WS_CCV), kc);
            for (int k2 = 0, cu = vcu_; cu < BATCH * 128; ++k2, cu += G_) { const int cuu = (G_ == 256 && k2 == 1) ? (cu & ~127) + (127 - (cu & 127)) : cu;
                lru::URegs ua; lru::u_load(cuu, UB, ua);
                lru::local_unit(cuu, layer, kc, ua, GB, SUM, (unsigned*)(ctl + CW_LRU + 64 * (4 * layer + (cuu >> 7))), a.lru_out_g, MIXB, F.lds); }
        }
        { FRESH();
          for (int u = vcu_; u < 768; u += G_) { const int bh = u / 24, kq = u % 24;
              if (kq < 8) att::item(bh * 8 + kq, QB, KB, VB, OBR, LSE, F.lds);
              else if (kq < 16) att::item(256 + bh * 8 + (kq - 8), QB, KB, VB, OBR, LSE, F.lds);
              else { att::item(512 + bh * 16 + 2 * (kq - 16), QB, KB, VB, OBR, LSE, F.lds); att::item(513 + bh * 16 + 2 * (kq - 16), QB, KB, VB, OBR, LSE, F.lds); } } }
#endif
        GRID_BAR();
#if PH(4)
        {
            FRESH();
            for (int cu = vcu_; cu < BATCH * 128; cu += G_) attn_combine(cu, layer, OBR, LSE, a.attn_out_g, MIXB);
        }
#endif
        GRID_BAR();
#if PH(5)
        {
            FRESH();
            pg8::Gemm g{MIXB, WOUT + (size_t)layer * D * D, T, D, D, 0, nullptr}; pg8::StaticOrder S; S.init(T, D, G_, bidx_);
            pg8::EpiBf16 E{MB, D};
            pg8::gemm_phase<pg8::EpiBf16, pg8::StaticOrder, false, false, true>(F.lds, g, S, E);
        }
#endif
        GRID_BAR();
#if PH(6)
        {
        FRESH();
        if (layer == 0) {
            struct MX { RawRow m, x; };
            const Gain4 gpost = ld_gain(a.post_mix_g + layer * D, lane_), gpre2 = ld_gain(a.pre_ffn_g + layer * D, lane_);
            row_pipe<MX>(gw, NGW, T,
                [&](int m, MX& q) { ld_raw(MB + (size_t)m * D, q.m, lane_); ld_raw(XB + (size_t)m * D, q.x, lane_); },
                [&](int m, MX& q) { f32x4 hn[4]; post_mix_row(q.m, q.x, XB + (size_t)m * D, gpost, gpre2, nullptr, nullptr, RSTDF + m, hn, lane_); });
        } else {
            LAS float* rt = (LAS float*)F.lds; LAS int* lcnt = (LAS int*)(F.lds + 32768); LAS int* gbase = lcnt + 8; LAS int* lsel = lcnt + 16; LAS float* lprob = (LAS float*)(lcnt + 16 + 4 * 128);
            for (int i = tid_; i < D * NE; i += NWAVES * 64) { const int k = i >> 3, e = i & 7; rt[e * D + k] = a.router_w[i]; }
            if (tid_ < 8) lcnt[tid_] = 0;
            __syncthreads();
            const int rows_per_wg = T / G_;
            for (int rb = 0; rb < rows_per_wg; rb += 128) {
                struct MX { RawRow m, x; };
                const Gain4 gpost = ld_gain(a.post_mix_g + layer * D, lane_), gpre2 = ld_gain(a.pre_ffn_g + layer * D, lane_); const int mbase = vcu_ * rows_per_wg + rb + wave_ * 16;
                row_pipe<MX>(0, 1, 16,
                  [&](int i, MX& q) { const int m = mbase + i; ld_raw(MB + (size_t)m * D, q.m, lane_); ld_raw(XB + (size_t)m * D, q.x, lane_); },
                  [&](int i, MX& q) {
                    const int lr = wave_ * 16 + i; const int m = mbase + i;
                    f32x4 hn[4];
                    post_mix_row(q.m, q.x, XB + (size_t)m * D, gpost, gpre2, nullptr, (unsigned char*)RA + (size_t)m * D, nullptr, hn, lane_);
                    float lg[8];
#pragma unroll
                    for (int e = 0; e < 8; ++e) { float s = 0.f;
#pragma unroll
                        for (int j = 0; j < 4; ++j) { const f32x4 w = *((const LAS f32x4*)(rt + e * D) + lane_ + 64 * j); s += (hn[j].x * w.x + hn[j].y * w.y) + (hn[j].z * w.z + hn[j].w * w.w); }
                        lg[e] = wave_sum(s); }
                    int e1 = 0; float v1 = lg[0];
#pragma unroll
                    for (int e = 1; e < 8; ++e) if (lg[e] > v1) { v1 = lg[e]; e1 = e; }
                    int e2 = -1; float v2 = -3.0e38f;
#pragma unroll
                    for (int e = 0; e < 8; ++e) if (e != e1 && lg[e] > v2) { v2 = lg[e]; e2 = e; }
                    if (lane_ == 0) { const float p2 = __builtin_amdgcn_rcpf(1.f + __builtin_amdgcn_exp2f(1.4426950408889634f * (v1 - v2))); const float p1 = 1.f - p2;
                        const int r1 = __hip_atomic_fetch_add(&lcnt[e1], 1, __ATOMIC_RELAXED, __HIP_MEMORY_SCOPE_WORKGROUP), r2 = __hip_atomic_fetch_add(&lcnt[e2], 1, __ATOMIC_RELAXED, __HIP_MEMORY_SCOPE_WORKGROUP);
                        lsel[lr * 4 + 0] = e1; lsel[lr * 4 + 1] = e2; lsel[lr * 4 + 2] = r1; lsel[lr * 4 + 3] = r2; lprob[lr * 2 + 0] = p1; lprob[lr * 2 + 1] = p2; }
                  });
                __syncthreads();
                if (tid_ < 8) { gbase[tid_] = (int)__hip_atomic_fetch_add(ctl + CW_CNT + 64 * tid_, (unsigned)lcnt[tid_], RLX_AGENT); }
                __syncthreads();
                if (tid_ < 128) { const int m = vcu_ * rows_per_wg + rb + tid_; const int e1 = lsel[tid_ * 4 + 0], e2 = lsel[tid_ * 4 + 1];
                    const int s1 = e1 * T + gbase[e1] + lsel[tid_ * 4 + 2], s2 = e2 * T + gbase[e2] + lsel[tid_ * 4 + 3];
                    ROWTOK[s1] = 2 * m; ROWGATE[s1] = lprob[tid_ * 2]; ROWTOK[s2] = 2 * m + 1; ROWGATE[s2] = lprob[tid_ * 2 + 1]; }
                __syncthreads();
                if (tid_ < 8) lcnt[tid_] = 0;
                __syncthreads();
            }
        }
        }
#endif
        GRID_BAR();
        if (layer == 0) {
#if PH(7)
            {
                FRESH();
                pg8::Gemm g{XB, WGU, T, 2 * FF, D, 0, nullptr}; pg8::StaticOrder S; S.init(T, 2 * FF, G_, bidx_);
                pg8::EpiSwiglu8 E{(unsigned char*)ACT, FF, RSTDF, MOE_ACT_SCALE};
                pg8::gemm_phase<pg8::EpiSwiglu8, pg8::StaticOrder, false, false, true>(F.lds, g, S, E);
            }
#endif
            GRID_BAR();
#if PH(8)
            {
                FRESH();
                pg8::Gemm g{ACT, WD, T, D, FF / 2, 0, nullptr}; pg8::StaticOrder S; S.init(T, D, G_, bidx_);
                pg8::EpiBf16 E{RA, D, 1.f / (MOE_WD_SCALE * MOE_ACT_SCALE)};
                pg8::gemm_phase<pg8::EpiBf16, pg8::StaticOrder, false, true, true>(F.lds, g, S, E);
            }
#endif
            GRID_BAR();
            { FRESH();
            struct FX { RawRow f, x; };
            const Gain4 gpost = ld_gain(a.post_ffn_g + layer * D, lane_);
            row_pipe<FX>(gw, NGW, T,
                [&](int m, FX& q) { ld_raw(RA + (size_t)m * D, q.f, lane_); ld_raw(XB + (size_t)m * D, q.x, lane_); },
                [&](int m, FX& q) { f32x4 f[4]; unpack_raw(q.f, f); post_ffn_row(f, q.x, XB + (size_t)m * D, nullptr, gpost, nullptr, nullptr, RSTDA + m, lane_); }); }
            GRID_BAR();
        } else {
            int ps[9]; ps[0] = 0;
#pragma unroll
            for (int e = 0; e < 8; ++e) { const int c = __builtin_amdgcn_readfirstlane((int)__hip_atomic_load(ctl + CW_CNT + 64 * e, RLX_AGENT)); ps[e + 1] = ps[e] + ((c + 255) >> 8); }
            const int P = ps[8];
            bool first = true;
            for (int p0 = 0; p0 < P || first; ) {
                int np = (P - p0) < CHPAN ? (P - p0) : CHPAN;
                if (first) { if (P > 128 && P - 128 < np) np = P - 128;
                             if (ps[EDEF] < np) np = ps[EDEF]; }
#if PH(10)
                {   FRESH();
                    pg8::Gemm g{RA, MOEW, T, 2 * FF, D / 2, (size_t)3 * D * FF, ROWTOK};
                    pg8::MoeOrder S{p0, np, 2 * FF / 256, np * (2 * FF / 256), G_, bidx_, T, ps[1], ps[2], ps[3], ps[4], ps[5], ps[6], ps[7]};
                    pg8::EpiSwigluF8 E{(unsigned char*)ACTM, FF, 1.f / MOE_WGU_SCALE, MOE_ACT_SCALE};
                    pg8::gemm_phase<pg8::EpiSwigluF8, pg8::MoeOrder, true, true, true>(F.lds, g, S, E);
                }
#endif
                const int Gn = F.G; const int tailg = (np * (2 * FF / 256)) % Gn; const int n1 = (first && tailg > 0) ? ((Gn - tailg) < NIT_DEF ? (Gn - tailg) : NIT_DEF) : 0;
                if (first) { FRESH(); const int it = bidx_ - tailg;
                    if (it >= 0 && it < n1) { WRegs r1; const WItem q = w_item_of(a, ws, NIT_P0 + it); w_load(q, r1, wave_, lane_); w_finish(q, r1, F.lds, wave_, lane_); } }
                GRID_BAR();
#if PH(11)
                {   FRESH();
                    pg8::Gemm g{ACTM, MOEW + (size_t)D * FF, np * 256, D, FF / 2, (size_t)3 * D * FF, nullptr};
                    pg8::MoeOrder S{p0, np, D / 256, np * (D / 256), G_, bidx_, T, ps[1], ps[2], ps[3], ps[4], ps[5], ps[6], ps[7]};
                    pg8::EpiMoeDown E{FSLOT, (size_t)T * D, ROWTOK, ROWGATE, 1.f / (MOE_WD_SCALE * MOE_ACT_SCALE)};
                    pg8::gemm_phase<pg8::EpiMoeDown, pg8::MoeOrder, false, true, true>(F.lds, g, S, E);
                }
#endif
                if (first) {
                    FRESH();
                    const int tail = (np * (D / 256)) % G_;
                    { const int slot = bidx_ - tail, nslots = G_ - tail;
                      if (slot >= 0) for (int it = n1 + slot; it < NIT_DEF; it += nslots) { WRegs r1; const WItem q = w_item_of(a, ws, NIT_P0 + it); w_load(q, r1, wave_, lane_); w_finish(q, r1, F.lds, wave_, lane_); } }
                }
                GRID_BAR();
                p0 += np; first = false;
            }
            { FRESH();
            struct FFX { RawRow f0, f1, x; };
            const Gain4 gpost = ld_gain(a.post_ffn_g + layer * D, lane_); float* outp = a.out;
            row_pipe<FFX>(gw, NGW, T,
                [&](int m, FFX& q) { ld_raw(FSLOT + (size_t)m * D, q.f0, lane_); ld_raw(FSLOT + (size_t)T * D + (size_t)m * D, q.f1, lane_); ld_raw(XB + (size_t)m * D, q.x, lane_); },
                [&](int m, FFX& q) { f32x4 f0[4], f1[4]; unpack_raw(q.f0, f0); unpack_raw(q.f1, f1);
#pragma unroll
                    for (int j = 0; j < 4; ++j) f0[j] = f0[j] + f1[j];
                    post_ffn_row(f0, q.x, nullptr, outp + (size_t)m * D, gpost, nullptr, nullptr, nullptr, lane_); }); }
        }
    }
#undef GRID_BAR
#undef FRESH
#undef ctl
}

extern "C" void kernel_launch(void* const* d_in, const int* in_sizes, int n_in, void* d_out, int out_size, void* d_ws, size_t ws_size, hipStream_t stream) {
    static int grid = 0;
    if (grid == 0) {
        if (n_in != 24 || in_sizes[0] != T * D || out_size != T * D || ws_size < WS_END) { fprintf(stderr, "kernel_launch: unexpected shapes / workspace (n_in %d, ws %zu, need %zu); nothing launched\n", n_in, ws_size, (size_t)WS_END); grid = -1; return; }
        int dev = 0, cus = 0, per_cu = 0;
        if (hipGetDevice(&dev) != hipSuccess || hipDeviceGetAttribute(&cus, hipDeviceAttributeMultiprocessorCount, dev) != hipSuccess) { grid = -1; return; }
        if (hipFuncSetAttribute((const void*)hymba_fwd, hipFuncAttributeMaxDynamicSharedMemorySize, LDS_BYTES) != hipSuccess) { fprintf(stderr, "kernel_launch: hipFuncSetAttribute failed\n"); grid = -1; return; }
        if (hipOccupancyMaxActiveBlocksPerMultiprocessor(&per_cu, (const void*)hymba_fwd, NWAVES * 64, LDS_BYTES) != hipSuccess || per_cu < 1) { fprintf(stderr, "kernel_launch: occupancy query says %d\n", per_cu); }
        (void)hipGetLastError();
        grid = cus;
    }
    if (grid < 0) return;
    if (hipMemsetAsync((char*)d_ws + WS_CTL, 0, CTL_ZERO_BYTES, stream) != hipSuccess) return;
    Args a{};
    a.x = (const float*)d_in[0]; a.pos = (const int*)d_in[1]; a.pre_mix_g = (const float*)d_in[2]; a.w_in = (const float*)d_in[3]; a.conv_w = (const float*)d_in[4]; a.conv_b = (const float*)d_in[5];
    a.w_rgate = (const float*)d_in[6]; a.b_rgate = (const float*)d_in[7]; a.w_igate = (const float*)d_in[8]; a.b_igate = (const float*)d_in[9]; a.lam = (const float*)d_in[10];
    a.attn_out_g = (const float*)d_in[11]; a.lru_out_g = (const float*)d_in[12]; a.w_out = (const float*)d_in[13]; a.post_mix_g = (const float*)d_in[14]; a.pre_ffn_g = (const float*)d_in[15]; a.post_ffn_g = (const float*)d_in[16];
    a.dw_gate = (const float*)d_in[17]; a.dw_up = (const float*)d_in[18]; a.dw_down = (const float*)d_in[19]; a.router_w = (const float*)d_in[20]; a.mw_gate = (const float*)d_in[21]; a.mw_up = (const float*)d_in[22]; a.mw_down = (const float*)d_in[23];
    a.out = (float*)d_out; a.ws = (unsigned char*)d_ws;
    hipLaunchKernelGGL(hymba_fwd, dim3(grid), dim3(NWAVES * 64), LDS_BYTES, stream, a);
}
```

```cpp
#include <hip/hip_runtime.h>
#include <cstdio>
#include <cstdint>
#include <cmath>
namespace pg8 {
#define PG8_LAS __attribute__((address_space(3)))
typedef unsigned short bf16_t;
typedef short bf16x8 __attribute__((ext_vector_type(8)));
typedef float f32x4 __attribute__((ext_vector_type(4)));
typedef unsigned u32x4 __attribute__((ext_vector_type(4)));
typedef unsigned u32x2 __attribute__((ext_vector_type(2)));
typedef int v4i_t __attribute__((ext_vector_type(4)));
typedef int v8i_t __attribute__((ext_vector_type(8)));
constexpr int BM = 256, BK = 64, HALF = 128, HTB = HALF * BK * 2  , STAGE_BYTES = 8 * HTB, NXCD = 8, WGM = 8;

__host__ __device__ __forceinline__ int lds_byte(int r, int c) { const int st = (r >> 4) * 2 + (c >> 5), rr = r & 15, cc = c & 31, ob = rr * 64 + cc * 2; return st * 1024 + (ob ^ (((ob >> 9) & 1) << 5)); }
__host__ __device__ __forceinline__ void stage_rc(int b, int& R, int& C) { const int st = b / 1024, sb = b % 1024, swz = sb ^ (((sb >> 9) & 1) << 5); R = (st >> 1) * 16 + swz / 64; C = (st & 1) * 32 + (swz % 64) / 2; }
__host__ __device__ __forceinline__ int perm32(int rho) { const int n = rho >> 4, i = rho & 15; return 8 * (i >> 2) + 4 * n + (i & 3); }

struct Unit { int pm, pn, pl, e, gb; };
struct Gemm { const bf16_t* A; const bf16_t* Bt; int M, N, K; size_t bstride  ; const int* rowtok  ; };

__device__ __forceinline__ void tile_of(int wgid, int nM, int nN, int& pm, int& pn) {
    const int nwg = nM * nN;
    { const int q = nwg / NXCD, r = nwg % NXCD, xcd = wgid % NXCD, off = wgid / NXCD; wgid = (xcd < r ? xcd * (q + 1) : r * (q + 1) + (xcd - r) * q) + off; }
    const int nig = WGM * nN, gid = wgid / nig, fm = gid * WGM, gsz = (nM - fm) < WGM ? (nM - fm) : WGM;
    pm = fm + ((wgid % nig) % gsz); pn = (wgid % nig) / gsz;
}
struct StaticOrder {
    int nM, nN, nwg, G, c;
    __device__ void init(int M, int N, int G_, int c_) { nM = M / BM; nN = N / BM; nwg = nM * nN; G = G_; c = c_; }
    __device__ __forceinline__ bool next(int i, Unit& u) const {
        const long L = (long)i * G + c; if (L >= nwg) return false;
        int pm, pn; tile_of((int)L, nM, nN, pm, pn); u.pm = pm; u.pn = pn; u.pl = pm; u.e = 0; u.gb = pm * BM; return true;
    }
};
struct MoeOrder {
    int p0, np, nN, nwg, G, c, seg; int ps1, ps2, ps3, ps4, ps5, ps6, ps7;
    __device__ __forceinline__ bool next(int i, Unit& u) const {
        const long L = (long)i * G + c; if (L >= nwg) return false;
        int pm, pn; tile_of((int)L, np, nN, pm, pn); u.pl = pm; u.pn = pn; pm += p0; u.pm = pm;
        const int e = (pm >= ps1) + (pm >= ps2) + (pm >= ps3) + (pm >= ps4) + (pm >= ps5) + (pm >= ps6) + (pm >= ps7);
        int pse = 0; pse = (pm >= ps1) ? ps1 : pse; pse = (pm >= ps2) ? ps2 : pse; pse = (pm >= ps3) ? ps3 : pse; pse = (pm >= ps4) ? ps4 : pse; pse = (pm >= ps5) ? ps5 : pse; pse = (pm >= ps6) ? ps6 : pse; pse = (pm >= ps7) ? ps7 : pse;
        u.e = e; u.gb = e * seg + (pm - pse) * BM; return true;
    }
};

__device__ __forceinline__ unsigned cvt_pk_bf16(float lo, float hi) { unsigned r; asm volatile("v_cvt_pk_bf16_f32 %0, %1, %2" : "=v"(r) : "v"(lo), "v"(hi)); return r; }

constexpr int SIDE_OFF = STAGE_BYTES, SIDE_BYTES = 17 * 1024;
__device__ __forceinline__ void side_dma(const void* gsrc_lane, PG8_LAS unsigned char* ldst_wave) {
    __builtin_amdgcn_global_load_lds((const unsigned*)gsrc_lane, (PG8_LAS unsigned*)ldst_wave, 16, 0, 0);
}
struct EpiBf16 {
    static constexpr bool PERM = true;
    bf16_t* O; int ldc; float oscale = 1.f;
    __device__ __forceinline__ void stage_side(PG8_LAS unsigned char*, const Unit&, int, int) const {}
    __device__ __forceinline__ void operator()(const f32x4 (&acc)[2][2][4][2], const Unit& u, int wr, int wc, int fr, int fq, const PG8_LAS unsigned char* side) const {
        const int row0 = u.pm * BM + wr * 64 + fr, col0 = u.pn * BM + wc * 32 + 8 * fq;
#pragma unroll
        for (int ai = 0; ai < 2; ++ai)
#pragma unroll
            for (int m = 0; m < 4; ++m) { bf16_t* rowp = O + (size_t)(row0 + ai * HALF + m * 16) * ldc + col0;
#pragma unroll
                for (int bj = 0; bj < 2; ++bj) { const f32x4 v0 = acc[ai][bj][m][0] * oscale, v1 = acc[ai][bj][m][1] * oscale;
                    u32x4 w; w.x = cvt_pk_bf16(v0[0], v0[1]); w.y = cvt_pk_bf16(v0[2], v0[3]); w.z = cvt_pk_bf16(v1[0], v1[1]); w.w = cvt_pk_bf16(v1[2], v1[3]);
                    *(u32x4*)(rowp + bj * HALF) = w; } }
    }
};
template <size_t OX, size_t OS1, size_t OS2, size_t OPC>
struct EpiPost {
    static constexpr bool PERM = true;
    static constexpr int ldc = 1024; static constexpr float invd = 1.f / 1024.f, eps = 1e-6f;
    unsigned char* ws; const float* gpost;
    __device__ __forceinline__ void stage_side(PG8_LAS unsigned char*, const Unit&, int, int) const {}
    __device__ __forceinline__ void operator()(const f32x4 (&acc)[2][2][4][2], const Unit& u, int wr, int wc, int fr, int fq, const PG8_LAS unsigned char* side) const {
        PG8_LAS float* red = (PG8_LAS float*)side; PG8_LAS float* gl = red + 1024;
        bf16_t* X = (bf16_t*)(ws + OX); float* s1 = (float*)(ws + OS1); float* s2 = (float*)(ws + OS2); unsigned* pcnt = (unsigned*)(ws + OPC);
        int tid = threadIdx.x, fq_ = fq, fr_ = fr; asm volatile("" : "+v"(tid), "+v"(fq_), "+v"(fr_));
        const int rl0 = wr * 64 + fr_, row0 = u.pm * BM + rl0, col0 = u.pn * BM + wc * 32 + 8 * fq_;
#pragma unroll
        for (int ai = 0; ai < 2; ++ai)
#pragma unroll
            for (int m = 0; m < 4; ++m) {
                const f32x4 q = acc[ai][0][m][0] * acc[ai][0][m][0] + acc[ai][0][m][1] * acc[ai][0][m][1] + acc[ai][1][m][0] * acc[ai][1][m][0] + acc[ai][1][m][1] * acc[ai][1][m][1];
                float s = (q[0] + q[1]) + (q[2] + q[3]); s += __shfl_xor(s, 16); s += __shfl_xor(s, 32);
                if (fq_ == 0) red[(rl0 + ai * HALF + m * 16) * 4 + wc] = s; }
        if (tid < 64) *(PG8_LAS f32x4*)(gl + 4 * tid) = *(const f32x4*)(gpost + u.pn * BM + 4 * tid);
        asm volatile("s_waitcnt lgkmcnt(0)" ::: "memory");
        __builtin_amdgcn_s_barrier();
        if (tid < BM) { const f32x4 p = *(const PG8_LAS f32x4*)(red + 4 * tid);
            __hip_atomic_store(s1 + ((size_t)u.pm * BM + tid) * 4 + u.pn, (p[0] + p[1]) + (p[2] + p[3]), __ATOMIC_RELAXED, __HIP_MEMORY_SCOPE_AGENT); }
        asm volatile("s_waitcnt vmcnt(0) lgkmcnt(0)" ::: "memory");
        __builtin_amdgcn_s_barrier();
        if (tid == 0) { unsigned* c = pcnt + 16 * u.pm;
            __hip_atomic_fetch_add(c, 1u, __ATOMIC_RELAXED, __HIP_MEMORY_SCOPE_AGENT);
            for (int spin = 0; spin < (1 << 22) && __hip_atomic_load(c, __ATOMIC_RELAXED, __HIP_MEMORY_SCOPE_AGENT) < 4u; ++spin) __builtin_amdgcn_s_sleep(1);
            __builtin_amdgcn_fence(__ATOMIC_ACQUIRE, "agent"); }
        asm volatile("s_waitcnt vmcnt(0)" ::: "memory");
        __builtin_amdgcn_s_barrier();
        float rsv[8];
#pragma unroll
        for (int r = 0; r < 8; ++r) { const int row = row0 + (r >> 2) * HALF + (r & 3) * 16;
            const unsigned long long pa = __hip_atomic_load((const unsigned long long*)(s1 + (size_t)row * 4), __ATOMIC_RELAXED, __HIP_MEMORY_SCOPE_AGENT),
                                     pb = __hip_atomic_load((const unsigned long long*)(s1 + (size_t)row * 4 + 2), __ATOMIC_RELAXED, __HIP_MEMORY_SCOPE_AGENT);
            const float tot = (__uint_as_float((unsigned)pa) + __uint_as_float((unsigned)(pa >> 32))) + (__uint_as_float((unsigned)pb) + __uint_as_float((unsigned)(pb >> 32)));
            rsv[r] = __builtin_amdgcn_rsqf(tot * invd + eps); }
        __builtin_amdgcn_sched_barrier(0);
#pragma unroll
        for (int ai = 0; ai < 2; ++ai) {
#pragma unroll
            for (int m = 0; m < 4; ++m) { const int row = row0 + ai * HALF + m * 16; bf16_t* rowp = X + (size_t)row * ldc + col0;
                const float rs = rsv[ai * 4 + m];
                f32x4 q = (f32x4){0.f, 0.f, 0.f, 0.f};
#pragma unroll
                for (int bj = 0; bj < 2; ++bj) { const u32x4 xw = *(const u32x4*)(rowp + bj * HALF);
                    const f32x4 g0 = *(const PG8_LAS f32x4*)(gl + wc * 32 + 8 * fq_ + bj * HALF), g1 = *(const PG8_LAS f32x4*)(gl + wc * 32 + 8 * fq_ + bj * HALF + 4);
                    const f32x4 x0 = (f32x4){__uint_as_float(xw.x << 16), __uint_as_float(xw.x & 0xffff0000u), __uint_as_float(xw.y << 16), __uint_as_float(xw.y & 0xffff0000u)};
                    const f32x4 x1 = (f32x4){__uint_as_float(xw.z << 16), __uint_as_float(xw.z & 0xffff0000u), __uint_as_float(xw.w << 16), __uint_as_float(xw.w & 0xffff0000u)};
                    const f32x4 y0 = x0 + (acc[ai][bj][m][0] * rs) * g0, y1 = x1 + (acc[ai][bj][m][1] * rs) * g1;
                    u32x4 w; w.x = cvt_pk_bf16(y0[0], y0[1]); w.y = cvt_pk_bf16(y0[2], y0[3]); w.z = cvt_pk_bf16(y1[0], y1[1]); w.w = cvt_pk_bf16(y1[2], y1[3]);
                    *(u32x4*)(rowp + bj * HALF) = w;
                    const f32x4 r0 = (f32x4){__uint_as_float(w.x << 16), __uint_as_float(w.x & 0xffff0000u), __uint_as_float(w.y << 16), __uint_as_float(w.y & 0xffff0000u)};
                    const f32x4 r1 = (f32x4){__uint_as_float(w.z << 16), __uint_as_float(w.z & 0xffff0000u), __uint_as_float(w.w << 16), __uint_as_float(w.w & 0xffff0000u)};
                    q += r0 * r0 + r1 * r1; }
                float s = (q[0] + q[1]) + (q[2] + q[3]); s += __shfl_xor(s, 16); s += __shfl_xor(s, 32);
                if (fq_ == 0) red[(rl0 + ai * HALF + m * 16) * 4 + wc] = s; }
            __builtin_amdgcn_sched_barrier(0); }
        asm volatile("s_waitcnt lgkmcnt(0)" ::: "memory");
        __builtin_amdgcn_s_barrier();
        if (tid < BM) { const f32x4 p = *(const PG8_LAS f32x4*)(red + 4 * tid); s2[((size_t)u.pm * BM + tid) * 4 + u.pn] = (p[0] + p[1]) + (p[2] + p[3]); }
        asm volatile("s_waitcnt lgkmcnt(0)" ::: "memory");
        __builtin_amdgcn_s_barrier();
    }
};
struct EpiZ {
    static constexpr bool PERM = true;
    bf16_t* Z; size_t tstride; const float* cosT; const float* sinT; float qscale; const float* rstd;
    __device__ __forceinline__ void stage_side(PG8_LAS unsigned char* side, const Unit& u, int wid, int lane) const {
        if (wid == 0) side_dma(rstd + (size_t)u.pm * BM + 4 * lane, side);
        if (u.pn < 4) { const size_t r0 = ((size_t)u.pm * BM + 32 * wid) * 8 + 4 * lane;
            side_dma(cosT + r0, side + 1024 + wid * 1024); side_dma(sinT + r0, side + 9216 + wid * 1024); }
    }
    __device__ __forceinline__ void operator()(const f32x4 (&acc)[2][2][4][2], const Unit& u, int wr, int wc, int fr, int fq, const PG8_LAS unsigned char* side) const {
        const int t = u.pn >> 1; bf16_t* base = Z + (size_t)t * tstride;
        const int row0 = u.pm * BM + wr * 64 + fr, col0 = (u.pn & 1) * 256 + wc * 32 + 8 * fq;
        const bool rotw = (t < 2) && ((wc & 1) == 0);
        const float sc = (t == 0) ? qscale : 1.f;
#pragma unroll
        for (int ai = 0; ai < 2; ++ai)
#pragma unroll
            for (int m = 0; m < 4; ++m) { const int row = row0 + ai * HALF + m * 16, rl = wr * 64 + fr + ai * HALF + m * 16; const float rs = ((const PG8_LAS float*)side)[rl] * sc;
                f32x4 v[2][2];
#pragma unroll
                for (int bj = 0; bj < 2; ++bj)
#pragma unroll
                    for (int n = 0; n < 2; ++n) v[bj][n] = acc[ai][bj][m][n] * rs;
                if (rotw) {
                    f32x4 c4[2], s4[2];
#pragma unroll
                    for (int n = 0; n < 2; ++n) { c4[n] = *(const PG8_LAS f32x4*)(side + 1024 + rl * 32 + 16 * n); s4[n] = *(const PG8_LAS f32x4*)(side + 9216 + rl * 32 + 16 * n); }
                    const float sg = (fq == 0) ? -1.f : 1.f;
#pragma unroll
                    for (int bj = 0; bj < 2; ++bj)
#pragma unroll
                        for (int n = 0; n < 2; ++n)
#pragma unroll
                            for (int e = 0; e < 4; ++e) { const float mine = v[bj][n][e]; const float other = __shfl_xor(mine, 16);
                                const float r = mine * c4[n][e] + sg * other * s4[n][e]; v[bj][n][e] = (fq < 2) ? r : mine; }
                }
                bf16_t* rowp = base + (size_t)row * 512 + col0;
#pragma unroll
                for (int bj = 0; bj < 2; ++bj) { const f32x4 v0 = v[bj][0], v1 = v[bj][1];
                    u32x4 w; w.x = cvt_pk_bf16(v0[0], v0[1]); w.y = cvt_pk_bf16(v0[2], v0[3]); w.z = cvt_pk_bf16(v1[0], v1[1]); w.w = cvt_pk_bf16(v1[2], v1[3]);
                    *(u32x4*)(rowp + bj * HALF) = w; } }
    }
};
__device__ __forceinline__ float silu_f(float x) { return x * __builtin_amdgcn_rcpf(1.f + __builtin_amdgcn_exp2f(-1.4426950408889634f * x)); }
struct EpiSwiglu {
    static constexpr bool PERM = true;
    bf16_t* O; int ldc; const float* rstd;
    __device__ __forceinline__ void stage_side(PG8_LAS unsigned char* side, const Unit& u, int wid, int lane) const { if (wid == 0) side_dma(rstd + (size_t)u.pl * BM + 4 * lane, side); }
    __device__ __forceinline__ void operator()(const f32x4 (&acc)[2][2][4][2], const Unit& u, int wr, int wc, int fr, int fq, const PG8_LAS unsigned char* side) const {
        const int row0 = u.pl * BM + wr * 64 + fr, col0 = u.pn * HALF + wc * 32 + 8 * fq;
#pragma unroll
        for (int ai = 0; ai < 2; ++ai)
#pragma unroll
            for (int m = 0; m < 4; ++m) { bf16_t* rowp = O + (size_t)(row0 + ai * HALF + m * 16) * ldc + col0; const float rs = ((const PG8_LAS float*)side)[wr * 64 + fr + ai * HALF + m * 16];
                f32x4 v[2];
                const float kg = -1.4426950408889634f * rs, ir2 = __builtin_amdgcn_rcpf(rs * rs);
#pragma unroll
                for (int n = 0; n < 2; ++n) { const f32x4 g = acc[ai][0][m][n], up = acc[ai][1][m][n];
#pragma unroll
                    for (int e = 0; e < 4; ++e) v[n][e] = (g[e] * up[e]) * __builtin_amdgcn_rcpf(__builtin_fmaf(__builtin_amdgcn_exp2f(kg * g[e]), ir2, ir2)); }
                u32x4 w; w.x = cvt_pk_bf16(v[0][0], v[0][1]); w.y = cvt_pk_bf16(v[0][2], v[0][3]); w.z = cvt_pk_bf16(v[1][0], v[1][1]); w.w = cvt_pk_bf16(v[1][2], v[1][3]);
                *(u32x4*)rowp = w; }
    }
};

__device__ __forceinline__ float clamp448(float v) { return __builtin_amdgcn_fmed3f(v, -448.f, 448.f); }
__device__ __forceinline__ unsigned pk4_fp8(float a, float b, float c, float d) { int w = 0; w = __builtin_amdgcn_cvt_pk_fp8_f32(a, b, w, false); w = __builtin_amdgcn_cvt_pk_fp8_f32(c, d, w, true); return (unsigned)w; }
struct EpiSwiglu8 {
    static constexpr bool PERM = true;
    unsigned char* O; int ldc; const float* rstd; float ascale; static constexpr float invd = 1.f / 1024.f, eps = 1e-6f;
    __device__ __forceinline__ void stage_side(PG8_LAS unsigned char* side, const Unit& u, int wid, int lane) const { if (wid < 4) side_dma(rstd + ((size_t)u.pl * BM + 64 * wid) * 4 + 4 * lane, side + wid * 1024); }
    __device__ __forceinline__ void operator()(const f32x4 (&acc)[2][2][4][2], const Unit& u, int wr, int wc, int fr, int fq, const PG8_LAS unsigned char* side) const {
        const int row0 = u.pl * BM + wr * 64 + fr, col0 = u.pn * HALF + wc * 32 + 8 * fq;
        const float ia = 1.f / ascale;
#pragma unroll
        for (int ai = 0; ai < 2; ++ai)
#pragma unroll
            for (int m = 0; m < 4; ++m) { unsigned char* rowp = O + (size_t)(row0 + ai * HALF + m * 16) * ldc + col0; const f32x4 pp = *(const PG8_LAS f32x4*)(side + 16 * (wr * 64 + fr + ai * HALF + m * 16)); const float rs = __builtin_amdgcn_rsqf(((pp[0] + pp[1]) + (pp[2] + pp[3])) * invd + eps);
                f32x4 v[2];
                const float kg = -1.4426950408889634f * rs, ir2 = __builtin_amdgcn_rcpf(rs * rs) * ia;
#pragma unroll
                for (int n = 0; n < 2; ++n) { const f32x4 g = acc[ai][0][m][n], up = acc[ai][1][m][n];
                    const f32x4 t = g * kg; const f32x4 ex = (f32x4){__builtin_amdgcn_exp2f(t[0]), __builtin_amdgcn_exp2f(t[1]), __builtin_amdgcn_exp2f(t[2]), __builtin_amdgcn_exp2f(t[3])};
                    const f32x4 dn = ex * ir2 + ir2; const f32x4 rc = (f32x4){__builtin_amdgcn_rcpf(dn[0]), __builtin_amdgcn_rcpf(dn[1]), __builtin_amdgcn_rcpf(dn[2]), __builtin_amdgcn_rcpf(dn[3])};
                    v[n] = (g * up) * rc; }
                u32x2 w; w.x = pk4_fp8(v[0][0], v[0][1], v[0][2], v[0][3]); w.y = pk4_fp8(v[1][0], v[1][1], v[1][2], v[1][3]);
                *(u32x2*)rowp = w; }
    }
};
struct EpiSwigluF8 {
    static constexpr bool PERM = true;
    unsigned char* O; int ldc; float wscale, ascale;
    __device__ __forceinline__ void stage_side(PG8_LAS unsigned char*, const Unit&, int, int) const {}
    __device__ __forceinline__ void operator()(const f32x4 (&acc)[2][2][4][2], const Unit& u, int wr, int wc, int fr, int fq, const PG8_LAS unsigned char* side) const {
        const int row0 = u.pl * BM + wr * 64 + fr, col0 = u.pn * HALF + wc * 32 + 8 * fq;
        const float ic = 1.f / (wscale * wscale * ascale);
#pragma unroll
        for (int ai = 0; ai < 2; ++ai)
#pragma unroll
            for (int m = 0; m < 4; ++m) { unsigned char* rowp = O + (size_t)(row0 + ai * HALF + m * 16) * ldc + col0;
                f32x4 v[2];
#pragma unroll
                for (int n = 0; n < 2; ++n) { const f32x4 g = acc[ai][0][m][n], up = acc[ai][1][m][n];
                    const f32x4 t = g * (-1.4426950408889634f * wscale); const f32x4 ex = (f32x4){__builtin_amdgcn_exp2f(t[0]), __builtin_amdgcn_exp2f(t[1]), __builtin_amdgcn_exp2f(t[2]), __builtin_amdgcn_exp2f(t[3])};
                    const f32x4 dn = ex * ic + ic; const f32x4 rc = (f32x4){__builtin_amdgcn_rcpf(dn[0]), __builtin_amdgcn_rcpf(dn[1]), __builtin_amdgcn_rcpf(dn[2]), __builtin_amdgcn_rcpf(dn[3])};
                    v[n] = (g * up) * rc; }
                u32x2 w; w.x = pk4_fp8(v[0][0], v[0][1], v[0][2], v[0][3]); w.y = pk4_fp8(v[1][0], v[1][1], v[1][2], v[1][3]);
                *(u32x2*)rowp = w; }
    }
};
struct EpiMoeDown {
    static constexpr bool PERM = true;
    bf16_t* F; size_t kstride; const int* rowtok; const float* rowgate; float oscale;
    __device__ __forceinline__ void stage_side(PG8_LAS unsigned char* side, const Unit& u, int wid, int lane) const {
        if (wid == 0) side_dma(rowtok + (size_t)u.gb + 4 * lane, side);
        if (wid == 1) side_dma(rowgate + (size_t)u.gb + 4 * lane, side + 1024);
    }
    __device__ __forceinline__ void operator()(const f32x4 (&acc)[2][2][4][2], const Unit& u, int wr, int wc, int fr, int fq, const PG8_LAS unsigned char* side) const {
        const int col0 = u.pn * BM + wc * 32 + 8 * fq;
#pragma unroll
        for (int ai = 0; ai < 2; ++ai)
#pragma unroll
            for (int m = 0; m < 4; ++m) { const int sl = wr * 64 + fr + ai * HALF + m * 16; const int tk = ((const PG8_LAS int*)side)[sl]; const float gt = ((const PG8_LAS float*)(side + 1024))[sl] * oscale;
                if (tk >= 0) { bf16_t* rowp = F + (size_t)(tk & 1) * kstride + (size_t)(tk >> 1) * 1024 + col0;
#pragma unroll
                    for (int bj = 0; bj < 2; ++bj) { const f32x4 v0 = acc[ai][bj][m][0] * gt, v1 = acc[ai][bj][m][1] * gt;
                        u32x4 w; w.x = cvt_pk_bf16(v0[0], v0[1]); w.y = cvt_pk_bf16(v0[2], v0[3]); w.z = cvt_pk_bf16(v1[0], v1[1]); w.w = cvt_pk_bf16(v1[2], v1[3]);
                        *(u32x4*)(rowp + bj * HALF) = w; } } }
    }
};

template <class Epi, class Sched, bool GATHER, bool FP8 = false, bool PEEL = false>
__device__ __forceinline__ void gemm_phase(PG8_LAS unsigned char* lds, const Gemm g, const Sched& S, const Epi& E) {
    int tid = threadIdx.x; asm volatile("" : "+v"(tid));
    const int wid = __builtin_amdgcn_readfirstlane(tid >> 6), lane = tid & 63, wr = wid >> 2, wc = wid & 3, fr = lane & 15, fq = lane >> 4;
    const int K = g.K, nt = K / BK;
    unsigned voffB[2]; unsigned vc[2][2], vn[2][2]; int RA[2], CA[2];
#pragma unroll
    for (int i = 0; i < 2; ++i) { int R, C; stage_rc(tid * 16 + i * 8192, R, C); const int Rb = Epi::PERM ? ((R & ~31) + perm32(R & 31)) : R;
        RA[i] = R; CA[i] = C; voffB[i] = (unsigned)(Rb * K + C) * 2u;
        vc[0][i] = vc[1][i] = vn[0][i] = vn[1][i] = (unsigned)(R * K + C) * 2u; }
    const size_t kstep = (size_t)(BK * 2);
    const size_t hstep = (size_t)HALF * K * 2;
    const size_t hstepA = GATHER ? 0 : hstep;
    const size_t tstep = 2 * hstep;
    const unsigned ldsw = (unsigned)wid * 1024u;
    const int aoff = lds_byte(wr * 64 + fr, fq * 8), boff = lds_byte(wc * 32 + fr, fq * 8);
#define PG8_SA(b, h) (((b) * 2 + (h)) * HTB)
#define PG8_SB(b, h) ((4 + (b) * 2 + (h)) * HTB)
#define PG8_STAGE(bufoff, gbase, voff) do { _Pragma("unroll") for (int _i = 0; _i < 2; ++_i) { unsigned _o = (voff)[_i]; asm volatile("" : "+v"(_o));     \
        __builtin_amdgcn_global_load_lds((const unsigned*)((const char*)(gbase) + _o), (PG8_LAS unsigned*)(lds + (bufoff) + ldsw + _i * 8192), 16, 0, 0); } } while (0)
#define PG8_STAGE_A(b, h, P, VO) PG8_STAGE(PG8_SA(b, h), (P) + (h) * hstepA, (VO)[h])
#define PG8_LDA(dst, b, h) do { _Pragma("unroll") for (int m = 0; m < 4; ++m) { dst[m].lo = *(const PG8_LAS v4i_t*)(lds + PG8_SA(b, h) + aoff + m * 2048); dst[m].hi = *(const PG8_LAS v4i_t*)(lds + PG8_SA(b, h) + aoff + m * 2048 + 1024); } } while (0)
#define PG8_LDB(dst, b, h) do { _Pragma("unroll") for (int n = 0; n < 2; ++n) { dst[n].lo = *(const PG8_LAS v4i_t*)(lds + PG8_SB(b, h) + boff + n * 2048); dst[n].hi = *(const PG8_LAS v4i_t*)(lds + PG8_SB(b, h) + boff + n * 2048 + 1024); } } while (0)
#define PG8_MMA(ai, bj, At, Bt) do { __builtin_amdgcn_s_setprio(1); _Pragma("unroll") for (int m = 0; m < 4; ++m) _Pragma("unroll") for (int n = 0; n < 2; ++n) { \
        if constexpr (FP8) asm volatile("v_mfma_scale_f32_16x16x128_f8f6f4 %0, %1, %2, %0, %3, %3 op_sel_hi:[0,0,0]" : "+v"(acc[ai][bj][m][n]) : "v"(Bt[n]), "v"(At[m]), "v"(f8one));     \
        else { const v4i_t blo_ = Bt[n].lo, bhi_ = Bt[n].hi, alo_ = At[m].lo, ahi_ = At[m].hi;     \
               acc[ai][bj][m][n] = __builtin_amdgcn_mfma_f32_16x16x32_bf16(__builtin_bit_cast(bf16x8, blo_), __builtin_bit_cast(bf16x8, alo_), acc[ai][bj][m][n], 0, 0, 0); \
               acc[ai][bj][m][n] = __builtin_amdgcn_mfma_f32_16x16x32_bf16(__builtin_bit_cast(bf16x8, bhi_), __builtin_bit_cast(bf16x8, ahi_), acc[ai][bj][m][n], 0, 0, 0); } } \
        __builtin_amdgcn_s_setprio(0); } while (0)
#define PG8_MMA0(ai, bj, At, Bt) do { __builtin_amdgcn_s_setprio(1); \
        if constexpr (FP8) { _Pragma("unroll") for (int m = 0; m < 4; ++m) _Pragma("unroll") for (int n = 0; n < 2; ++n) \
            asm volatile("v_mfma_scale_f32_16x16x128_f8f6f4 %0, %1, %2, 0, %3, %3 op_sel_hi:[0,0,0]" : "=&v"(acc[ai][bj][m][n]) : "v"(Bt[n]), "v"(At[m]), "v"(f8one)); } \
        else { _Pragma("unroll") for (int m = 0; m < 4; ++m) _Pragma("unroll") for (int n = 0; n < 2; ++n) { const v4i_t blo_ = Bt[n].lo, alo_ = At[m].lo; \
                   asm volatile("v_mfma_f32_16x16x32_bf16 %0, %1, %2, 0" : "=&v"(acc[ai][bj][m][n]) : "v"(blo_), "v"(alo_)); }     \
               _Pragma("unroll") for (int m = 0; m < 4; ++m) _Pragma("unroll") for (int n = 0; n < 2; ++n) { const v4i_t bhi_ = Bt[n].hi, ahi_ = At[m].hi; \
                   acc[ai][bj][m][n] = __builtin_amdgcn_mfma_f32_16x16x32_bf16(__builtin_bit_cast(bf16x8, bhi_), __builtin_bit_cast(bf16x8, ahi_), acc[ai][bj][m][n], 0, 0, 0); } } \
        __builtin_amdgcn_s_setprio(0); } while (0)
#define PG8_WAIT_V(n) asm volatile("s_waitcnt vmcnt(" #n ")" ::: "memory")
#define PG8_WAIT_L(n) asm volatile("s_waitcnt lgkmcnt(" #n ")" ::: "memory")
#define PG8_BAR __builtin_amdgcn_s_barrier()
#define PG8_SCHED __builtin_amdgcn_sched_barrier(0)
#define PG8_GATHER_OFFS(dst, U) do { _Pragma("unroll") for (int _h = 0; _h < 2; ++_h) _Pragma("unroll") for (int _i = 0; _i < 2; ++_i) { \
        int _tk = g.rowtok[(U).gb + _h * HALF + RA[_i]]; _tk = _tk < 0 ? 0 : (_tk >> 1); dst[_h][_i] = (unsigned)(_tk * K + CA[_i]) * 2u; } } while (0)
    Unit cur, nxt; int ui = 0;
    if (!S.next(0, cur)) return;
    f32x4 acc[2][2][4][2];
    if constexpr (!PEEL) {
#pragma unroll
    for (int a = 0; a < 2; ++a)
#pragma unroll
        for (int b = 0; b < 2; ++b)
#pragma unroll
            for (int m = 0; m < 4; ++m)
#pragma unroll
                for (int n = 0; n < 2; ++n) acc[a][b][m][n] = (f32x4){0.f, 0.f, 0.f, 0.f};
    }
    const int f8one = 0x7F7F7F7F;
    v8i_t At[4], B0[2], B1[2];
    if constexpr (GATHER) PG8_GATHER_OFFS(vc, cur);
    const char* cA = (const char*)g.A + (GATHER ? (size_t)0 : (size_t)cur.pl * tstep); const char* cB = (const char*)g.Bt + (size_t)cur.e * g.bstride + (size_t)cur.pn * tstep;
    PG8_STAGE(PG8_SB(0, 0), cB, voffB); PG8_STAGE(PG8_SB(0, 1), cB + hstep, voffB); PG8_STAGE_A(0, 0, cA, vc); PG8_STAGE_A(0, 1, cA, vc);
    if (wr == 1) PG8_BAR;
    PG8_WAIT_V(2); PG8_BAR;
    PG8_STAGE(PG8_SB(1, 0), cB + kstep, voffB); PG8_STAGE_A(1, 0, cA + kstep, vc); PG8_STAGE(PG8_SB(1, 1), cB + hstep + kstep, voffB);
    PG8_WAIT_V(6); PG8_BAR;
#pragma nounroll
    for (;;) {
        const bool has_next = S.next(ui + 1, nxt);
        const char* nA = has_next ? (const char*)g.A + (GATHER ? (size_t)0 : (size_t)nxt.pl * tstep) : cA;
        const char* nB = has_next ? (const char*)g.Bt + (size_t)nxt.e * g.bstride + (size_t)nxt.pn * tstep : cB;
        if constexpr (GATHER) { if (has_next) PG8_GATHER_OFFS(vn, nxt); else { _Pragma("unroll") for (int _h = 0; _h < 2; ++_h) _Pragma("unroll") for (int _i = 0; _i < 2; ++_i) vn[_h][_i] = vc[_h][_i]; } }
        if constexpr (PEEL) {
            const int t = 0;
            const bool last = (t == nt - 2);
            const char* a1 = cA + (size_t)(t + 1) * kstep;
            const char* a2 = last ? nA : cA + (size_t)(t + 2) * kstep; const char* b2 = last ? nB : cB + (size_t)(t + 2) * kstep;
            const char* a3 = a2 + kstep; const char* b3 = b2 + kstep;
            unsigned v2[2][2];
#pragma unroll
            for (int _h = 0; _h < 2; ++_h)
#pragma unroll
                for (int _i = 0; _i < 2; ++_i) v2[_h][_i] = (GATHER && last) ? vn[_h][_i] : vc[_h][_i];
            if (t == 2) E.stage_side(lds + SIDE_OFF, cur, wid, lane);
            PG8_LDB(B0, 0, 0); PG8_LDB(B1, 0, 1); PG8_SCHED; PG8_LDA(At, 0, 0); PG8_STAGE_A(1, 1, a1, vc);
            PG8_WAIT_V(8); PG8_WAIT_L(0); PG8_BAR; PG8_MMA0(0, 0, At, B0); PG8_MMA0(0, 1, At, B1); PG8_BAR; PG8_SCHED;
            PG8_LDA(At, 0, 1); PG8_STAGE(PG8_SB(0, 0), b2, voffB); PG8_STAGE(PG8_SB(0, 1), b2 + hstep, voffB); PG8_STAGE_A(0, 0, a2, v2);
            PG8_WAIT_V(8); PG8_WAIT_L(0); PG8_BAR; PG8_MMA0(1, 0, At, B0); PG8_MMA0(1, 1, At, B1); PG8_BAR; PG8_SCHED;
            PG8_LDB(B0, 1, 0); PG8_LDB(B1, 1, 1); PG8_SCHED; PG8_LDA(At, 1, 0); PG8_STAGE_A(0, 1, a2, v2);
            PG8_WAIT_V(8); PG8_WAIT_L(0); PG8_BAR; PG8_MMA(0, 0, At, B0); PG8_MMA(0, 1, At, B1); PG8_BAR; PG8_SCHED;
            PG8_LDA(At, 1, 1); PG8_STAGE(PG8_SB(1, 0), b3, voffB); PG8_STAGE(PG8_SB(1, 1), b3 + hstep, voffB); PG8_STAGE_A(1, 0, a3, v2);
            PG8_WAIT_V(8); PG8_WAIT_L(0); PG8_BAR; PG8_MMA(1, 0, At, B0); PG8_MMA(1, 1, At, B1); PG8_BAR; PG8_SCHED;
        }
#pragma nounroll
        for (int t = PEEL ? 2 : 0; t < nt; t += 2) {
            const bool last = (t == nt - 2);
            const char* a1 = cA + (size_t)(t + 1) * kstep;
            const char* a2 = last ? nA : cA + (size_t)(t + 2) * kstep; const char* b2 = last ? nB : cB + (size_t)(t + 2) * kstep;
            const char* a3 = a2 + kstep; const char* b3 = b2 + kstep;
            unsigned v2[2][2];
#pragma unroll
            for (int _h = 0; _h < 2; ++_h)
#pragma unroll
                for (int _i = 0; _i < 2; ++_i) v2[_h][_i] = (GATHER && last) ? vn[_h][_i] : vc[_h][_i];
            if (t == 2) E.stage_side(lds + SIDE_OFF, cur, wid, lane);
            PG8_LDB(B0, 0, 0); PG8_LDB(B1, 0, 1); PG8_SCHED; PG8_LDA(At, 0, 0); PG8_STAGE_A(1, 1, a1, vc);
            PG8_WAIT_V(8); PG8_WAIT_L(0); PG8_BAR; PG8_MMA(0, 0, At, B0); PG8_MMA(0, 1, At, B1); PG8_BAR; PG8_SCHED;
            PG8_LDA(At, 0, 1); PG8_STAGE(PG8_SB(0, 0), b2, voffB); PG8_STAGE(PG8_SB(0, 1), b2 + hstep, voffB); PG8_STAGE_A(0, 0, a2, v2);
            PG8_WAIT_V(8); PG8_WAIT_L(0); PG8_BAR; PG8_MMA(1, 0, At, B0); PG8_MMA(1, 1, At, B1); PG8_BAR; PG8_SCHED;
            PG8_LDB(B0, 1, 0); PG8_LDB(B1, 1, 1); PG8_SCHED; PG8_LDA(At, 1, 0); PG8_STAGE_A(0, 1, a2, v2);
            PG8_WAIT_V(8); PG8_WAIT_L(0); PG8_BAR; PG8_MMA(0, 0, At, B0); PG8_MMA(0, 1, At, B1); PG8_BAR; PG8_SCHED;
            PG8_LDA(At, 1, 1); PG8_STAGE(PG8_SB(1, 0), b3, voffB); PG8_STAGE(PG8_SB(1, 1), b3 + hstep, voffB); PG8_STAGE_A(1, 0, a3, v2);
            PG8_WAIT_V(8); PG8_WAIT_L(0); PG8_BAR; PG8_MMA(1, 0, At, B0); PG8_MMA(1, 1, At, B1); PG8_BAR; PG8_SCHED;
        }
        if constexpr (FP8) asm volatile("s_nop 15\n\ts_nop 15" ::: "memory");
        if (wr == 0) PG8_BAR;
        E(acc, cur, wr, wc, fr, fq, lds + SIDE_OFF);
        if (!has_next) break;
        if constexpr (!PEEL) {
#pragma unroll
        for (int a = 0; a < 2; ++a)
#pragma unroll
            for (int b = 0; b < 2; ++b)
#pragma unroll
                for (int m = 0; m < 4; ++m)
#pragma unroll
                    for (int n = 0; n < 2; ++n) acc[a][b][m][n] = (f32x4){0.f, 0.f, 0.f, 0.f};
        }
        cur = nxt; cA = nA; cB = nB; ++ui;
        if constexpr (GATHER) { _Pragma("unroll") for (int _h = 0; _h < 2; ++_h) _Pragma("unroll") for (int _i = 0; _i < 2; ++_i) vc[_h][_i] = vn[_h][_i]; }
        if (wr == 1) PG8_BAR;
    }
    PG8_WAIT_V(0);
    PG8_BAR;
#undef PG8_SA
#undef PG8_SB
#undef PG8_STAGE
#undef PG8_STAGE_A
#undef PG8_LDA
#undef PG8_LDB
#undef PG8_MMA
#undef PG8_MMA0
#undef PG8_WAIT_V
#undef PG8_WAIT_L
#undef PG8_BAR
#undef PG8_SCHED
#undef PG8_GATHER_OFFS
}
}
constexpr int NWAVES = 8;
constexpr int BATCH = 4, SEQ = 8192, D = 1024, T = BATCH * SEQ;
constexpr int AW = 512, NH = 8, HD = 64, LW = 512, INC = 2560, FF = 3584, NE = 8;
constexpr float RMS_EPS = 1e-6f;
constexpr float QSCALE = 0.125f * 1.4426950408889634f;
constexpr int MAXPAN = 264;
constexpr int CHPAN = 146;
constexpr float MOE_WGU_SCALE = 32.f, MOE_WD_SCALE = 64.f, MOE_ACT_SCALE = 16.f;

constexpr size_t MiB = 1u << 20;
constexpr size_t WS_CTL = 0, CTL_ZERO_BYTES = 1 * MiB;
constexpr size_t WS_SUM = 1 * MiB;
constexpr size_t WS_TOKE = 3 * MiB, WS_TOKP = WS_TOKE + 256 * 1024, WS_TOKR = WS_TOKP + 256 * 1024;
constexpr size_t WS_RSTDA = 513 * MiB, WS_RSTDF = WS_RSTDA + 128 * 1024;
constexpr size_t WS_CCV = 3 * MiB;
constexpr size_t WS_ROWTOK = 514 * MiB, WS_ROWGATE = 515 * MiB;
constexpr size_t WS_WFR = 4 * MiB + 640 * 1024;
constexpr size_t WS_ROPE = 5 * MiB;
constexpr size_t WS_LSE = 7 * MiB;
constexpr size_t WS_WIN = 10 * MiB, WS_WOUT = 20 * MiB, WS_WGU = 24 * MiB, WS_WD = 38 * MiB;
constexpr size_t WS_RA = 45 * MiB;
constexpr size_t WS_RB = 109 * MiB;
constexpr size_t WS_RC = 269 * MiB;
constexpr size_t WS_MOEW = 365 * MiB;
constexpr size_t WS_XB = 449 * MiB;
constexpr size_t WS_END = 533 * MiB;
constexpr size_t WS_ACTM = WS_RB, WS_FSLOT = WS_RB + 128 * MiB;
static_assert((size_t)CHPAN * 256 * FF <= 128 * MiB && WS_FSLOT + 128 * MiB <= WS_MOEW && WS_RB + 224 * MiB <= WS_MOEW && WS_RC + 96 * MiB <= WS_MOEW && WS_MOEW + 84 * MiB <= WS_XB && WS_XB + 64 * MiB <= WS_END, "ws map");
constexpr int CW_BAR = 4096;
constexpr int CW_LRU = 20480;
constexpr int CW_PCNT = 24576;
constexpr size_t WS_S1 = WS_LSE, WS_S2 = WS_LSE + 1 * MiB;
constexpr int CW_CNT = 16384;

constexpr int LDS_BYTES = 159744;
constexpr int LDSCTL_OFF = 158720;

#define GAS __attribute__((address_space(1)))
#define LAS __attribute__((address_space(3)))
typedef unsigned short bf16;
typedef unsigned v4u __attribute__((ext_vector_type(4)));
typedef unsigned v2u __attribute__((ext_vector_type(2)));
typedef float f32x4 __attribute__((ext_vector_type(4)));
typedef float f32x2 __attribute__((ext_vector_type(2)));
typedef float f32x16 __attribute__((ext_vector_type(16)));
typedef short bf16x8 __attribute__((ext_vector_type(8)));
typedef short v4i16_t __attribute__((ext_vector_type(4)));
typedef GAS unsigned gu32;
#define RLX_AGENT __ATOMIC_RELAXED, __HIP_MEMORY_SCOPE_AGENT
#define LDS_WAIT() asm volatile("s_waitcnt lgkmcnt(0)" ::: "memory")
#define VM_WAIT() asm volatile("s_waitcnt vmcnt(0)" ::: "memory")
__device__ __forceinline__ unsigned f2bf(float f) { unsigned u = __builtin_bit_cast(unsigned, f); return (u + 0x7fffu + ((u >> 16) & 1u)) >> 16; }
__device__ __forceinline__ unsigned pk2(float lo, float hi) { typedef float f2_t __attribute__((ext_vector_type(2))); typedef __bf16 b2_t __attribute__((ext_vector_type(2))); const f2_t v = {lo, hi}; return __builtin_bit_cast(unsigned, __builtin_convertvector(v, b2_t)); }
__device__ __forceinline__ float bf_lo(unsigned w) { return __builtin_bit_cast(float, w << 16); }
__device__ __forceinline__ float bf_hi(unsigned w) { return __builtin_bit_cast(float, w & 0xffff0000u); }

#define XB_TMO      128
#define XB_XCNT(j)  (256  + 64 * (j))
#define XB_XSUB(j)  (1280 + 64 * (j))
#define XB_XGEN(j)  (2304 + 64 * (j))
#define XB_TOP      3328
#define XB_TOPGEN   3392
#define XCD_BAR_WORDS 3456
#define XB_SPIN_CAP (1u << 18)

__device__ __forceinline__ unsigned xb_ld(unsigned* p)              { return __hip_atomic_load(p, __ATOMIC_RELAXED, __HIP_MEMORY_SCOPE_AGENT); }
__device__ __forceinline__ unsigned xb_add(unsigned* p, unsigned v) { return __hip_atomic_fetch_add(p, v, __ATOMIC_RELAXED, __HIP_MEMORY_SCOPE_AGENT); }
__device__ __forceinline__ unsigned xb_xcc_id() { return (unsigned)__builtin_amdgcn_s_getreg((3 << 11) | 20) & 0xFu; }
#define XB_SPIN(cond, bar) do { unsigned _sp = 0; while (cond) { __builtin_amdgcn_s_sleep(1); \
    if ((++_sp & 255u) == 0u) { if (xb_ld(&(bar)[XB_TMO])) break; if (_sp > XB_SPIN_CAP) { atomicAdd(&(bar)[XB_TMO], 1u); break; } } } } while (0)

struct XcdBarrier {
    unsigned* bar; unsigned x;
    volatile LAS unsigned* st;
};
__device__ __forceinline__ XcdBarrier xcd_barrier_post(unsigned* bar, volatile LAS unsigned* st) {
    XcdBarrier b; b.bar = bar; b.x = xb_xcc_id(); b.st = st;
    if (threadIdx.x == 0) (void)xb_add(&bar[XB_XCNT(b.x)], 1u);
    return b;
}
__device__ __forceinline__ void xcd_barrier_complete(unsigned* bar, unsigned x, unsigned& nloc, unsigned& nx) {
    const unsigned G = gridDim.x * gridDim.y * gridDim.z;
    unsigned sum, cnt, mine, sp = 0u;
    for (;;) {
        sum = 0u; cnt = 0u; mine = 0u;
#pragma unroll
        for (unsigned j = 0; j < 16; ++j) { const unsigned c = xb_ld(&bar[XB_XCNT(j)]); sum += c; cnt += (c > 0u) ? 1u : 0u; mine = (j == x) ? c : mine; }
        if (sum == G) break;
        __builtin_amdgcn_s_sleep(1);
        if ((++sp & 255u) == 0u) { if (xb_ld(&bar[XB_TMO])) break; if (sp > XB_SPIN_CAP) { atomicAdd(&bar[XB_TMO], 1u); break; } }
    }
    nloc = mine > 0u ? mine : 1u; nx = cnt > 0u ? cnt : 1u;
}
__device__ __forceinline__ void xcd_barrier(const XcdBarrier& b) {
    asm volatile("s_waitcnt vmcnt(0)" ::: "memory");
    __syncthreads();
    if (threadIdx.x == 0) {
        unsigned* bar = b.bar; { const unsigned long long u_ = (unsigned long long)bar; bar = (unsigned*)(((unsigned long long)(unsigned)__builtin_amdgcn_readfirstlane((int)(u_ >> 32)) << 32) | (unsigned)__builtin_amdgcn_readfirstlane((int)u_)); } asm volatile("" : "+s"(bar));
        __builtin_amdgcn_s_waitcnt(0);
        unsigned nloc = b.st[0], nx = b.st[1];
        unsigned bx_ = b.x; asm volatile("" : "+s"(bx_));
        if (nloc == 0u) { xcd_barrier_complete(bar, bx_, nloc, nx); b.st[0] = nloc; b.st[1] = nx; }
        const unsigned old = xb_add(&bar[XB_XSUB(bx_)], 1u);
        const unsigned gen = old / nloc;
        if (old + 1u == (gen + 1u) * nloc) {
            __builtin_amdgcn_fence(__ATOMIC_RELEASE, "agent");
            asm volatile("s_waitcnt vmcnt(0)" ::: "memory");
            const unsigned og = xb_add(&bar[XB_TOP], 1u);
            const unsigned tg = og / nx;
            if (og + 1u == (tg + 1u) * nx) xb_add(&bar[XB_TOPGEN], 1u);
            else XB_SPIN(xb_ld(&bar[XB_TOPGEN]) == tg, bar);
            __builtin_amdgcn_fence(__ATOMIC_ACQUIRE, "agent");
            xb_add(&bar[XB_XGEN(bx_)], 1u);
            asm volatile("s_waitcnt vmcnt(0)" ::: "memory");
        } else {
            XB_SPIN(xb_ld(&bar[XB_XGEN(bx_)]) == gen, bar);
            __builtin_amdgcn_fence(__ATOMIC_ACQUIRE, "agent");
            asm volatile("s_waitcnt vmcnt(0)" ::: "memory");
        }
    }
    __syncthreads();
}

struct Args {
    const float* x; const int* pos; const float* pre_mix_g; const float* w_in; const float* conv_w; const float* conv_b;
    const float* w_rgate; const float* b_rgate; const float* w_igate; const float* b_igate; const float* lam;
    const float* attn_out_g; const float* lru_out_g; const float* w_out; const float* post_mix_g; const float* pre_ffn_g; const float* post_ffn_g;
    const float* dw_gate; const float* dw_up; const float* dw_down; const float* router_w; const float* mw_gate; const float* mw_up; const float* mw_down;
    float* out; unsigned char* ws;
};
struct Frame {
    LAS unsigned char* lds;
    int vcu, G;
};
#define DPP_ADD(v, ctrl) ((v) + __builtin_bit_cast(float, __builtin_amdgcn_update_dpp(0, __builtin_bit_cast(int, (v)), (ctrl), 0xF, 0xF, true)))
__device__ __forceinline__ float wave_sum(float v) {
    v = DPP_ADD(v, 0xB1);
    v = DPP_ADD(v, 0x4E);
    v = DPP_ADD(v, 0x141);
    v = DPP_ADD(v, 0x140);
    const int b = __builtin_bit_cast(int, v);
    const float r0 = __builtin_bit_cast(float, __builtin_amdgcn_readlane(b, 0)), r1 = __builtin_bit_cast(float, __builtin_amdgcn_readlane(b, 16));
    const float r2 = __builtin_bit_cast(float, __builtin_amdgcn_readlane(b, 32)), r3 = __builtin_bit_cast(float, __builtin_amdgcn_readlane(b, 48));
    return (r0 + r1) + (r2 + r3);
}
__device__ __forceinline__ void p0_transpose_item(const float* W, int K, int N, bf16* WT, int k0, int n0, int drow0, LAS float* scr, int lane) {
    float ld_[32];
#pragma unroll
    for (int i = 0; i < 32; ++i) { const int kk = 2 * i + (lane >> 5); ld_[i] = W[(size_t)(k0 + kk) * N + n0 + (lane & 31)]; }
#pragma unroll
    for (int i = 0; i < 32; ++i) { const int kk = 2 * i + (lane >> 5); scr[kk * 33 + (lane & 31)] = ld_[i]; }
    LDS_WAIT(); asm volatile("" ::: "memory");
    const int c = lane & 7;
#pragma unroll
    for (int j = 0; j < 4; ++j) { const int n = (lane >> 3) + 8 * j; const LAS float* s = scr + (8 * c) * 33 + n;
        v4u o; o.x = pk2(s[0 * 33], s[1 * 33]); o.y = pk2(s[2 * 33], s[3 * 33]); o.z = pk2(s[4 * 33], s[5 * 33]); o.w = pk2(s[6 * 33], s[7 * 33]);
        *(GAS v4u*)(WT + (size_t)(drow0 + n) * K + k0 + 8 * c) = o; }
    LDS_WAIT(); asm volatile("" ::: "memory");
}
__device__ __forceinline__ unsigned pk4f8(float a, float b, float c, float d) { int w = 0; w = __builtin_amdgcn_cvt_pk_fp8_f32(a, b, w, false); w = __builtin_amdgcn_cvt_pk_fp8_f32(c, d, w, true); return (unsigned)w; }
__device__ __forceinline__ void p0_transpose_item_f8(const float* W, int K, int N, unsigned char* WT, int k0, int n0, int drow0, float scale, LAS float* scr, int lane) {
    float ld_[64];
#pragma unroll
    for (int i = 0; i < 64; ++i) { const int kk = 2 * i + (lane >> 5); ld_[i] = W[(size_t)(k0 + kk) * N + n0 + (lane & 31)]; }
#pragma unroll
    for (int i = 0; i < 64; ++i) { const int kk = 2 * i + (lane >> 5); scr[kk * 33 + (lane & 31)] = ld_[i]; }
    LDS_WAIT(); asm volatile("" ::: "memory");
    const int c = lane & 7;
#pragma unroll
    for (int j = 0; j < 4; ++j) { const int n = (lane >> 3) + 8 * j; const LAS float* s = scr + (16 * c) * 33 + n;
        v4u o; o.x = pk4f8(s[0 * 33] * scale, s[1 * 33] * scale, s[2 * 33] * scale, s[3 * 33] * scale); o.y = pk4f8(s[4 * 33] * scale, s[5 * 33] * scale, s[6 * 33] * scale, s[7 * 33] * scale);
        o.z = pk4f8(s[8 * 33] * scale, s[9 * 33] * scale, s[10 * 33] * scale, s[11 * 33] * scale); o.w = pk4f8(s[12 * 33] * scale, s[13 * 33] * scale, s[14 * 33] * scale, s[15 * 33] * scale);
        *(GAS v4u*)(WT + (size_t)(drow0 + n) * K + k0 + 16 * c) = o; }
    LDS_WAIT(); asm volatile("" ::: "memory");
}
__device__ __forceinline__ void tr_plain_f8(const float* W, int K, int N, unsigned char* WT, int item, float scale, LAS float* scr, int lane) {
    const int nblk = N / 32, kb = item / nblk, nb = item % nblk; p0_transpose_item_f8(W, K, N, WT, 128 * kb, 32 * nb, 32 * nb, scale, scr, lane);
}
__device__ __forceinline__ void tr_gu_f8(const float* W, unsigned char* WT, int isup, int item, float scale, LAS float* scr, int lane) {
    const int nblk = FF / 32, kb = item / nblk, nb = item % nblk, n0 = 32 * nb; p0_transpose_item_f8(W, D, FF, WT, 128 * kb, n0, 256 * (n0 >> 7) + 128 * isup + (n0 & 127), scale, scr, lane);
}
__device__ __forceinline__ void tr_plain(const float* W, int K, int N, bf16* WT, int item, LAS float* scr, int lane) {
    const int nblk = N / 32, kb = item / nblk, nb = item % nblk; p0_transpose_item(W, K, N, WT, 64 * kb, 32 * nb, 32 * nb, scr, lane);
}
__device__ __forceinline__ void tr_gu(const float* W, bf16* WT, int isup, int item, LAS float* scr, int lane) {
    const int nblk = FF / 32, kb = item / nblk, nb = item % nblk, n0 = 32 * nb; p0_transpose_item(W, D, FF, WT, 64 * kb, n0, 256 * (n0 >> 7) + 128 * isup + (n0 & 127), scr, lane);
}
template <bool F8>
__device__ __forceinline__ void coop_item(const float* W, int K, int N, void* WT, int k0, int n0, int GU, float scale, LAS unsigned char* lds, int wave, int lane, const float* gk = nullptr) {
    LAS float* tl = (LAS float*)lds;
    float ld_[64];
#pragma unroll
    for (int r = 0; r < 16; ++r) { const float gr = gk ? gk[k0 + 16 * wave + r] : 1.f;
#pragma unroll
        for (int j = 0; j < 4; ++j) ld_[4 * r + j] = W[(size_t)(k0 + 16 * wave + r) * N + n0 + lane + 64 * j] * gr; }
#pragma unroll
    for (int r = 0; r < 16; ++r)
#pragma unroll
        for (int j = 0; j < 4; ++j) tl[(16 * wave + r) * 257 + lane + 64 * j] = ld_[4 * r + j];
    __syncthreads();
    if (F8) {
        const int c = lane & 7;
#pragma unroll
        for (int it = 0; it < 4; ++it) { const int nl = 32 * wave + 8 * it + (lane >> 3), n = n0 + nl; const LAS float* s = tl + (16 * c) * 257 + nl;
            const int drow = (GU < 0) ? n : 256 * (n >> 7) + 128 * GU + (n & 127);
            v4u o; o.x = pk4f8(s[0 * 257] * scale, s[1 * 257] * scale, s[2 * 257] * scale, s[3 * 257] * scale); o.y = pk4f8(s[4 * 257] * scale, s[5 * 257] * scale, s[6 * 257] * scale, s[7 * 257] * scale);
            o.z = pk4f8(s[8 * 257] * scale, s[9 * 257] * scale, s[10 * 257] * scale, s[11 * 257] * scale); o.w = pk4f8(s[12 * 257] * scale, s[13 * 257] * scale, s[14 * 257] * scale, s[15 * 257] * scale);
            *(GAS v4u*)((unsigned char*)WT + (size_t)drow * K + k0 + 16 * c) = o; }
    } else {
        const int c = lane & 15;
#pragma unroll
        for (int it = 0; it < 8; ++it) { const int nl = 32 * wave + 4 * it + (lane >> 4), n = n0 + nl; const LAS float* s = tl + (8 * c) * 257 + nl;
            const int drow = (GU < 0) ? n : 256 * (n >> 7) + 128 * GU + (n & 127);
            v4u o; o.x = pk2(s[0 * 257], s[1 * 257]); o.y = pk2(s[2 * 257], s[3 * 257]); o.z = pk2(s[4 * 257], s[5 * 257]); o.w = pk2(s[6 * 257], s[7 * 257]);
            *(GAS v4u*)((bf16*)WT + (size_t)drow * K + k0 + 8 * c) = o; }
    }
    __syncthreads();
}
constexpr int WGAIN_OFF = 135168;
struct WItem { const float* W; unsigned char* WT; int K, N, k0, n0, GU, f8, gko; float scale; };
struct WRegs { float v[64]; };
__device__ __forceinline__ void w_load(const WItem& q, WRegs& r, int wave, int lane) {
    const GAS float* src = (const GAS float*)q.W + (size_t)(q.k0 + 16 * wave) * q.N + q.n0 + lane;
#pragma unroll
    for (int i = 0; i < 16; ++i)
#pragma unroll
        for (int j = 0; j < 4; ++j) r.v[4 * i + j] = src[(size_t)i * q.N + 64 * j];
}
__device__ __forceinline__ void w_finish(const WItem& q, WRegs& r, LAS unsigned char* lds, int wave, int lane) {
    LAS float* tl = (LAS float*)lds;
    if (q.gko >= 0) {
        const LAS float* gl = (const LAS float*)(lds + WGAIN_OFF) + q.gko + q.k0 + 16 * wave;
#pragma unroll
        for (int i = 0; i < 16; ++i) { const float gi = gl[i];
#pragma unroll
            for (int j = 0; j < 4; ++j) tl[(16 * wave + i) * 257 + lane + 64 * j] = r.v[4 * i + j] * gi; }
    } else {
#pragma unroll
        for (int i = 0; i < 16; ++i)
#pragma unroll
            for (int j = 0; j < 4; ++j) tl[(16 * wave + i) * 257 + lane + 64 * j] = r.v[4 * i + j];
    }
    LDS_WAIT(); __builtin_amdgcn_s_barrier();
    const int K = q.K, GU = q.GU;
    if (q.f8) {
        const float scale = q.scale;
#pragma unroll
        for (int it = 0; it < 4; ++it) { const int c = (lane >> 4) + 4 * (it & 1), nl = 32 * wave + 16 * (it >> 1) + (lane & 15), n = q.n0 + nl; const LAS float* s = tl + (16 * c) * 257 + nl;
            const int drow = (GU < 0) ? n : 256 * (n >> 7) + 128 * GU + (n & 127);
            v4u o; o.x = pk4f8(s[0 * 257] * scale, s[1 * 257] * scale, s[2 * 257] * scale, s[3 * 257] * scale); o.y = pk4f8(s[4 * 257] * scale, s[5 * 257] * scale, s[6 * 257] * scale, s[7 * 257] * scale);
            o.z = pk4f8(s[8 * 257] * scale, s[9 * 257] * scale, s[10 * 257] * scale, s[11 * 257] * scale); o.w = pk4f8(s[12 * 257] * scale, s[13 * 257] * scale, s[14 * 257] * scale, s[15 * 257] * scale);
            *(GAS v4u*)(q.WT + (size_t)drow * K + q.k0 + 16 * c) = o; }
    } else {
#pragma unroll
        for (int it = 0; it < 8; ++it) { const int c = (lane >> 3) + 8 * (it & 1), nl = 32 * wave + 8 * (it >> 1) + (lane & 7), n = q.n0 + nl; const LAS float* s = tl + (8 * c) * 257 + nl;
            const int drow = (GU < 0) ? n : 256 * (n >> 7) + 128 * GU + (n & 127);
            v4u o; o.x = pk2(s[0 * 257], s[1 * 257]); o.y = pk2(s[2 * 257], s[3 * 257]); o.z = pk2(s[4 * 257], s[5 * 257]); o.w = pk2(s[6 * 257], s[7 * 257]);
            *(GAS v4u*)((bf16*)q.WT + (size_t)drow * K + q.k0 + 8 * c) = o; }
    }
    LDS_WAIT(); __builtin_amdgcn_s_barrier();
}
__device__ __forceinline__ void rms_store_bf16(const f32x4 (&v)[4], const float* g, bf16* orow, int lane) {
    float s = 0.f;
#pragma unroll
    for (int j = 0; j < 4; ++j) s += (v[j].x * v[j].x + v[j].y * v[j].y) + (v[j].z * v[j].z + v[j].w * v[j].w);
    const float rstd = __builtin_amdgcn_rsqf(wave_sum(s) * (1.f / D) + RMS_EPS);
    GAS unsigned long long* o8 = (GAS unsigned long long*)orow + lane;
#pragma unroll
    for (int j = 0; j < 4; ++j) { const f32x4 gg = *((const GAS f32x4*)g + lane + 64 * j);
        o8[64 * j] = (unsigned long long)pk2(v[j].x * rstd * gg.x, v[j].y * rstd * gg.y) | ((unsigned long long)pk2(v[j].z * rstd * gg.z, v[j].w * rstd * gg.w) << 32); }
}
template <class S, class L, class P>
__device__ __forceinline__ void row_pipe(int r0, int step, int end, L load, P proc) {
    if (r0 >= end) return;
    const int last = r0 + ((end - 1 - r0) / step) * step;
#define RP_CL(x) ((x) < last ? (x) : last)
    S s0, s1, s2, s3;
    load(r0, s0); load(RP_CL(r0 + step), s1); load(RP_CL(r0 + 2 * step), s2);
    for (int r = r0; ; r += 4 * step) {
        load(RP_CL(r + 3 * step), s3);
        proc(r, s0);
        if (r + step > last) break;
        load(RP_CL(r + 4 * step), s0);
        proc(r + step, s1);
        if (r + 2 * step > last) break;
        load(RP_CL(r + 5 * step), s1);
        proc(r + 2 * step, s2);
        if (r + 3 * step > last) break;
        load(RP_CL(r + 6 * step), s2);
        proc(r + 3 * step, s3);
        if (r + 4 * step > last) break;
    }
#undef RP_CL
}
struct Gain4 { f32x4 g[4]; };
__device__ __forceinline__ Gain4 ld_gain(const float* g, int lane) { Gain4 r;
#pragma unroll
    for (int j = 0; j < 4; ++j) r.g[j] = *((const GAS f32x4*)g + lane + 64 * j);
    return r; }
struct RawRow { v2u a[4]; };
__device__ __forceinline__ void ld_raw(const bf16* row, RawRow& r, int lane) {
    const GAS v2u* r8 = (const GAS v2u*)row + lane;
#pragma unroll
    for (int j = 0; j < 4; ++j) r.a[j] = r8[64 * j];
}
__device__ __forceinline__ void unpack_raw(const RawRow& r, f32x4 (&v)[4]) {
#pragma unroll
    for (int j = 0; j < 4; ++j) v[j] = (f32x4){bf_lo(r.a[j].x), bf_hi(r.a[j].x), bf_lo(r.a[j].y), bf_hi(r.a[j].y)};
}
__device__ __forceinline__ void load_bf16_row(const bf16* row, f32x4 (&v)[4], int lane) {
    const GAS v2u* r8 = (const GAS v2u*)row + lane;
#pragma unroll
    for (int j = 0; j < 4; ++j) { const v2u w = r8[64 * j]; v[j] = (f32x4){bf_lo(w.x), bf_hi(w.x), bf_lo(w.y), bf_hi(w.y)}; }
}
namespace att {
constexpr int KSLOT = 16384, VRING = 4 * KSLOT, RING = 8 * KSLOT;
static_assert(RING <= LDSCTL_OFF, "attention LDS");
__device__ __forceinline__ int crow(int r, int hi) { return (r & 3) + 8 * (r >> 2) + 4 * hi; }
typedef float f32x4_t __attribute__((ext_vector_type(4)));
__device__ __forceinline__ float max3f(float a, float b, float c) { float r; asm("v_max3_f32 %0, %1, %2, %3" : "=v"(r) : "v"(a), "v"(b), "v"(c)); return r; }
__device__ __forceinline__ void glds16(const void* gsrc, unsigned lds_dst) { unsigned keep; lds_dst = (unsigned)__builtin_amdgcn_readfirstlane((int)lds_dst);

    asm volatile("s_mov_b32 %0, m0\n\ts_mov_b32 m0, %2\n\ts_nop 0\n\tglobal_load_lds_dwordx4 %1, off\n\ts_mov_b32 m0, %0" : "=&s"(keep) : "v"(gsrc), "s"(lds_dst) : "memory"); }
__device__ __forceinline__ void dma_block(const bf16* K, const bf16* V, size_t rowbase  , int dsh, int h, LAS unsigned char* lds, int blk, int wid, int lane) {
    const unsigned sb = (unsigned)__builtin_amdgcn_readfirstlane((int)(unsigned)(uintptr_t)lds) + (unsigned)(blk & 3) * KSLOT;
#pragma unroll
    for (int i = 0; i < 2; ++i) { const int p = 2 * wid + i; const int key = 8 * p + (lane >> 3), ch = (lane & 7) ^ ((lane >> 3) & 7);
        const size_t eo = (rowbase + ((size_t)key << dsh)) * AW + h * HD + 8 * ch;
        glds16(K + eo, sb + p * 1024); glds16(V + eo, sb + VRING + p * 1024); }
}
__device__ __forceinline__ void item(int idx, const bf16* Q, const bf16* K, const bf16* V, bf16* O, float* LSE, LAS unsigned char* lds) {
    int tid = threadIdx.x; asm volatile("" : "+v"(tid));
    const int lane = tid & 63, wid = __builtin_amdgcn_readfirstlane(tid >> 6), r16 = lane & 15, g4 = lane >> 4;
    int br, b, h, g, n0, nblk;
    if (idx < 256) { br = 0; b = idx >> 6; h = (idx >> 3) & 7; g = 0; n0 = 8 * (idx & 7); nblk = 8; }
    else if (idx < 512) { const int j = idx - 256; br = 1; b = j >> 6; h = (j >> 3) & 7; g = (j & 7) >> 1; n0 = 8 * (j & 1); nblk = 8; }
    else { const int j = idx - 512; br = 2; b = j >> 7; h = (j >> 4) & 7; g = j & 15; n0 = 0; nblk = 4; }
    const int dsh = 2 * br;
    const size_t seq0 = (size_t)b * SEQ + g;
    const int nend = n0 + nblk;
    if (n0 > 0) dma_block(K, V, seq0 + ((size_t)(128 * (n0 - 1)) << dsh), dsh, h, lds, n0 - 1, wid, lane);
    else {
#pragma unroll
        for (int i = 0; i < 2; ++i) { *(LAS v4u*)(lds + 3 * KSLOT + tid * 16 + i * 8192) = (v4u){0u, 0u, 0u, 0u}; *(LAS v4u*)(lds + VRING + 3 * KSLOT + tid * 16 + i * 8192) = (v4u){0u, 0u, 0u, 0u}; }
    }
    dma_block(K, V, seq0 + ((size_t)(128 * n0) << dsh), dsh, h, lds, n0, wid, lane);
    dma_block(K, V, seq0 + ((size_t)(128 * (n0 + 1)) << dsh), dsh, h, lds, n0 + 1, wid, lane);
    const int qi = 16 * wid + r16;
    bf16x8 qf[2];
    { const size_t rowq = seq0 + ((size_t)(128 * n0 + qi) << dsh);
#pragma unroll
      for (int ks = 0; ks < 2; ++ks) qf[ks] = *(const GAS bf16x8*)(Q + rowq * AW + h * HD + 32 * ks + 8 * g4); }
    asm volatile("s_waitcnt vmcnt(0) lgkmcnt(0)\n\ts_barrier" ::: "memory");
    int kl[2], vl[4];
#pragma unroll
    for (int ks = 0; ks < 2; ++ks) kl[ks] = r16 * 128 + 16 * ((4 * ks + g4) ^ (r16 & 7));
#pragma unroll
    for (int dt = 0; dt < 4; ++dt) vl[dt] = VRING + (4 * g4 + (r16 >> 2)) * 128 + (((2 * dt + ((r16 & 3) >> 1)) ^ ((4 * g4 + (r16 >> 2)) & 7)) * 16) + (r16 & 1) * 8;
#define ATT_STEP(n, SPH, QC0, QC1, QX0, QX1) do { \
        const bool more = ((n) + 1 < nend), more2 = ((n) + 2 < nend); \
        { const bf16* qp = Q + (seq0 + ((size_t)(128 * ((n) + (more ? 1 : 0)) + qi) << dsh)) * AW + h * HD + 8 * g4; \
          asm volatile("global_load_dwordx4 %0, %2, off\n\tglobal_load_dwordx4 %1, %2, off offset:64" : "=&v"(QX0), "=&v"(QX1) : "v"(qp) : "memory"); } \
        if (more2) dma_block(K, V, seq0 + ((size_t)(128 * ((n) + 2)) << dsh), dsh, h, lds, (n) + 2, wid, lane); \
          \
        const int wbase = 128 * (SPH) + 16 * wid; \
        f32x4_t sc[9]; bf16x8 kf[9][2]; \
        _Pragma("unroll") \
        for (int j = 0; j < 9; ++j) { \
        _Pragma("unroll") \
            for (int ks = 0; ks < 2; ++ks) kf[j][ks] = ((SPH) < 3) ? *(const LAS bf16x8*)(lds + kbs[ks] + (128 * (SPH) + 16 * j) * 128) : *(const LAS bf16x8*)(lds + ((wbase + 16 * j) & 511) * 128 + kl[ks]); } \
        __builtin_amdgcn_sched_barrier(0); \
        _Pragma("unroll") \
        for (int j = 0; j < 9; ++j) sc[j] = __builtin_amdgcn_mfma_f32_16x16x32_bf16(kf[j][0], QC0, (f32x4_t){0.f, 0.f, 0.f, 0.f}, 0, 0, 0);     \
        _Pragma("unroll") \
        for (int j = 0; j < 9; ++j) sc[j] = __builtin_amdgcn_mfma_f32_16x16x32_bf16(kf[j][1], QC1, sc[j], 0, 0, 0); \
        __builtin_amdgcn_sched_barrier(0); \
        if ((n) == 0) {                                                  \
        _Pragma("unroll") \
            for (int j = 0; j < 8; ++j) if (wid + j < 8) sc[j] = (f32x4_t){-1e30f, -1e30f, -1e30f, -1e30f}; } \
        _Pragma("unroll") \
        for (int r = 0; r < 4; ++r) { if (4 * g4 + r < r16) sc[0][r] = -1e30f; if (4 * g4 + r > r16) sc[8][r] = -1e30f; }     \
        float mx = -1e30f; \
        _Pragma("unroll") \
        for (int j = 0; j < 9; ++j) { mx = max3f(mx, sc[j][0], sc[j][1]); mx = max3f(mx, sc[j][2], sc[j][3]); } \
        mx = max3f(mx, __shfl_xor(mx, 16), mx); mx = max3f(mx, __shfl_xor(mx, 32), mx); \
        float l = 0.f; \
        _Pragma("unroll") \
        for (int j = 0; j < 9; ++j) \
        _Pragma("unroll") \
            for (int r = 0; r < 4; ++r) { const float e = __builtin_amdgcn_exp2f(sc[j][r] - mx); sc[j][r] = e; l += e; } \
        l += __shfl_xor(l, 16); l += __shfl_xor(l, 32); \
        f32x4_t o[4]; \
        v4i16_t vlo[5][4], vh8[5][4]; bf16x8 pf[5]; \
        _Pragma("unroll") \
        for (int kk = 0; kk < 5; ++kk) { \
        _Pragma("unroll") \
            for (int dt = 0; dt < 4; ++dt) { \
                if ((SPH) < 3) { vlo[kk][dt] = __builtin_amdgcn_ds_read_tr16_b64_v4i16((LAS v4i16_t*)(lds + vbs[dt] + (128 * (SPH) + 32 * kk) * 128)); \
                                 vh8[kk][dt] = __builtin_amdgcn_ds_read_tr16_b64_v4i16((LAS v4i16_t*)(lds + vbs[dt] + (128 * (SPH) + 32 * kk + (kk < 4 ? 16 : 0)) * 128)); } \
                else { LAS unsigned char* va = lds + ((wbase + 32 * kk) & 511) * 128; \
                       LAS unsigned char* vb = (kk < 4) ? lds + ((wbase + 32 * kk + 16) & 511) * 128 : va;         \
                       vlo[kk][dt] = __builtin_amdgcn_ds_read_tr16_b64_v4i16((LAS v4i16_t*)(va + vl[dt])); vh8[kk][dt] = __builtin_amdgcn_ds_read_tr16_b64_v4i16((LAS v4i16_t*)(vb + vl[dt])); } } \
            v4u pw; pw.x = pk2(sc[2 * kk][0], sc[2 * kk][1]); pw.y = pk2(sc[2 * kk][2], sc[2 * kk][3]); \
            if (kk < 4) { pw.z = pk2(sc[2 * kk + 1][0], sc[2 * kk + 1][1]); pw.w = pk2(sc[2 * kk + 1][2], sc[2 * kk + 1][3]); } else { pw.z = 0u; pw.w = 0u; } \
            pf[kk] = __builtin_bit_cast(bf16x8, pw); } \
        __builtin_amdgcn_sched_barrier(0); \
        _Pragma("unroll") \
        for (int kk = 0; kk < 5; ++kk) \
        _Pragma("unroll") \
            for (int dt = 0; dt < 4; ++dt) { const bf16x8 vf = (bf16x8){vlo[kk][dt][0], vlo[kk][dt][1], vlo[kk][dt][2], vlo[kk][dt][3], vh8[kk][dt][0], vh8[kk][dt][1], vh8[kk][dt][2], vh8[kk][dt][3]}; \
                o[dt] = (kk == 0) ? __builtin_amdgcn_mfma_f32_16x16x32_bf16(vf, pf[kk], (f32x4_t){0.f, 0.f, 0.f, 0.f}, 0, 0, 0) : __builtin_amdgcn_mfma_f32_16x16x32_bf16(vf, pf[kk], o[dt], 0, 0, 0); } \
        __builtin_amdgcn_sched_barrier(0); \
        if (more2) asm volatile("s_waitcnt vmcnt(4)" ::: "memory");     \
        else asm volatile("s_waitcnt vmcnt(0)" ::: "memory"); \
        const float inv = __builtin_amdgcn_rcpf(l); \
        const size_t rowq = seq0 + ((size_t)(128 * (n) + qi) << dsh); \
        bf16* orow = O + ((size_t)br * T + rowq) * AW + h * HD; \
        _Pragma("unroll") \
        for (int dt = 0; dt < 4; ++dt) { v2u w; w.x = pk2(o[dt][0] * inv, o[dt][1] * inv); w.y = pk2(o[dt][2] * inv, o[dt][3] * inv); *(GAS v2u*)(orow + 16 * dt + 4 * g4) = w; } \
        if (g4 == 0) LSE[((size_t)br * T + rowq) * NH + h] = mx + __builtin_amdgcn_logf(l); \
        asm volatile("s_waitcnt lgkmcnt(0)\n\ts_barrier" ::: "memory"); } while (0)
    int kbs[2], vbs[4];
#pragma unroll
    for (int ks = 0; ks < 2; ++ks) kbs[ks] = kl[ks] + 16 * wid * 128;
#pragma unroll
    for (int dt = 0; dt < 4; ++dt) vbs[dt] = vl[dt] + 16 * wid * 128;
    bf16x8 qb0, qb1;
    for (int n4 = n0; n4 < nend; n4 += 4) { ATT_STEP(n4, 3, qf[0], qf[1], qb0, qb1); ATT_STEP(n4 + 1, 0, qb0, qb1, qf[0], qf[1]); ATT_STEP(n4 + 2, 1, qf[0], qf[1], qb0, qb1); ATT_STEP(n4 + 3, 2, qb0, qb1, qf[0], qf[1]); }
#undef ATT_STEP
}
}

namespace lru {
constexpr int USTR = 144, U_BYTES = 67 * USTR, C_BYTES = 64 * USTR, W_BYTES = U_BYTES + C_BYTES;
constexpr int OFF_SSQ = 8 * W_BYTES, OFF_CAR = OFF_SSQ + 8 * 64 * 4, OFF_RSL = OFF_CAR + 512 * 4, LDS_END = OFF_RSL + 64 * 4;
static_assert(W_BYTES % 16 == 0 && LDS_END <= LDSCTL_OFF, "lru LDS");
__device__ __forceinline__ float sigmoid_f(float x) { return __builtin_amdgcn_rcpf(1.f + __builtin_amdgcn_exp2f(-1.4426950408889634f * x)); }
__device__ __forceinline__ float gelu_tanh(float x) { const float t = __builtin_fmaf(-0.10294323972f, x * x, -2.30220819813f); return x * __builtin_amdgcn_rcpf(1.f + __builtin_amdgcn_exp2f(x * t)); }
__device__ __forceinline__ float bf2f(unsigned short h) { return __builtin_bit_cast(float, (unsigned)h << 16); }
__device__ __forceinline__ f32x2 pair_xy(float v) { const float o = __shfl_xor(v, 32); const bool up = (threadIdx.x & 32) != 0; return (f32x2){up ? o : v, up ? v : o}; }
struct LruConst { bf16x8 fr[16]; float w0, w1, w2, w3, cb, brv[2], biv[2], ccv[2]; };
__device__ __forceinline__ void load_const(int layer, const bf16* WFR, const float* conv_w, const float* conv_b, const float* b_r, const float* b_i, const float* lam, LruConst& k) {
    int tid = threadIdx.x; asm volatile("" : "+v"(tid));
    const int lane = tid & 63, wid = __builtin_amdgcn_readfirstlane(tid >> 6), r32 = lane & 31;
    const GAS bf16x8* wfr = (const GAS bf16x8*)(WFR + ((size_t)(layer * 8 + wid) * 16) * 512) + lane;
#pragma unroll
    for (int i = 0; i < 16; ++i) k.fr[i] = wfr[i * 64];
    const int gch = layer * LW + wid * 64 + lane;
    k.w0 = conv_w[layer * 4 * LW + 0 * LW + wid * 64 + lane]; k.w1 = conv_w[layer * 4 * LW + 1 * LW + wid * 64 + lane]; k.w2 = conv_w[layer * 4 * LW + 2 * LW + wid * 64 + lane]; k.w3 = conv_w[layer * 4 * LW + 3 * LW + wid * 64 + lane];
    k.cb = conv_b[gch];
#pragma unroll
    for (int nb = 0; nb < 2; ++nb) { const int ch = wid * 64 + 32 * nb + r32; k.brv[nb] = -1.4426950408889634f * b_r[layer * LW + ch]; k.biv[nb] = -1.4426950408889634f * b_i[layer * LW + ch];
        k.ccv[nb] = lam[layer * LW + ch]; }
}
struct URegs { v4u uv[9]; };
__device__ __forceinline__ void u_load(int cu, const bf16* U, URegs& q) {
    int tid = threadIdx.x; asm volatile("" : "+v"(tid));
    const int lane = tid & 63, wid = __builtin_amdgcn_readfirstlane(tid >> 6);
    const int b = cu >> 7, t0 = 64 * (cu & 127);
#pragma unroll
    for (int j = 0; j < 9; ++j) { const int i = lane + 64 * j, r = i >> 3, ch = i & 7; int t = t0 - 3 + r; t = t < 0 ? 0 : (t > SEQ - 1 ? SEQ - 1 : t);
        q.uv[j] = *(const GAS v4u*)(U + ((size_t)b * SEQ + t) * LW + wid * 64 + ch * 8); }
    __builtin_amdgcn_sched_barrier(0);
}
__device__ __forceinline__ void local_unit(int cu, int layer, const LruConst& kc, const URegs& uq, const bf16* Gt, f32x2* SUM, unsigned* cnt, const float* gout, bf16* MIX, LAS unsigned char* lds) {
    int tid = threadIdx.x; asm volatile("" : "+v"(tid));
    const int lane = tid & 63, wid = __builtin_amdgcn_readfirstlane(tid >> 6), r32 = lane & 31, hi = lane >> 5;
    const int b = cu >> 7, c = cu & 127, t0 = 64 * c;
    const size_t row0 = (size_t)b * SEQ + t0;
    LAS unsigned char* ul = lds + wid * W_BYTES; LAS unsigned char* cl = ul + U_BYTES;
    {
#pragma unroll
      for (int j = 0; j < 9; ++j) { const int i = lane + 64 * j, r = i >> 3, ch = i & 7; const int t = t0 - 3 + r;
          *(LAS v4u*)(ul + r * USTR + ch * 16) = (t >= 0) ? uq.uv[j] : (v4u){0u, 0u, 0u, 0u}; } }
    {
        const float w0 = kc.w0, w1 = kc.w1, w2 = kc.w2, w3 = kc.w3, cb = kc.cb;
        float u0 = bf2f(*(const LAS unsigned short*)(ul + 0 * USTR + 2 * lane)), u1 = bf2f(*(const LAS unsigned short*)(ul + 1 * USTR + 2 * lane)), u2 = bf2f(*(const LAS unsigned short*)(ul + 2 * USTR + 2 * lane));
#pragma unroll 16
        for (int t = 0; t < 64; ++t) { const float u3 = bf2f(*(const LAS unsigned short*)(ul + (t + 3) * USTR + 2 * lane));
            const float y = cb + w0 * u0 + w1 * u1 + w2 * u2 + w3 * u3;
            *(LAS unsigned short*)(cl + t * USTR + 2 * lane) = (unsigned short)pk2(y, 0.f);
            u0 = u1; u1 = u2; u2 = u3; }
    }
    float brv[2], biv[2], ccv[2], hrun[2], ptot[2];
#pragma unroll
    for (int nb = 0; nb < 2; ++nb) { brv[nb] = kc.brv[nb]; biv[nb] = kc.biv[nb]; ccv[nb] = kc.ccv[nb]; hrun[nb] = 0.f; ptot[nb] = 1.f; }
    asm volatile("s_waitcnt lgkmcnt(0)" ::: "memory");
#pragma unroll
    for (int tt = 0; tt < 2; ++tt) {
        bf16x8 ucf[4];
#pragma unroll
        for (int s = 0; s < 4; ++s) ucf[s] = *(const LAS bf16x8*)(cl + (32 * tt + r32) * USTR + (16 * s + 8 * hi) * 2);
#pragma unroll
        for (int nb = 0; nb < 2; ++nb) {
            f32x16 aR, aI;
#pragma unroll
            for (int r = 0; r < 16; ++r) { aR[r] = 0.f; aI[r] = 0.f; }
#pragma unroll
            for (int s = 0; s < 4; ++s) { const bf16x8 fr_ = kc.fr[(0 * 2 + nb) * 4 + s], fi_ = kc.fr[(1 * 2 + nb) * 4 + s];
                aR = __builtin_amdgcn_mfma_f32_32x32x16_bf16(ucf[s], fr_, aR, 0, 0, 0); aI = __builtin_amdgcn_mfma_f32_32x32x16_bf16(ucf[s], fi_, aI, 0, 0, 0); }
#pragma unroll
            for (int q = 0; q < 4; ++q) {
                float a4[4], b4[4];
#pragma unroll
                for (int k = 0; k < 4; ++k) { const int r = 4 * q + k, tl = 32 * tt + 8 * q + 4 * hi + k;
                    const float ucv = bf2f(*(const LAS unsigned short*)(cl + tl * USTR + 2 * (32 * nb + r32)));
                    const float rg = __builtin_amdgcn_rcpf(1.f + __builtin_amdgcn_exp2f(aR[r] + brv[nb])), ig = __builtin_amdgcn_rcpf(1.f + __builtin_amdgcn_exp2f(aI[r] + biv[nb]));
                    const float A = __builtin_amdgcn_exp2f(ccv[nb] * rg);
                    a4[k] = A; b4[k] = __builtin_amdgcn_sqrtf(fmaxf(1.f - A * A, 0.f)) * ig * ucv; }
                const float Ag = (a4[0] * a4[1]) * (a4[2] * a4[3]);
                const float Bg = ((b4[0] * a4[1] + b4[1]) * a4[2] + b4[2]) * a4[3] + b4[3];
                const f32x2 Ax = pair_xy(Ag), Bx = pair_xy(Bg);
                const float hA = Ax.x * hrun[nb] + Bx.x, hB = Ax.y * hA + Bx.y;
                float h = hi ? hA : hrun[nb];
                float p = hi ? ptot[nb] * Ax.x : ptot[nb];
                hrun[nb] = hB; ptot[nb] *= Ax.x * Ax.y;
#pragma unroll
                for (int k = 0; k < 4; ++k) { const int tl = 32 * tt + 8 * q + 4 * hi + k;
                    h = a4[k] * h + b4[k]; p = a4[k] * p;
                    *(LAS unsigned short*)(cl + tl * USTR + 2 * (32 * nb + r32)) = (unsigned short)pk2(h, 0.f);
                    *(LAS unsigned short*)(ul + tl * USTR + 2 * (32 * nb + r32)) = (unsigned short)pk2(p, 0.f); }
                __builtin_amdgcn_sched_barrier(0);
            }
        }
    }
    if (hi == 0) {
#pragma unroll
        for (int nb = 0; nb < 2; ++nb) { const f32x2 sv = (f32x2){ptot[nb], hrun[nb]};
            __hip_atomic_store((unsigned long long*)(SUM + ((size_t)b * 128 + c) * 512 + wid * 64 + 32 * nb + r32), __builtin_bit_cast(unsigned long long, sv), __ATOMIC_RELAXED, __HIP_MEMORY_SCOPE_AGENT); }
    }
    asm volatile("s_waitcnt vmcnt(0) lgkmcnt(0)" ::: "memory");
    const int ch8 = lane & 7;
    v4u gg[8];
#pragma unroll
    for (int i = 0; i < 8; ++i) gg[i] = *(const GAS v4u*)(Gt + (row0 + 8 * i + (lane >> 3)) * LW + wid * 64 + 8 * ch8);
    const f32x4 g0 = *(const GAS f32x4*)(gout + layer * LW + wid * 64 + 8 * ch8), g1 = *(const GAS f32x4*)(gout + layer * LW + wid * 64 + 8 * ch8 + 4);
    __syncthreads();
    if (tid == 0) {
        (void)__hip_atomic_fetch_add(cnt, 1u, __ATOMIC_RELAXED, __HIP_MEMORY_SCOPE_AGENT);
        unsigned sp = 0;
        while (__hip_atomic_load(cnt, __ATOMIC_RELAXED, __HIP_MEMORY_SCOPE_AGENT) < 128u) { __builtin_amdgcn_s_sleep(2); if (++sp > (1u << 20)) break; }
        __builtin_amdgcn_fence(__ATOMIC_ACQUIRE, "agent");
        asm volatile("s_waitcnt vmcnt(0)" ::: "memory");
    }
    __syncthreads();
    {
        float hc = 0.f; const f32x2* spq = SUM + ((size_t)b * 128) * 512 + tid;
        for (int cc = 0; cc < c; cc += 32) { f32x2 ab[32];
#pragma unroll
            for (int k = 0; k < 32; ++k) { const int i = cc + k; ab[k] = spq[(size_t)(i < c ? i : 0) * 512]; }
#pragma unroll
            for (int k = 0; k < 32; ++k) { const int i = cc + k; const f32x2 u_ = (i < c) ? ab[k] : (f32x2){1.f, 0.f}; hc = u_.x * hc + u_.y; } }
        ((LAS float*)(lds + OFF_CAR))[tid] = hc;
    }
    __syncthreads();
    {
        LAS float* ssq = (LAS float*)(lds + OFF_SSQ); LAS float* rsl = (LAS float*)(lds + OFF_RSL); const LAS float* car = (const LAS float*)(lds + OFF_CAR);
        const f32x4 c0 = *(const LAS f32x4*)(car + wid * 64 + 8 * ch8), c1 = *(const LAS f32x4*)(car + wid * 64 + 8 * ch8 + 4);
        float rec[8][8];
#pragma unroll
        for (int i = 0; i < 8; ++i) { const int tk = 8 * i + (lane >> 3); float s = 0.f;
            const v4u hl = *(const LAS v4u*)(cl + tk * USTR + ch8 * 16), pc = *(const LAS v4u*)(ul + tk * USTR + ch8 * 16);
#pragma unroll
            for (int e = 0; e < 4; ++e) { const float ca = (e == 0) ? c0.x : (e == 1) ? c0.z : (e == 2) ? c1.x : c1.z, cb_ = (e == 0) ? c0.y : (e == 1) ? c0.w : (e == 2) ? c1.y : c1.w;
                const float h0 = bf_lo(hl[e]) + bf_lo(pc[e]) * ca, h1 = bf_hi(hl[e]) + bf_hi(pc[e]) * cb_;
                const float r0 = gelu_tanh(bf_lo(gg[i][e])) * h0, r1 = gelu_tanh(bf_hi(gg[i][e])) * h1;
                rec[i][2 * e] = r0; rec[i][2 * e + 1] = r1; s += r0 * r0 + r1 * r1; }
            s = DPP_ADD(s, 0xB1); s = DPP_ADD(s, 0x4E); s = DPP_ADD(s, 0x141);
            if (ch8 == 0) ssq[wid * 64 + tk] = s; }
        __syncthreads();
        if (tid < 64) { float s = 0.f;
#pragma unroll
            for (int w = 0; w < 8; ++w) s += ssq[w * 64 + tid];
            rsl[tid] = __builtin_amdgcn_rsqf(s * (1.f / LW) + RMS_EPS); }
        __syncthreads();
#pragma unroll
        for (int i = 0; i < 8; ++i) { const int tk = 8 * i + (lane >> 3); const float rs = rsl[tk];
            v4u o; o.x = pk2(rec[i][0] * rs * g0.x, rec[i][1] * rs * g0.y); o.y = pk2(rec[i][2] * rs * g0.z, rec[i][3] * rs * g0.w);
            o.z = pk2(rec[i][4] * rs * g1.x, rec[i][5] * rs * g1.y); o.w = pk2(rec[i][6] * rs * g1.z, rec[i][7] * rs * g1.w);
            *(GAS v4u*)(MIX + (row0 + tk) * D + AW + wid * 64 + 8 * ch8) = o; }
    }
    __syncthreads();
}
constexpr int OFF_CARA = 8 * 64 * 4, OFF_CARB = OFF_CARA + 512 * 4 + 64 * 4;
__device__ __forceinline__ void carry2(int cuA, int cuB, const f32x2* SUM, LAS unsigned char* lds) {
    int tid = threadIdx.x; asm volatile("" : "+v"(tid));
    const int cA = cuA & 127, cB = (cuB >= 0) ? (cuB & 127) : 0, cmax = cA > cB ? cA : cB;
    const f32x2* spA = SUM + ((size_t)(cuA >> 7) * 128) * 512 + tid; const f32x2* spB = SUM + ((size_t)((cuB >= 0 ? cuB : cuA) >> 7) * 128) * 512 + tid;
    float hA = 0.f, hB = 0.f;
    for (int cc = 0; cc < cmax; cc += 32) { f32x2 a[32], b[32];
#pragma unroll
        for (int k = 0; k < 32; ++k) { const int i = cc + k; a[k] = spA[(size_t)(i < cA ? i : 0) * 512]; b[k] = spB[(size_t)(i < cB ? i : 0) * 512]; }
#pragma unroll
        for (int k = 0; k < 32; ++k) { const int i = cc + k; const f32x2 ua = (i < cA) ? a[k] : (f32x2){1.f, 0.f}, ub = (i < cB) ? b[k] : (f32x2){1.f, 0.f};
            hA = ua.x * hA + ua.y; hB = ub.x * hB + ub.y; } }
    ((LAS float*)(lds + OFF_CARA))[tid] = hA; ((LAS float*)(lds + OFF_CARB))[tid] = hB;
}
struct FinRegs { v4u hl[8], pc[8], gg[8]; f32x4 g0, g1; };
__device__ __forceinline__ void finish_load(int cu, int layer, const bf16* HL, const bf16* PC, const bf16* Gt, const float* gout, FinRegs& q) {
    int tid = threadIdx.x; asm volatile("" : "+v"(tid));
    const int lane = tid & 63, wid = __builtin_amdgcn_readfirstlane(tid >> 6), ch8 = lane & 7;
    const size_t row0 = (size_t)(cu >> 7) * SEQ + 64 * (cu & 127);
#pragma unroll
    for (int i = 0; i < 8; ++i) { const size_t e = (row0 + 8 * i + (lane >> 3)) * LW + wid * 64 + 8 * ch8;
        q.hl[i] = *(const GAS v4u*)(HL + e); q.pc[i] = *(const GAS v4u*)(PC + e); q.gg[i] = *(const GAS v4u*)(Gt + e); }
    q.g0 = *(const GAS f32x4*)(gout + layer * LW + wid * 64 + 8 * ch8); q.g1 = *(const GAS f32x4*)(gout + layer * LW + wid * 64 + 8 * ch8 + 4);
    __builtin_amdgcn_sched_barrier(0);
}
__device__ __forceinline__ void finish_unit(int cu, int layer, const FinRegs& q, const LAS float* car, const float* gout, bf16* MIX, LAS unsigned char* lds) {
    int tid = threadIdx.x; asm volatile("" : "+v"(tid));
    const int lane = tid & 63, wid = __builtin_amdgcn_readfirstlane(tid >> 6), ch8 = lane & 7;
    const int b = cu >> 7, c = cu & 127;
    const size_t row0 = (size_t)b * SEQ + 64 * c;
    LAS float* ssq = (LAS float*)lds; LAS float* rsl = ssq + 8 * 64 + 512;
    const v4u (&hl)[8] = q.hl; const v4u (&pc)[8] = q.pc; const v4u (&gg)[8] = q.gg;
    const f32x4 c0 = *(const LAS f32x4*)(car + wid * 64 + 8 * ch8), c1 = *(const LAS f32x4*)(car + wid * 64 + 8 * ch8 + 4);
    float rec[8][8];
#pragma unroll
    for (int i = 0; i < 8; ++i) { float s = 0.f;
#pragma unroll
        for (int e = 0; e < 4; ++e) { const float ca = (e == 0) ? c0.x : (e == 1) ? c0.z : (e == 2) ? c1.x : c1.z, cb_ = (e == 0) ? c0.y : (e == 1) ? c0.w : (e == 2) ? c1.y : c1.w;
            const float h0 = bf_lo(hl[i][e]) + bf_lo(pc[i][e]) * ca, h1 = bf_hi(hl[i][e]) + bf_hi(pc[i][e]) * cb_;
            const float r0 = gelu_tanh(bf_lo(gg[i][e])) * h0, r1 = gelu_tanh(bf_hi(gg[i][e])) * h1;
            rec[i][2 * e] = r0; rec[i][2 * e + 1] = r1; s += r0 * r0 + r1 * r1; }
        s = DPP_ADD(s, 0xB1); s = DPP_ADD(s, 0x4E); s = DPP_ADD(s, 0x141);
        if (ch8 == 0) ssq[wid * 64 + 8 * i + (lane >> 3)] = s; }
    __syncthreads();
    if (tid < 64) { float s = 0.f;
#pragma unroll
        for (int w = 0; w < 8; ++w) s += ssq[w * 64 + tid];
        rsl[tid] = __builtin_amdgcn_rsqf(s * (1.f / LW) + RMS_EPS); }
    __syncthreads();
    const f32x4 g0 = q.g0, g1 = q.g1;
#pragma unroll
    for (int i = 0; i < 8; ++i) { const int tk = 8 * i + (lane >> 3); const float rs = rsl[tk];
        v4u o; o.x = pk2(rec[i][0] * rs * g0.x, rec[i][1] * rs * g0.y); o.y = pk2(rec[i][2] * rs * g0.z, rec[i][3] * rs * g0.w);
        o.z = pk2(rec[i][4] * rs * g1.x, rec[i][5] * rs * g1.y); o.w = pk2(rec[i][6] * rs * g1.z, rec[i][7] * rs * g1.w);
        *(GAS v4u*)(MIX + (row0 + tk) * D + AW + wid * 64 + 8 * ch8) = o; }
    __syncthreads();
}
}

__device__ __forceinline__ void attn_combine(int cu, int layer, const bf16* OBR, const float* LSE, const float* gain, bf16* MIX) {
    int tid = threadIdx.x; asm volatile("" : "+v"(tid));
    const int lane = tid & 63, wid = __builtin_amdgcn_readfirstlane(tid >> 6), head = lane >> 3;
    const f32x4 g0 = *(const GAS f32x4*)(gain + layer * AW + 8 * lane), g1 = *(const GAS f32x4*)(gain + layer * AW + 8 * lane + 4);
    const size_t rowb = (size_t)(cu >> 7) * SEQ + 64 * (cu & 127) + wid;
#pragma unroll
    for (int bt = 0; bt < 2; ++bt) {
        float l0[4], l1[4], l2[4]; v4u a[4], b[4], d[4];
#pragma unroll
        for (int k = 0; k < 4; ++k) { const size_t row = rowb + 8 * (4 * bt + k);
            l0[k] = LSE[((size_t)0 * T + row) * NH + head]; l1[k] = LSE[((size_t)1 * T + row) * NH + head]; l2[k] = LSE[((size_t)2 * T + row) * NH + head];
            a[k] = *(const GAS v4u*)(OBR + ((size_t)0 * T + row) * AW + 8 * lane); b[k] = *(const GAS v4u*)(OBR + ((size_t)1 * T + row) * AW + 8 * lane); d[k] = *(const GAS v4u*)(OBR + ((size_t)2 * T + row) * AW + 8 * lane); }
        __builtin_amdgcn_sched_barrier(0);
#pragma unroll
        for (int k = 0; k < 4; ++k) { const size_t row = rowb + 8 * (4 * bt + k);
            const float mx = fmaxf(l0[k], fmaxf(l1[k], l2[k]));
            float w0 = __builtin_amdgcn_exp2f(l0[k] - mx), w1 = __builtin_amdgcn_exp2f(l1[k] - mx), w2 = __builtin_amdgcn_exp2f(l2[k] - mx);
            const float iw = __builtin_amdgcn_rcpf(w0 + w1 + w2); w0 *= iw; w1 *= iw; w2 *= iw;
            float acc[8]; float ss = 0.f;
#pragma unroll
            for (int e = 0; e < 4; ++e) { const float lo = w0 * bf_lo(a[k][e]) + w1 * bf_lo(b[k][e]) + w2 * bf_lo(d[k][e]), hh = w0 * bf_hi(a[k][e]) + w1 * bf_hi(b[k][e]) + w2 * bf_hi(d[k][e]);
                acc[2 * e] = lo; acc[2 * e + 1] = hh; ss += lo * lo + hh * hh; }
            const float rstd = __builtin_amdgcn_rsqf(wave_sum(ss) * (1.f / AW) + RMS_EPS);
            v4u w; w.x = pk2(acc[0] * rstd * g0.x, acc[1] * rstd * g0.y); w.y = pk2(acc[2] * rstd * g0.z, acc[3] * rstd * g0.w);
            w.z = pk2(acc[4] * rstd * g1.x, acc[5] * rstd * g1.y); w.w = pk2(acc[6] * rstd * g1.z, acc[7] * rstd * g1.w);
            *(GAS v4u*)(MIX + row * D + 8 * lane) = w; }
    }
}

__device__ __forceinline__ void mix_unit(int cu, int layer, const bf16* OBR, const float* LSE, const float* again, const bf16* HL, const bf16* PC, const bf16* Gt, const LAS float* car, const float* lgain, bf16* MIX) {
    int tid = threadIdx.x; asm volatile("" : "+v"(tid));
    const int lane = tid & 63, wid = __builtin_amdgcn_readfirstlane(tid >> 6), head = lane >> 3;
    const f32x4 g0 = *(const GAS f32x4*)(again + layer * AW + 8 * lane), g1 = *(const GAS f32x4*)(again + layer * AW + 8 * lane + 4);
    const f32x4 h0 = *(const GAS f32x4*)(lgain + layer * LW + 8 * lane), h1 = *(const GAS f32x4*)(lgain + layer * LW + 8 * lane + 4);
    const f32x4 c0 = *(const LAS f32x4*)(car + 8 * lane), c1 = *(const LAS f32x4*)(car + 8 * lane + 4);
    const size_t rowb = (size_t)(cu >> 7) * SEQ + 64 * (cu & 127) + 8 * wid;
#pragma unroll
    for (int bt = 0; bt < 2; ++bt) {
        float l0[4], l1[4], l2[4]; v4u a[4], b[4], d[4], hl[4], pc[4], gg[4];
#pragma unroll
        for (int k = 0; k < 4; ++k) { const size_t row = rowb + 4 * bt + k;
            l0[k] = LSE[((size_t)0 * T + row) * NH + head]; l1[k] = LSE[((size_t)1 * T + row) * NH + head]; l2[k] = LSE[((size_t)2 * T + row) * NH + head];
            a[k] = *(const GAS v4u*)(OBR + ((size_t)0 * T + row) * AW + 8 * lane); b[k] = *(const GAS v4u*)(OBR + ((size_t)1 * T + row) * AW + 8 * lane); d[k] = *(const GAS v4u*)(OBR + ((size_t)2 * T + row) * AW + 8 * lane);
            hl[k] = *(const GAS v4u*)(HL + row * LW + 8 * lane); pc[k] = *(const GAS v4u*)(PC + row * LW + 8 * lane); gg[k] = *(const GAS v4u*)(Gt + row * LW + 8 * lane); }
        __builtin_amdgcn_sched_barrier(0);
#pragma unroll
        for (int k = 0; k < 4; ++k) { const size_t row = rowb + 4 * bt + k;
            const float mx = fmaxf(l0[k], fmaxf(l1[k], l2[k]));
            float w0 = __builtin_amdgcn_exp2f(l0[k] - mx), w1 = __builtin_amdgcn_exp2f(l1[k] - mx), w2 = __builtin_amdgcn_exp2f(l2[k] - mx);
            const float iw = __builtin_amdgcn_rcpf(w0 + w1 + w2); w0 *= iw; w1 *= iw; w2 *= iw;
            float acc[8], rec[8]; float ss = 0.f, s2 = 0.f;
#pragma unroll
            for (int e = 0; e < 4; ++e) { const float lo = w0 * bf_lo(a[k][e]) + w1 * bf_lo(b[k][e]) + w2 * bf_lo(d[k][e]), hh = w0 * bf_hi(a[k][e]) + w1 * bf_hi(b[k][e]) + w2 * bf_hi(d[k][e]);
                acc[2 * e] = lo; acc[2 * e + 1] = hh; ss += lo * lo + hh * hh;
                const float ca = (e == 0) ? c0.x : (e == 1) ? c0.z : (e == 2) ? c1.x : c1.z, cb_ = (e == 0) ? c0.y : (e == 1) ? c0.w : (e == 2) ? c1.y : c1.w;
                const float x0 = bf_lo(hl[k][e]) + bf_lo(pc[k][e]) * ca, x1 = bf_hi(hl[k][e]) + bf_hi(pc[k][e]) * cb_;
                const float r0 = lru::gelu_tanh(bf_lo(gg[k][e])) * x0, r1 = lru::gelu_tanh(bf_hi(gg[k][e])) * x1;
                rec[2 * e] = r0; rec[2 * e + 1] = r1; s2 += r0 * r0 + r1 * r1; }
            const float rstd = __builtin_amdgcn_rsqf(wave_sum(ss) * (1.f / AW) + RMS_EPS), rstd2 = __builtin_amdgcn_rsqf(wave_sum(s2) * (1.f / LW) + RMS_EPS);
            v4u w; w.x = pk2(acc[0] * rstd * g0.x, acc[1] * rstd * g0.y); w.y = pk2(acc[2] * rstd * g0.z, acc[3] * rstd * g0.w);
            w.z = pk2(acc[4] * rstd * g1.x, acc[5] * rstd * g1.y); w.w = pk2(acc[6] * rstd * g1.z, acc[7] * rstd * g1.w);
            *(GAS v4u*)(MIX + row * D + 8 * lane) = w;
            v4u o; o.x = pk2(rec[0] * rstd2 * h0.x, rec[1] * rstd2 * h0.y); o.y = pk2(rec[2] * rstd2 * h0.z, rec[3] * rstd2 * h0.w);
            o.z = pk2(rec[4] * rstd2 * h1.x, rec[5] * rstd2 * h1.y); o.w = pk2(rec[6] * rstd2 * h1.z, rec[7] * rstd2 * h1.w);
            *(GAS v4u*)(MIX + row * D + AW + 8 * lane) = o; }
    }
}
__device__ __forceinline__ void post_mix_row(const RawRow& mraw, const RawRow& xraw, bf16* xout, const Gain4& gpost, const Gain4& gpre2, bf16* hrow, unsigned char* h8row, float* rstd_out, f32x4 (&hn)[4], int lane) {
    f32x4 m[4], xv[4]; unpack_raw(mraw, m); unpack_raw(xraw, xv);
    float s = 0.f;
#pragma unroll
    for (int j = 0; j < 4; ++j) s += (m[j].x * m[j].x + m[j].y * m[j].y) + (m[j].z * m[j].z + m[j].w * m[j].w);
    const float rstd = __builtin_amdgcn_rsqf(wave_sum(s) * (1.f / D) + RMS_EPS);
    float s2 = 0.f;
    GAS unsigned long long* x8 = (GAS unsigned long long*)xout + lane;
#pragma unroll
    for (int j = 0; j < 4; ++j) { const f32x4 gg = gpost.g[j];
        f32x4 y; y.x = xv[j].x + m[j].x * rstd * gg.x; y.y = xv[j].y + m[j].y * rstd * gg.y; y.z = xv[j].z + m[j].z * rstd * gg.z; y.w = xv[j].w + m[j].w * rstd * gg.w;
        x8[64 * j] = (unsigned long long)pk2(y.x, y.y) | ((unsigned long long)pk2(y.z, y.w) << 32); hn[j] = y; s2 += (y.x * y.x + y.y * y.y) + (y.z * y.z + y.w * y.w); }
    const float rstd2 = __builtin_amdgcn_rsqf(wave_sum(s2) * (1.f / D) + RMS_EPS);
    if (rstd_out && lane == 0) *rstd_out = rstd2;
    GAS unsigned long long* o8 = (GAS unsigned long long*)hrow + lane;
#pragma unroll
    for (int j = 0; j < 4; ++j) { const f32x4 gg = gpre2.g[j];
        hn[j].x *= rstd2 * gg.x; hn[j].y *= rstd2 * gg.y; hn[j].z *= rstd2 * gg.z; hn[j].w *= rstd2 * gg.w;
        if (hrow) o8[64 * j] = (unsigned long long)pk2(hn[j].x, hn[j].y) | ((unsigned long long)pk2(hn[j].z, hn[j].w) << 32);
        if (h8row) *((GAS unsigned*)h8row + lane + 64 * j) = pg8::pk4_fp8(hn[j].x, hn[j].y, hn[j].z, hn[j].w); }
}
__device__ __forceinline__ void post_ffn_row(f32x4 (&f)[4], const RawRow& xraw, bf16* xout, float* orow32, const Gain4& gpost, const float* gnext, bf16* hrow, float* rstd_out, int lane) {
    f32x4 xv[4]; unpack_raw(xraw, xv);
    float s = 0.f;
#pragma unroll
    for (int j = 0; j < 4; ++j) s += (f[j].x * f[j].x + f[j].y * f[j].y) + (f[j].z * f[j].z + f[j].w * f[j].w);
    const float rstd = __builtin_amdgcn_rsqf(wave_sum(s) * (1.f / D) + RMS_EPS);
    f32x4 y[4];
    GAS unsigned long long* x8 = (GAS unsigned long long*)xout + lane;
#pragma unroll
    for (int j = 0; j < 4; ++j) { const f32x4 gg = gpost.g[j];
        y[j].x = xv[j].x + f[j].x * rstd * gg.x; y[j].y = xv[j].y + f[j].y * rstd * gg.y; y[j].z = xv[j].z + f[j].z * rstd * gg.z; y[j].w = xv[j].w + f[j].w * rstd * gg.w;
        if (orow32) *((GAS f32x4*)orow32 + lane + 64 * j) = y[j];
        if (xout) x8[64 * j] = (unsigned long long)pk2(y[j].x, y[j].y) | ((unsigned long long)pk2(y[j].z, y[j].w) << 32); }
    if (gnext) rms_store_bf16(y, gnext, hrow, lane);
    if (rstd_out) { float s2 = 0.f;
#pragma unroll
        for (int j = 0; j < 4; ++j) s2 += (y[j].x * y[j].x + y[j].y * y[j].y) + (y[j].z * y[j].z + y[j].w * y[j].w);
        const float r2 = __builtin_amdgcn_rsqf(wave_sum(s2) * (1.f / D) + RMS_EPS); if (lane == 0) *rstd_out = r2; }
}

constexpr int I_IN = 8 * 10, I_OUT = 8 * 4, I_G = 8 * 14, I_D = 28 * 4, I_E = 2 * I_G + I_D, NIT_DENSE = 2 * I_IN + 2 * I_OUT + 2 * I_G + I_D;
constexpr int EDEF = 5, NIT_P0 = NIT_DENSE + EDEF * I_E, NIT_DEF = (NE - EDEF) * I_E;
__device__ __forceinline__ WItem w_item_of(const Args& a, unsigned char* ws, int it) {
            WItem q; q.gko = -1; q.GU = -1; q.f8 = 0; q.scale = 1.f; int r = it;
            if (r < 2 * I_IN) { const int l = r / I_IN, s = r % I_IN; q.W = a.w_in + (size_t)l * D * INC; q.K = D; q.N = INC; q.WT = (unsigned char*)((bf16*)(ws + WS_WIN) + (size_t)l * INC * D); q.k0 = 128 * (s / 10); q.n0 = 256 * (s % 10); q.gko = l * D; return q; } r -= 2 * I_IN;
            if (r < 2 * I_OUT) { const int l = r / I_OUT, s = r % I_OUT; q.W = a.w_out + (size_t)l * D * D; q.K = D; q.N = D; q.WT = (unsigned char*)((bf16*)(ws + WS_WOUT) + (size_t)l * D * D); q.k0 = 128 * (s / 4); q.n0 = 256 * (s % 4); return q; } r -= 2 * I_OUT;
            if (r < 2 * I_G) { const int up = r / I_G, s = r % I_G; q.W = up ? a.dw_up : a.dw_gate; q.K = D; q.N = FF; q.WT = (unsigned char*)(ws + WS_WGU); q.k0 = 128 * (s / 14); q.n0 = 256 * (s % 14); q.GU = up; q.gko = 2 * D; return q; } r -= 2 * I_G;
            if (r < I_D) { q.W = a.dw_down; q.K = FF; q.N = D; q.WT = (unsigned char*)(ws + WS_WD); q.k0 = 128 * (r / 4); q.n0 = 256 * (r % 4); q.f8 = 1; q.scale = MOE_WD_SCALE; return q; } r -= I_D;
            const int e = r / (2 * I_G + I_D); r -= e * (2 * I_G + I_D);
            unsigned char* we = (unsigned char*)(ws + WS_MOEW) + (size_t)e * (3 * (size_t)D * FF);
            q.f8 = 1;
            if (r < 2 * I_G) { const int up = r / I_G, s = r % I_G; q.W = (up ? a.mw_up : a.mw_gate) + (size_t)e * D * FF; q.K = D; q.N = FF; q.WT = we; q.k0 = 128 * (s / 14); q.n0 = 256 * (s % 14); q.GU = up; q.scale = MOE_WGU_SCALE; return q; } r -= 2 * I_G;
            q.W = a.mw_down + (size_t)e * FF * D; q.K = FF; q.N = D; q.WT = we + (size_t)2 * D * FF; q.k0 = 128 * (r / 4); q.n0 = 256 * (r % 4); q.scale = MOE_WD_SCALE; return q; }
__device__ __forceinline__ void convert_items(const Args& a, unsigned char* ws, LAS unsigned char* lds, int first, int cnt, int slot, int nslots, int wave, int lane) {
        if (slot < 0 || slot >= cnt) return;
        const int n = (cnt - slot + nslots - 1) / nslots;
        WRegs ra, rb; WItem ia = w_item_of(a, ws, first + slot), ib = ia;
        w_load(ia, ra, wave, lane);
        int k = 0;
        for (;;) {
            if (k + 1 >= n) { w_finish(ia, ra, lds, wave, lane); break; }
            ib = w_item_of(a, ws, first + slot + (k + 1) * nslots); w_load(ib, rb, wave, lane);
            w_finish(ia, ra, lds, wave, lane);
            if (k + 2 >= n) { w_finish(ib, rb, lds, wave, lane); break; }
            ia = w_item_of(a, ws, first + slot + (k + 2) * nslots); w_load(ia, ra, wave, lane);
            w_finish(ib, rb, lds, wave, lane);
            k += 2;
        }
}


#ifndef ONLY
#define PH(n) 1
#else
#define PH(n) (ONLY == (n))
#endif
#define CAS __attribute__((address_space(4)))
__global__ void __launch_bounds__(NWAVES * 64, 2) hymba_fwd(Args a) {
    extern __shared__ __attribute__((aligned(16))) unsigned char lds_raw[];
    Frame F;
    F.lds = (LAS unsigned char*)lds_raw;
    F.G = gridDim.x; { const int bx = blockIdx.x; F.vcu = (F.G % 8 == 0) ? (bx % 8) * (F.G / 8) + bx / 8 : bx; }
    unsigned char* const ws0 = a.ws; size_t wso = 0; unsigned char* ws = ws0;
#define ctl ((gu32*)(ws + WS_CTL))
    volatile LAS unsigned* MISC = (volatile LAS unsigned*)(F.lds + LDSCTL_OFF);
    for (int u = threadIdx.x; u < (LDS_BYTES - LDSCTL_OFF) / 4; u += NWAVES * 64) ((LAS unsigned*)(F.lds + LDSCTL_OFF))[u] = 0u;
    __syncthreads();
    __builtin_amdgcn_s_setreg(1 | (23 << 6) | (0 << 11), 1);
    XcdBarrier bar = xcd_barrier_post((unsigned*)(ctl + CW_BAR), MISC + 8);
#define GRID_BAR() xcd_barrier(bar)
#define FRESH() int tid_ = threadIdx.x; asm volatile("" : "+v"(tid_)); const int lane_ = tid_ & 63, wave_ = __builtin_amdgcn_readfirstlane(tid_ >> 6); \
    int vcu_ = F.vcu, G_ = F.G, bidx_ = blockIdx.x; asm volatile("" : "+s"(vcu_), "+s"(G_), "+s"(bidx_)); const int gw = vcu_ * NWAVES + wave_, NGW = G_ * NWAVES; (void)lane_; (void)gw; (void)NGW; (void)bidx_
#define SUM ((f32x2*)(ws + WS_SUM))
#define ROWTOK ((int*)(ws + WS_ROWTOK))
#define ROWGATE ((float*)(ws + WS_ROWGATE))
#define COST ((float*)(ws + WS_ROPE))
#define SINT ((float*)(ws + WS_ROPE) + (size_t)T * 8)
#define LSE ((float*)(ws + WS_LSE))
#define WFR ((bf16*)(ws + WS_WFR))
#define WIN ((bf16*)(ws + WS_WIN))
#define WOUT ((bf16*)(ws + WS_WOUT))
#define WGU ((bf16*)(ws + WS_WGU))
#define WD ((bf16*)(ws + WS_WD))
#define MOEW ((bf16*)(ws + WS_MOEW))
#define RA ((bf16*)(ws + WS_RA))
#define ZB ((bf16*)(ws + WS_RB))
#define OBR ((bf16*)(ws + WS_RC))
#define QB ZB
#define KB (ZB + (size_t)T * 512)
#define VB (ZB + (size_t)2 * T * 512)
#define UB (ZB + (size_t)3 * T * 512)
#define GB (ZB + (size_t)4 * T * 512)
#define MIXB RA
#define MB VB
#define HLB RA
#define PCB (RA + (size_t)T * 512)
#define ACT ZB
#define ACTM ((bf16*)(ws + WS_ACTM))
#define FSLOT ((bf16*)(ws + WS_FSLOT))
#define RSTDA ((float*)(ws + WS_RSTDA))
#define RSTDF ((float*)(ws + WS_RSTDF))
#define XB ((bf16*)(ws + WS_XB))

#if PH(0)
    {
        FRESH();
        for (int i = tid_; i < 3 * D; i += NWAVES * 64) ((LAS float*)(F.lds + WGAIN_OFF))[i] = (i < 2 * D) ? a.pre_mix_g[i] : a.pre_ffn_g[i - 2 * D];
        __syncthreads();
        convert_items(a, ws, F.lds, 0, NIT_P0, vcu_, G_, wave_, lane_);
        const int gt = vcu_ * (NWAVES * 64) + tid_, NGT = G_ * NWAVES * 64;
        for (int i = gt; i < T * 8; i += NGT) { const int row = i >> 3, f = i & 7;
            const float inv = powf(500000.0f, -(float)f * 0.125f); const float ang = (float)a.pos[row] * inv; float sn, cs; sincosf(ang, &sn, &cs); COST[i] = cs; SINT[i] = sn; }
        for (int i = gt; i < NE * T; i += NGT) ROWTOK[i] = -1;
        for (int i = gt; i < 2 * LW; i += NGT) { const float lm = a.lam[i]; const float sp = (lm > 15.f) ? __expf(-lm) : log1pf(__expf(-lm));
            ((float*)(ws + WS_CCV))[i] = -8.f * sp * 1.4426950408889634f; }
        for (int i = gt; i < 2 * 8 * 16 * 64; i += NGT) {
            const int ln = i & 63, s_ = (i >> 6) & 3, mb = (i >> 8) & 1, gate = (i >> 9) & 1, lg = i >> 10;
            const float* w = (gate ? a.w_igate : a.w_rgate) + (size_t)lg * 64 * 64; const int i0 = 16 * s_ + 8 * (ln >> 5), j = 32 * mb + (ln & 31);
            const float sg = -1.4426950408889634f;
            v4u o; o.x = pk2(sg * w[(i0 + 0) * 64 + j], sg * w[(i0 + 1) * 64 + j]); o.y = pk2(sg * w[(i0 + 2) * 64 + j], sg * w[(i0 + 3) * 64 + j]); o.z = pk2(sg * w[(i0 + 4) * 64 + j], sg * w[(i0 + 5) * 64 + j]); o.w = pk2(sg * w[(i0 + 6) * 64 + j], sg * w[(i0 + 7) * 64 + j]);
            *(GAS v4u*)(WFR + (size_t)i * 8) = o; }
        {
            struct XS { f32x4 v[4]; };
            const float* xin = a.x;
            row_pipe<XS>(gw, NGW, T,
                [&](int m, XS& q) {
#pragma unroll
                    for (int j = 0; j < 4; ++j) q.v[j] = *((const GAS f32x4*)(xin + (size_t)m * D) + lane_ + 64 * j); },
                [&](int m, XS& q) { float s = 0.f;
#pragma unroll
                    for (int j = 0; j < 4; ++j) s += (q.v[j].x * q.v[j].x + q.v[j].y * q.v[j].y) + (q.v[j].z * q.v[j].z + q.v[j].w * q.v[j].w);
                    const float rs = __builtin_amdgcn_rsqf(wave_sum(s) * (1.f / D) + RMS_EPS); if (lane_ == 0) RSTDA[m] = rs;
                    GAS unsigned long long* x8 = (GAS unsigned long long*)(XB + (size_t)m * D) + lane_;
#pragma unroll
                    for (int j = 0; j < 4; ++j) x8[64 * j] = (unsigned long long)pk2(q.v[j].x, q.v[j].y) | ((unsigned long long)pk2(q.v[j].z, q.v[j].w) << 32); });
        }
    }
#endif
    GRID_BAR();

    for (int layer = 0; layer < 2; ++layer) {
        asm volatile("" : "+s"(wso)); ws = ws0 + wso;
#if PH(2)
        {
            FRESH();
            pg8::Gemm g{XB, WIN + (size_t)layer * INC * D, T, INC, D, 0, nullptr}; pg8::StaticOrder S; S.init(T, INC, G_, bidx_);
            pg8::EpiZ E{ZB, (size_t)T * 512, COST, SINT, QSCALE, RSTDA};
            pg8::gemm_phase<pg8::EpiZ, pg8::StaticOrder, false>(F.lds, g, S, E);
        }
#endif
        GRID_BAR();
#if PH(3)
        {
            FRESH();
            lru::LruConst kc; lru::load_const(layer, WFR, a.conv_w, a.conv_b, a.b_rgate, a.b_igate, (const float*)(ws + WS_CCV), kc);
            for (int cu = vcu_; cu < BATCH * 128; cu += G_) { lru::URegs ua; lru::u_load(cu, UB, ua);
                lru::local_unit(cu, layer, kc, ua, GB, SUM, (unsigned*)(ctl + CW_LRU + 64 * (4 * layer + (cu >> 7))), a.lru_out_g, MIXB, F.lds); }
        }
        { FRESH();
          for (int u = vcu_; u < 768; u += G_) { const int bh = u / 24, kq = u % 24;
              if (kq < 8) att::item(bh * 8 + kq, QB, KB, VB, OBR, LSE, F.lds);
              else if (kq < 16) att::item(256 + bh * 8 + (kq - 8), QB, KB, VB, OBR, LSE, F.lds);
              else { att::item(512 + bh * 16 + 2 * (kq - 16), QB, KB, VB, OBR, LSE, F.lds); att::item(513 + bh * 16 + 2 * (kq - 16), QB, KB, VB, OBR, LSE, F.lds); } } }
#endif
        GRID_BAR();
#if PH(4)
        {
            FRESH();
            for (int cu = vcu_; cu < BATCH * 128; cu += G_) attn_combine(cu, layer, OBR, LSE, a.attn_out_g, MIXB);
        }
#endif
        GRID_BAR();
#if PH(5)
        {
            FRESH();
            pg8::Gemm g{MIXB, WOUT + (size_t)layer * D * D, T, D, D, 0, nullptr}; pg8::StaticOrder S; S.init(T, D, G_, bidx_);
            if (layer == 0) {
                using EP = pg8::EpiPost<WS_XB, WS_S1, WS_S2, WS_CTL + 4 * (size_t)CW_PCNT>; static_assert(D == 1024, "EpiPost row length"); EP E{ws, a.post_mix_g};
                pg8::gemm_phase<EP, pg8::StaticOrder, false, false, true>(F.lds, g, S, E);
            } else {
                pg8::EpiBf16 E{MB, D};
                pg8::gemm_phase<pg8::EpiBf16, pg8::StaticOrder, false, false, true>(F.lds, g, S, E);
            }
        }
#endif
        GRID_BAR();
#if PH(6)
        {
        FRESH();
        if (layer != 0) {
            LAS float* rt = (LAS float*)F.lds; LAS int* lcnt = (LAS int*)(F.lds + 32768); LAS int* gbase = lcnt + 8; LAS int* lsel = lcnt + 16; LAS float* lprob = (LAS float*)(lcnt + 16 + 4 * 128);
            for (int i = tid_; i < D * NE; i += NWAVES * 64) { const int k = i >> 3, e = i & 7; rt[e * D + k] = a.router_w[i]; }
            if (tid_ < 8) lcnt[tid_] = 0;
            __syncthreads();
            const int rows_per_wg = T / G_;
            for (int rb = 0; rb < rows_per_wg; rb += 128) {
                struct MX { RawRow m, x; };
                const Gain4 gpost = ld_gain(a.post_mix_g + layer * D, lane_), gpre2 = ld_gain(a.pre_ffn_g + layer * D, lane_); const int mbase = vcu_ * rows_per_wg + rb + wave_ * 16;
                row_pipe<MX>(0, 1, 16,
                  [&](int i, MX& q) { const int m = mbase + i; ld_raw(MB + (size_t)m * D, q.m, lane_); ld_raw(XB + (size_t)m * D, q.x, lane_); },
                  [&](int i, MX& q) {
                    const int lr = wave_ * 16 + i; const int m = mbase + i;
                    f32x4 hn[4];
                    post_mix_row(q.m, q.x, XB + (size_t)m * D, gpost, gpre2, nullptr, (unsigned char*)RA + (size_t)m * D, nullptr, hn, lane_);
                    float lg[8];
#pragma unroll
                    for (int e = 0; e < 8; ++e) { float s = 0.f;
#pragma unroll
                        for (int j = 0; j < 4; ++j) { const f32x4 w = *((const LAS f32x4*)(rt + e * D) + lane_ + 64 * j); s += (hn[j].x * w.x + hn[j].y * w.y) + (hn[j].z * w.z + hn[j].w * w.w); }
                        lg[e] = wave_sum(s); }
                    int e1 = 0; float v1 = lg[0];
#pragma unroll
                    for (int e = 1; e < 8; ++e) if (lg[e] > v1) { v1 = lg[e]; e1 = e; }
                    int e2 = -1; float v2 = -3.0e38f;
#pragma unroll
                    for (int e = 0; e < 8; ++e) if (e != e1 && lg[e] > v2) { v2 = lg[e]; e2 = e; }
                    if (lane_ == 0) { const float p2 = __builtin_amdgcn_rcpf(1.f + __builtin_amdgcn_exp2f(1.4426950408889634f * (v1 - v2))); const float p1 = 1.f - p2;
                        const int r1 = __hip_atomic_fetch_add(&lcnt[e1], 1, __ATOMIC_RELAXED, __HIP_MEMORY_SCOPE_WORKGROUP), r2 = __hip_atomic_fetch_add(&lcnt[e2], 1, __ATOMIC_RELAXED, __HIP_MEMORY_SCOPE_WORKGROUP);
                        lsel[lr * 4 + 0] = e1; lsel[lr * 4 + 1] = e2; lsel[lr * 4 + 2] = r1; lsel[lr * 4 + 3] = r2; lprob[lr * 2 + 0] = p1; lprob[lr * 2 + 1] = p2; }
                  });
                __syncthreads();
                if (tid_ < 8) { gbase[tid_] = (int)__hip_atomic_fetch_add(ctl + CW_CNT + 64 * tid_, (unsigned)lcnt[tid_], RLX_AGENT); }
                __syncthreads();
                if (tid_ < 128) { const int m = vcu_ * rows_per_wg + rb + tid_; const int e1 = lsel[tid_ * 4 + 0], e2 = lsel[tid_ * 4 + 1];
                    const int s1 = e1 * T + gbase[e1] + lsel[tid_ * 4 + 2], s2 = e2 * T + gbase[e2] + lsel[tid_ * 4 + 3];
                    ROWTOK[s1] = 2 * m; ROWGATE[s1] = lprob[tid_ * 2]; ROWTOK[s2] = 2 * m + 1; ROWGATE[s2] = lprob[tid_ * 2 + 1]; }
                __syncthreads();
                if (tid_ < 8) lcnt[tid_] = 0;
                __syncthreads();
            }
        }
        }
#endif
        if (layer != 0) GRID_BAR();
        if (layer == 0) {
#if PH(7)
            {
                FRESH();
                pg8::Gemm g{XB, WGU, T, 2 * FF, D, 0, nullptr}; pg8::StaticOrder S; S.init(T, 2 * FF, G_, bidx_);
                pg8::EpiSwiglu8 E{(unsigned char*)ACT, FF, (const float*)(ws + WS_S2), MOE_ACT_SCALE};
                pg8::gemm_phase<pg8::EpiSwiglu8, pg8::StaticOrder, false, false, true>(F.lds, g, S, E);
            }
#endif
            GRID_BAR();
#if PH(8)
            {
                FRESH();
                pg8::Gemm g{ACT, WD, T, D, FF / 2, 0, nullptr}; pg8::StaticOrder S; S.init(T, D, G_, bidx_);
                pg8::EpiBf16 E{RA, D, 1.f / (MOE_WD_SCALE * MOE_ACT_SCALE)};
                pg8::gemm_phase<pg8::EpiBf16, pg8::StaticOrder, false, true, true>(F.lds, g, S, E);
            }
#endif
            GRID_BAR();
            { FRESH();
            struct FX { RawRow f, x; };
            const Gain4 gpost = ld_gain(a.post_ffn_g + layer * D, lane_);
            row_pipe<FX>(gw, NGW, T,
                [&](int m, FX& q) { ld_raw(RA + (size_t)m * D, q.f, lane_); ld_raw(XB + (size_t)m * D, q.x, lane_); },
                [&](int m, FX& q) { f32x4 f[4]; unpack_raw(q.f, f); post_ffn_row(f, q.x, XB + (size_t)m * D, nullptr, gpost, nullptr, nullptr, RSTDA + m, lane_); }); }
            GRID_BAR();
        } else {
            int ps[9]; ps[0] = 0;
#pragma unroll
            for (int e = 0; e < 8; ++e) { const int c = __builtin_amdgcn_readfirstlane((int)__hip_atomic_load(ctl + CW_CNT + 64 * e, RLX_AGENT)); ps[e + 1] = ps[e] + ((c + 255) >> 8); }
            const int P = ps[8];
            bool first = true;
            for (int p0 = 0; p0 < P || first; ) {
                int np = (P - p0) < CHPAN ? (P - p0) : CHPAN;
                if (first) { if (P > 128 && P - 128 < np) np = P - 128;
                             if (ps[EDEF] < np) np = ps[EDEF]; }
#if PH(10)
                {   FRESH();
                    pg8::Gemm g{RA, MOEW, T, 2 * FF, D / 2, (size_t)3 * D * FF, ROWTOK};
                    pg8::MoeOrder S{p0, np, 2 * FF / 256, np * (2 * FF / 256), G_, bidx_, T, ps[1], ps[2], ps[3], ps[4], ps[5], ps[6], ps[7]};
                    pg8::EpiSwigluF8 E{(unsigned char*)ACTM, FF, 1.f / MOE_WGU_SCALE, MOE_ACT_SCALE};
                    pg8::gemm_phase<pg8::EpiSwigluF8, pg8::MoeOrder, true, true, true>(F.lds, g, S, E);
                }
#endif
                const int Gn = F.G; const int tailg = (np * (2 * FF / 256)) % Gn; const int n1 = (first && tailg > 0) ? ((Gn - tailg) < NIT_DEF ? (Gn - tailg) : NIT_DEF) : 0;
                if (first) { FRESH(); const int it = bidx_ - tailg;
                    if (it >= 0 && it < n1) { WRegs r1; const WItem q = w_item_of(a, ws, NIT_P0 + it); w_load(q, r1, wave_, lane_); w_finish(q, r1, F.lds, wave_, lane_); } }
                GRID_BAR();
#if PH(11)
                {   FRESH();
                    pg8::Gemm g{ACTM, MOEW + (size_t)D * FF, np * 256, D, FF / 2, (size_t)3 * D * FF, nullptr};
                    pg8::MoeOrder S{p0, np, D / 256, np * (D / 256), G_, bidx_, T, ps[1], ps[2], ps[3], ps[4], ps[5], ps[6], ps[7]};
                    pg8::EpiMoeDown E{FSLOT, (size_t)T * D, ROWTOK, ROWGATE, 1.f / (MOE_WD_SCALE * MOE_ACT_SCALE)};
                    pg8::gemm_phase<pg8::EpiMoeDown, pg8::MoeOrder, false, true, true>(F.lds, g, S, E);
                }
#endif
                if (first) {
                    FRESH();
                    const int tail = (np * (D / 256)) % G_;
                    { const int slot = bidx_ - tail, nslots = G_ - tail;
                      if (slot >= 0) for (int it = n1 + slot; it < NIT_DEF; it += nslots) { WRegs r1; const WItem q = w_item_of(a, ws, NIT_P0 + it); w_load(q, r1, wave_, lane_); w_finish(q, r1, F.lds, wave_, lane_); } }
                }
                GRID_BAR();
                p0 += np; first = false;
            }
            { FRESH();
            struct FFX { RawRow f0, f1, x; };
            const Gain4 gpost = ld_gain(a.post_ffn_g + layer * D, lane_); float* outp = a.out;
            row_pipe<FFX>(gw, NGW, T,
                [&](int m, FFX& q) { ld_raw(FSLOT + (size_t)m * D, q.f0, lane_); ld_raw(FSLOT + (size_t)T * D + (size_t)m * D, q.f1, lane_); ld_raw(XB + (size_t)m * D, q.x, lane_); },
                [&](int m, FFX& q) { f32x4 f0[4], f1[4]; unpack_raw(q.f0, f0); unpack_raw(q.f1, f1);
#pragma unroll
                    for (int j = 0; j < 4; ++j) f0[j] = f0[j] + f1[j];
                    post_ffn_row(f0, q.x, nullptr, outp + (size_t)m * D, gpost, nullptr, nullptr, nullptr, lane_); }); }
        }
    }
#undef GRID_BAR
#undef FRESH
#undef ctl
}

extern "C" void kernel_launch(void* const* d_in, const int* in_sizes, int n_in, void* d_out, int out_size, void* d_ws, size_t ws_size, hipStream_t stream) {
    static int grid = 0;
    if (grid == 0) {
        if (n_in != 24 || in_sizes[0] != T * D || out_size != T * D || ws_size < WS_END) { fprintf(stderr, "kernel_launch: unexpected shapes / workspace (n_in %d, ws %zu, need %zu); nothing launched\n", n_in, ws_size, (size_t)WS_END); grid = -1; return; }
        int dev = 0, cus = 0, per_cu = 0;
        if (hipGetDevice(&dev) != hipSuccess || hipDeviceGetAttribute(&cus, hipDeviceAttributeMultiprocessorCount, dev) != hipSuccess) { grid = -1; return; }
        if (hipFuncSetAttribute((const void*)hymba_fwd, hipFuncAttributeMaxDynamicSharedMemorySize, LDS_BYTES) != hipSuccess) { fprintf(stderr, "kernel_launch: hipFuncSetAttribute failed\n"); grid = -1; return; }
        if (hipOccupancyMaxActiveBlocksPerMultiprocessor(&per_cu, (const void*)hymba_fwd, NWAVES * 64, LDS_BYTES) != hipSuccess || per_cu < 1) { fprintf(stderr, "kernel_launch: occupancy query says %d\n", per_cu); }
        (void)hipGetLastError();
        grid = cus;
    }
    if (grid < 0) return;
    if (hipMemsetAsync((char*)d_ws + WS_CTL, 0, CTL_ZERO_BYTES, stream) != hipSuccess) return;
    Args a{};
    a.x = (const float*)d_in[0]; a.pos = (const int*)d_in[1]; a.pre_mix_g = (const float*)d_in[2]; a.w_in = (const float*)d_in[3]; a.conv_w = (const float*)d_in[4]; a.conv_b = (const float*)d_in[5];
    a.w_rgate = (const float*)d_in[6]; a.b_rgate = (const float*)d_in[7]; a.w_igate = (const float*)d_in[8]; a.b_igate = (const float*)d_in[9]; a.lam = (const float*)d_in[10];
    a.attn_out_g = (const float*)d_in[11]; a.lru_out_g = (const float*)d_in[12]; a.w_out = (const float*)d_in[13]; a.post_mix_g = (const float*)d_in[14]; a.pre_ffn_g = (const float*)d_in[15]; a.post_ffn_g = (const float*)d_in[16];
    a.dw_gate = (const float*)d_in[17]; a.dw_up = (const float*)d_in[18]; a.dw_down = (const float*)d_in[19]; a.router_w = (const float*)d_in[20]; a.mw_gate = (const float*)d_in[21]; a.mw_up = (const float*)d_in[22]; a.mw_down = (const float*)d_in[23];
    a.out = (float*)d_out; a.ws = (unsigned char*)d_ws;
    hipLaunchKernelGGL(hymba_fwd, dim3(grid), dim3(NWAVES * 64), LDS_BYTES, stream, a);
}
```

```cpp
#include <hip/hip_runtime.h>
#include <cstdio>
#include <cstdint>
#include <cmath>
namespace pg8 {
#define PG8_LAS __attribute__((address_space(3)))
typedef unsigned short bf16_t;
typedef short bf16x8 __attribute__((ext_vector_type(8)));
typedef float f32x4 __attribute__((ext_vector_type(4)));
typedef unsigned u32x4 __attribute__((ext_vector_type(4)));
typedef unsigned u32x2 __attribute__((ext_vector_type(2)));
typedef int v4i_t __attribute__((ext_vector_type(4)));
typedef int v8i_t __attribute__((ext_vector_type(8)));
constexpr int BM = 256, BK = 64, HALF = 128, HTB = HALF * BK * 2  , STAGE_BYTES = 8 * HTB, NXCD = 8, WGM = 8;

__host__ __device__ __forceinline__ int lds_byte(int r, int c) { const int st = (r >> 4) * 2 + (c >> 5), rr = r & 15, cc = c & 31, ob = rr * 64 + cc * 2; return st * 1024 + (ob ^ (((ob >> 9) & 1) << 5)); }
__host__ __device__ __forceinline__ void stage_rc(int b, int& R, int& C) { const int st = b / 1024, sb = b % 1024, swz = sb ^ (((sb >> 9) & 1) << 5); R = (st >> 1) * 16 + swz / 64; C = (st & 1) * 32 + (swz % 64) / 2; }
__host__ __device__ __forceinline__ int perm32(int rho) { const int n = rho >> 4, i = rho & 15; return 8 * (i >> 2) + 4 * n + (i & 3); }

struct Unit { int pm, pn, pl, e, gb; };
struct Gemm { const bf16_t* A; const bf16_t* Bt; int M, N, K; size_t bstride  ; const int* rowtok  ; };

__device__ __forceinline__ void tile_of(int wgid, int nM, int nN, int& pm, int& pn) {
    const int nwg = nM * nN;
    { const int q = nwg / NXCD, r = nwg % NXCD, xcd = wgid % NXCD, off = wgid / NXCD; wgid = (xcd < r ? xcd * (q + 1) : r * (q + 1) + (xcd - r) * q) + off; }
    const int nig = WGM * nN, gid = wgid / nig, fm = gid * WGM, gsz = (nM - fm) < WGM ? (nM - fm) : WGM;
    pm = fm + ((wgid % nig) % gsz); pn = (wgid % nig) / gsz;
}
struct StaticOrder {
    int nM, nN, nwg, G, c;
    __device__ void init(int M, int N, int G_, int c_) { nM = M / BM; nN = N / BM; nwg = nM * nN; G = G_; c = c_; }
    __device__ __forceinline__ bool next(int i, Unit& u) const {
        const long L = (long)i * G + c; if (L >= nwg) return false;
        int pm, pn; tile_of((int)L, nM, nN, pm, pn); u.pm = pm; u.pn = pn; u.pl = pm; u.e = 0; u.gb = pm * BM; return true;
    }
};
struct MoeOrder {
    int p0, np, nN, nwg, G, c, seg; int ps1, ps2, ps3, ps4, ps5, ps6, ps7;
    __device__ __forceinline__ bool next(int i, Unit& u) const {
        const long L = (long)i * G + c; if (L >= nwg) return false;
        int pm, pn; tile_of((int)L, np, nN, pm, pn); u.pl = pm; u.pn = pn; pm += p0; u.pm = pm;
        const int e = (pm >= ps1) + (pm >= ps2) + (pm >= ps3) + (pm >= ps4) + (pm >= ps5) + (pm >= ps6) + (pm >= ps7);
        int pse = 0; pse = (pm >= ps1) ? ps1 : pse; pse = (pm >= ps2) ? ps2 : pse; pse = (pm >= ps3) ? ps3 : pse; pse = (pm >= ps4) ? ps4 : pse; pse = (pm >= ps5) ? ps5 : pse; pse = (pm >= ps6) ? ps6 : pse; pse = (pm >= ps7) ? ps7 : pse;
        u.e = e; u.gb = e * seg + (pm - pse) * BM; return true;
    }
};

__device__ __forceinline__ unsigned cvt_pk_bf16(float lo, float hi) { unsigned r; asm volatile("v_cvt_pk_bf16_f32 %0, %1, %2" : "=v"(r) : "v"(lo), "v"(hi)); return r; }

constexpr int SIDE_OFF = STAGE_BYTES, SIDE_BYTES = 17 * 1024;
__device__ __forceinline__ void side_dma(const void* gsrc_lane, PG8_LAS unsigned char* ldst_wave) {
    __builtin_amdgcn_global_load_lds((const unsigned*)gsrc_lane, (PG8_LAS unsigned*)ldst_wave, 16, 0, 0);
}
struct EpiBf16 {
    static constexpr bool PERM = true;
    bf16_t* O; int ldc; float oscale = 1.f;
    __device__ __forceinline__ void stage_side(PG8_LAS unsigned char*, const Unit&, int, int) const {}
    __device__ __forceinline__ void operator()(const f32x4 (&acc)[2][2][4][2], const Unit& u, int wr, int wc, int fr, int fq, const PG8_LAS unsigned char* side) const {
        const int row0 = u.pm * BM + wr * 64 + fr, col0 = u.pn * BM + wc * 32 + 8 * fq;
#pragma unroll
        for (int ai = 0; ai < 2; ++ai)
#pragma unroll
            for (int m = 0; m < 4; ++m) { bf16_t* rowp = O + (size_t)(row0 + ai * HALF + m * 16) * ldc + col0;
#pragma unroll
                for (int bj = 0; bj < 2; ++bj) { const f32x4 v0 = acc[ai][bj][m][0] * oscale, v1 = acc[ai][bj][m][1] * oscale;
                    u32x4 w; w.x = cvt_pk_bf16(v0[0], v0[1]); w.y = cvt_pk_bf16(v0[2], v0[3]); w.z = cvt_pk_bf16(v1[0], v1[1]); w.w = cvt_pk_bf16(v1[2], v1[3]);
                    *(u32x4*)(rowp + bj * HALF) = w; } }
    }
};
struct EpiZ {
    static constexpr bool PERM = true;
    bf16_t* Z; size_t tstride; const float* cosT; const float* sinT; float qscale; const float* rstd;
    __device__ __forceinline__ void stage_side(PG8_LAS unsigned char* side, const Unit& u, int wid, int lane) const {
        if (wid == 0) side_dma(rstd + (size_t)u.pm * BM + 4 * lane, side);
        if (u.pn < 4) { const size_t r0 = ((size_t)u.pm * BM + 32 * wid) * 8 + 4 * lane;
            side_dma(cosT + r0, side + 1024 + wid * 1024); side_dma(sinT + r0, side + 9216 + wid * 1024); }
    }
    __device__ __forceinline__ void operator()(const f32x4 (&acc)[2][2][4][2], const Unit& u, int wr, int wc, int fr, int fq, const PG8_LAS unsigned char* side) const {
        const int t = u.pn >> 1; bf16_t* base = Z + (size_t)t * tstride;
        const int row0 = u.pm * BM + wr * 64 + fr, col0 = (u.pn & 1) * 256 + wc * 32 + 8 * fq;
        const bool rotw = (t < 2) && ((wc & 1) == 0);
        const float sc = (t == 0) ? qscale : 1.f;
#pragma unroll
        for (int ai = 0; ai < 2; ++ai)
#pragma unroll
            for (int m = 0; m < 4; ++m) { const int row = row0 + ai * HALF + m * 16, rl = wr * 64 + fr + ai * HALF + m * 16; const float rs = ((const PG8_LAS float*)side)[rl] * sc;
                f32x4 v[2][2];
#pragma unroll
                for (int bj = 0; bj < 2; ++bj)
#pragma unroll
                    for (int n = 0; n < 2; ++n) v[bj][n] = acc[ai][bj][m][n] * rs;
                if (rotw) {
                    f32x4 c4[2], s4[2];
#pragma unroll
                    for (int n = 0; n < 2; ++n) { c4[n] = *(const PG8_LAS f32x4*)(side + 1024 + rl * 32 + 16 * n); s4[n] = *(const PG8_LAS f32x4*)(side + 9216 + rl * 32 + 16 * n); }
                    const float sg = (fq == 0) ? -1.f : 1.f;
#pragma unroll
                    for (int bj = 0; bj < 2; ++bj)
#pragma unroll
                        for (int n = 0; n < 2; ++n)
#pragma unroll
                            for (int e = 0; e < 4; ++e) { const float mine = v[bj][n][e]; const float other = __shfl_xor(mine, 16);
                                const float r = mine * c4[n][e] + sg * other * s4[n][e]; v[bj][n][e] = (fq < 2) ? r : mine; }
                }
                bf16_t* rowp = base + (size_t)row * 512 + col0;
#pragma unroll
                for (int bj = 0; bj < 2; ++bj) { const f32x4 v0 = v[bj][0], v1 = v[bj][1];
                    u32x4 w; w.x = cvt_pk_bf16(v0[0], v0[1]); w.y = cvt_pk_bf16(v0[2], v0[3]); w.z = cvt_pk_bf16(v1[0], v1[1]); w.w = cvt_pk_bf16(v1[2], v1[3]);
                    *(u32x4*)(rowp + bj * HALF) = w; } }
    }
};
__device__ __forceinline__ float silu_f(float x) { return x * __builtin_amdgcn_rcpf(1.f + __builtin_amdgcn_exp2f(-1.4426950408889634f * x)); }
struct EpiSwiglu {
    static constexpr bool PERM = true;
    bf16_t* O; int ldc; const float* rstd;
    __device__ __forceinline__ void stage_side(PG8_LAS unsigned char* side, const Unit& u, int wid, int lane) const { if (wid == 0) side_dma(rstd + (size_t)u.pl * BM + 4 * lane, side); }
    __device__ __forceinline__ void operator()(const f32x4 (&acc)[2][2][4][2], const Unit& u, int wr, int wc, int fr, int fq, const PG8_LAS unsigned char* side) const {
        const int row0 = u.pl * BM + wr * 64 + fr, col0 = u.pn * HALF + wc * 32 + 8 * fq;
#pragma unroll
        for (int ai = 0; ai < 2; ++ai)
#pragma unroll
            for (int m = 0; m < 4; ++m) { bf16_t* rowp = O + (size_t)(row0 + ai * HALF + m * 16) * ldc + col0; const float rs = ((const PG8_LAS float*)side)[wr * 64 + fr + ai * HALF + m * 16];
                f32x4 v[2];
                const float kg = -1.4426950408889634f * rs, ir2 = __builtin_amdgcn_rcpf(rs * rs);
#pragma unroll
                for (int n = 0; n < 2; ++n) { const f32x4 g = acc[ai][0][m][n], up = acc[ai][1][m][n];
#pragma unroll
                    for (int e = 0; e < 4; ++e) v[n][e] = (g[e] * up[e]) * __builtin_amdgcn_rcpf(__builtin_fmaf(__builtin_amdgcn_exp2f(kg * g[e]), ir2, ir2)); }
                u32x4 w; w.x = cvt_pk_bf16(v[0][0], v[0][1]); w.y = cvt_pk_bf16(v[0][2], v[0][3]); w.z = cvt_pk_bf16(v[1][0], v[1][1]); w.w = cvt_pk_bf16(v[1][2], v[1][3]);
                *(u32x4*)rowp = w; }
    }
};

__device__ __forceinline__ float clamp448(float v) { return __builtin_amdgcn_fmed3f(v, -448.f, 448.f); }
__device__ __forceinline__ unsigned pk4_fp8(float a, float b, float c, float d) { int w = 0; w = __builtin_amdgcn_cvt_pk_fp8_f32(a, b, w, false); w = __builtin_amdgcn_cvt_pk_fp8_f32(c, d, w, true); return (unsigned)w; }
struct EpiSwiglu8 {
    static constexpr bool PERM = true;
    unsigned char* O; int ldc; const float* rstd; float ascale;
    __device__ __forceinline__ void stage_side(PG8_LAS unsigned char* side, const Unit& u, int wid, int lane) const { if (wid == 0) side_dma(rstd + (size_t)u.pl * BM + 4 * lane, side); }
    __device__ __forceinline__ void operator()(const f32x4 (&acc)[2][2][4][2], const Unit& u, int wr, int wc, int fr, int fq, const PG8_LAS unsigned char* side) const {
        const int row0 = u.pl * BM + wr * 64 + fr, col0 = u.pn * HALF + wc * 32 + 8 * fq;
        const float ia = 1.f / ascale;
#pragma unroll
        for (int ai = 0; ai < 2; ++ai)
#pragma unroll
            for (int m = 0; m < 4; ++m) { unsigned char* rowp = O + (size_t)(row0 + ai * HALF + m * 16) * ldc + col0; const float rs = ((const PG8_LAS float*)side)[wr * 64 + fr + ai * HALF + m * 16];
                f32x4 v[2];
                const float kg = -1.4426950408889634f * rs, ir2 = __builtin_amdgcn_rcpf(rs * rs) * ia;
#pragma unroll
                for (int n = 0; n < 2; ++n) { const f32x4 g = acc[ai][0][m][n], up = acc[ai][1][m][n];
                    const f32x4 t = g * kg; const f32x4 ex = (f32x4){__builtin_amdgcn_exp2f(t[0]), __builtin_amdgcn_exp2f(t[1]), __builtin_amdgcn_exp2f(t[2]), __builtin_amdgcn_exp2f(t[3])};
                    const f32x4 dn = ex * ir2 + ir2; const f32x4 rc = (f32x4){__builtin_amdgcn_rcpf(dn[0]), __builtin_amdgcn_rcpf(dn[1]), __builtin_amdgcn_rcpf(dn[2]), __builtin_amdgcn_rcpf(dn[3])};
                    v[n] = (g * up) * rc; }
                u32x2 w; w.x = pk4_fp8(v[0][0], v[0][1], v[0][2], v[0][3]); w.y = pk4_fp8(v[1][0], v[1][1], v[1][2], v[1][3]);
                *(u32x2*)rowp = w; }
    }
};
struct EpiSwigluF8 {
    static constexpr bool PERM = true;
    unsigned char* O; int ldc; float wscale, ascale;
    __device__ __forceinline__ void stage_side(PG8_LAS unsigned char*, const Unit&, int, int) const {}
    __device__ __forceinline__ void operator()(const f32x4 (&acc)[2][2][4][2], const Unit& u, int wr, int wc, int fr, int fq, const PG8_LAS unsigned char* side) const {
        const int row0 = u.pl * BM + wr * 64 + fr, col0 = u.pn * HALF + wc * 32 + 8 * fq;
        const float ic = 1.f / (wscale * wscale * ascale);
#pragma unroll
        for (int ai = 0; ai < 2; ++ai)
#pragma unroll
            for (int m = 0; m < 4; ++m) { unsigned char* rowp = O + (size_t)(row0 + ai * HALF + m * 16) * ldc + col0;
                f32x4 v[2];
#pragma unroll
                for (int n = 0; n < 2; ++n) { const f32x4 g = acc[ai][0][m][n], up = acc[ai][1][m][n];
                    const f32x4 t = g * (-1.4426950408889634f * wscale); const f32x4 ex = (f32x4){__builtin_amdgcn_exp2f(t[0]), __builtin_amdgcn_exp2f(t[1]), __builtin_amdgcn_exp2f(t[2]), __builtin_amdgcn_exp2f(t[3])};
                    const f32x4 dn = ex * ic + ic; const f32x4 rc = (f32x4){__builtin_amdgcn_rcpf(dn[0]), __builtin_amdgcn_rcpf(dn[1]), __builtin_amdgcn_rcpf(dn[2]), __builtin_amdgcn_rcpf(dn[3])};
                    v[n] = (g * up) * rc; }
                u32x2 w; w.x = pk4_fp8(v[0][0], v[0][1], v[0][2], v[0][3]); w.y = pk4_fp8(v[1][0], v[1][1], v[1][2], v[1][3]);
                *(u32x2*)rowp = w; }
    }
};
struct EpiSwigluF8B {
    static constexpr bool PERM = true;
    bf16_t* O; int ldc; float wscale;
    __device__ __forceinline__ void stage_side(PG8_LAS unsigned char*, const Unit&, int, int) const {}
    __device__ __forceinline__ void operator()(const f32x4 (&acc)[2][2][4][2], const Unit& u, int wr, int wc, int fr, int fq, const PG8_LAS unsigned char* side) const {
        const int row0 = u.pl * BM + wr * 64 + fr, col0 = u.pn * HALF + wc * 32 + 8 * fq;
        const float ic = 1.f / (wscale * wscale);
#pragma unroll
        for (int ai = 0; ai < 2; ++ai)
#pragma unroll
            for (int m = 0; m < 4; ++m) { bf16_t* rowp = O + (size_t)(row0 + ai * HALF + m * 16) * ldc + col0;
                f32x4 v[2];
#pragma unroll
                for (int n = 0; n < 2; ++n) { const f32x4 g = acc[ai][0][m][n], up = acc[ai][1][m][n];
                    const f32x4 t = g * (-1.4426950408889634f * wscale); const f32x4 ex = (f32x4){__builtin_amdgcn_exp2f(t[0]), __builtin_amdgcn_exp2f(t[1]), __builtin_amdgcn_exp2f(t[2]), __builtin_amdgcn_exp2f(t[3])};
                    const f32x4 dn = ex * ic + ic; const f32x4 rc = (f32x4){__builtin_amdgcn_rcpf(dn[0]), __builtin_amdgcn_rcpf(dn[1]), __builtin_amdgcn_rcpf(dn[2]), __builtin_amdgcn_rcpf(dn[3])};
                    v[n] = (g * up) * rc; }
                u32x4 w; w.x = cvt_pk_bf16(v[0][0], v[0][1]); w.y = cvt_pk_bf16(v[0][2], v[0][3]); w.z = cvt_pk_bf16(v[1][0], v[1][1]); w.w = cvt_pk_bf16(v[1][2], v[1][3]);
                *(u32x4*)rowp = w; }
    }
};
struct EpiMoeDown {
    static constexpr bool PERM = true;
    bf16_t* F; size_t kstride; const int* rowtok; const float* rowgate; float oscale;
    __device__ __forceinline__ void stage_side(PG8_LAS unsigned char* side, const Unit& u, int wid, int lane) const {
        if (wid == 0) side_dma(rowtok + (size_t)u.gb + 4 * lane, side);
        if (wid == 1) side_dma(rowgate + (size_t)u.gb + 4 * lane, side + 1024);
    }
    __device__ __forceinline__ void operator()(const f32x4 (&acc)[2][2][4][2], const Unit& u, int wr, int wc, int fr, int fq, const PG8_LAS unsigned char* side) const {
        const int col0 = u.pn * BM + wc * 32 + 8 * fq;
#pragma unroll
        for (int ai = 0; ai < 2; ++ai)
#pragma unroll
            for (int m = 0; m < 4; ++m) { const int sl = wr * 64 + fr + ai * HALF + m * 16; const int tk = ((const PG8_LAS int*)side)[sl]; const float gt = ((const PG8_LAS float*)(side + 1024))[sl] * oscale;
                if (tk >= 0) { bf16_t* rowp = F + (size_t)(tk & 1) * kstride + (size_t)(tk >> 1) * 1024 + col0;
#pragma unroll
                    for (int bj = 0; bj < 2; ++bj) { const f32x4 v0 = acc[ai][bj][m][0] * gt, v1 = acc[ai][bj][m][1] * gt;
                        u32x4 w; w.x = cvt_pk_bf16(v0[0], v0[1]); w.y = cvt_pk_bf16(v0[2], v0[3]); w.z = cvt_pk_bf16(v1[0], v1[1]); w.w = cvt_pk_bf16(v1[2], v1[3]);
                        *(u32x4*)(rowp + bj * HALF) = w; } } }
    }
};

template <class Epi, class Sched, bool GATHER, bool FP8 = false, bool PEEL = false>
__device__ __forceinline__ void gemm_phase(PG8_LAS unsigned char* lds, const Gemm g, const Sched& S, const Epi& E) {
    int tid = threadIdx.x; asm volatile("" : "+v"(tid));
    const int wid = __builtin_amdgcn_readfirstlane(tid >> 6), lane = tid & 63, wr = wid >> 2, wc = wid & 3, fr = lane & 15, fq = lane >> 4;
    const int K = g.K, nt = K / BK;
    unsigned voffB[2]; unsigned vc[2][2], vn[2][2]; int RA[2], CA[2];
#pragma unroll
    for (int i = 0; i < 2; ++i) { int R, C; stage_rc(tid * 16 + i * 8192, R, C); const int Rb = Epi::PERM ? ((R & ~31) + perm32(R & 31)) : R;
        RA[i] = R; CA[i] = C; voffB[i] = (unsigned)(Rb * K + C) * 2u;
        vc[0][i] = vc[1][i] = vn[0][i] = vn[1][i] = (unsigned)(R * K + C) * 2u; }
    const size_t kstep = (size_t)(BK * 2);
    const size_t hstep = (size_t)HALF * K * 2;
    const size_t hstepA = GATHER ? 0 : hstep;
    const size_t tstep = 2 * hstep;
    const unsigned ldsw = (unsigned)wid * 1024u;
    const int aoff = lds_byte(wr * 64 + fr, fq * 8), boff = lds_byte(wc * 32 + fr, fq * 8);
#define PG8_SA(b, h) (((b) * 2 + (h)) * HTB)
#define PG8_SB(b, h) ((4 + (b) * 2 + (h)) * HTB)
#define PG8_STAGE(bufoff, gbase, voff) do { _Pragma("unroll") for (int _i = 0; _i < 2; ++_i) { unsigned _o = (voff)[_i]; asm volatile("" : "+v"(_o));     \
        __builtin_amdgcn_global_load_lds((const unsigned*)((const char*)(gbase) + _o), (PG8_LAS unsigned*)(lds + (bufoff) + ldsw + _i * 8192), 16, 0, 0); } } while (0)
#define PG8_STAGE_A(b, h, P, VO) PG8_STAGE(PG8_SA(b, h), (P) + (h) * hstepA, (VO)[h])
#define PG8_LDA(dst, b, h) do { _Pragma("unroll") for (int m = 0; m < 4; ++m) { dst[m].lo = *(const PG8_LAS v4i_t*)(lds + PG8_SA(b, h) + aoff + m * 2048); dst[m].hi = *(const PG8_LAS v4i_t*)(lds + PG8_SA(b, h) + aoff + m * 2048 + 1024); } } while (0)
#define PG8_LDB(dst, b, h) do { _Pragma("unroll") for (int n = 0; n < 2; ++n) { dst[n].lo = *(const PG8_LAS v4i_t*)(lds + PG8_SB(b, h) + boff + n * 2048); dst[n].hi = *(const PG8_LAS v4i_t*)(lds + PG8_SB(b, h) + boff + n * 2048 + 1024); } } while (0)
#define PG8_MMA(ai, bj, At, Bt) do { __builtin_amdgcn_s_setprio(1); _Pragma("unroll") for (int m = 0; m < 4; ++m) _Pragma("unroll") for (int n = 0; n < 2; ++n) { \
        if constexpr (FP8) asm volatile("v_mfma_scale_f32_16x16x128_f8f6f4 %0, %1, %2, %0, %3, %3 op_sel_hi:[0,0,0]" : "+v"(acc[ai][bj][m][n]) : "v"(Bt[n]), "v"(At[m]), "v"(f8one));     \
        else { const v4i_t blo_ = Bt[n].lo, bhi_ = Bt[n].hi, alo_ = At[m].lo, ahi_ = At[m].hi;     \
               acc[ai][bj][m][n] = __builtin_amdgcn_mfma_f32_16x16x32_bf16(__builtin_bit_cast(bf16x8, blo_), __builtin_bit_cast(bf16x8, alo_), acc[ai][bj][m][n], 0, 0, 0); \
               acc[ai][bj][m][n] = __builtin_amdgcn_mfma_f32_16x16x32_bf16(__builtin_bit_cast(bf16x8, bhi_), __builtin_bit_cast(bf16x8, ahi_), acc[ai][bj][m][n], 0, 0, 0); } } \
        __builtin_amdgcn_s_setprio(0); } while (0)
#define PG8_MMA0(ai, bj, At, Bt) do { __builtin_amdgcn_s_setprio(1); \
        if constexpr (FP8) { _Pragma("unroll") for (int m = 0; m < 4; ++m) _Pragma("unroll") for (int n = 0; n < 2; ++n) \
            asm volatile("v_mfma_scale_f32_16x16x128_f8f6f4 %0, %1, %2, 0, %3, %3 op_sel_hi:[0,0,0]" : "=&v"(acc[ai][bj][m][n]) : "v"(Bt[n]), "v"(At[m]), "v"(f8one)); } \
        else { _Pragma("unroll") for (int m = 0; m < 4; ++m) _Pragma("unroll") for (int n = 0; n < 2; ++n) { const v4i_t blo_ = Bt[n].lo, alo_ = At[m].lo; \
                   asm volatile("v_mfma_f32_16x16x32_bf16 %0, %1, %2, 0" : "=&v"(acc[ai][bj][m][n]) : "v"(blo_), "v"(alo_)); }     \
               _Pragma("unroll") for (int m = 0; m < 4; ++m) _Pragma("unroll") for (int n = 0; n < 2; ++n) { const v4i_t bhi_ = Bt[n].hi, ahi_ = At[m].hi; \
                   acc[ai][bj][m][n] = __builtin_amdgcn_mfma_f32_16x16x32_bf16(__builtin_bit_cast(bf16x8, bhi_), __builtin_bit_cast(bf16x8, ahi_), acc[ai][bj][m][n], 0, 0, 0); } } \
        __builtin_amdgcn_s_setprio(0); } while (0)
#define PG8_WAIT_V(n) asm volatile("s_waitcnt vmcnt(" #n ")" ::: "memory")
#define PG8_WAIT_L(n) asm volatile("s_waitcnt lgkmcnt(" #n ")" ::: "memory")
#define PG8_BAR __builtin_amdgcn_s_barrier()
#define PG8_SCHED __builtin_amdgcn_sched_barrier(0)
#define PG8_GATHER_OFFS(dst, U) do { _Pragma("unroll") for (int _h = 0; _h < 2; ++_h) _Pragma("unroll") for (int _i = 0; _i < 2; ++_i) { \
        int _tk = g.rowtok[(U).gb + _h * HALF + RA[_i]]; _tk = _tk < 0 ? 0 : (_tk >> 1); dst[_h][_i] = (unsigned)(_tk * K + CA[_i]) * 2u; } } while (0)
    Unit cur, nxt; int ui = 0;
    if (!S.next(0, cur)) return;
    f32x4 acc[2][2][4][2];
    if constexpr (!PEEL) {
#pragma unroll
    for (int a = 0; a < 2; ++a)
#pragma unroll
        for (int b = 0; b < 2; ++b)
#pragma unroll
            for (int m = 0; m < 4; ++m)
#pragma unroll
                for (int n = 0; n < 2; ++n) acc[a][b][m][n] = (f32x4){0.f, 0.f, 0.f, 0.f};
    }
    const int f8one = 0x7F7F7F7F;
    v8i_t At[4], B0[2], B1[2];
    if constexpr (GATHER) PG8_GATHER_OFFS(vc, cur);
    const char* cA = (const char*)g.A + (GATHER ? (size_t)0 : (size_t)cur.pl * tstep); const char* cB = (const char*)g.Bt + (size_t)cur.e * g.bstride + (size_t)cur.pn * tstep;
    PG8_STAGE(PG8_SB(0, 0), cB, voffB); PG8_STAGE(PG8_SB(0, 1), cB + hstep, voffB); PG8_STAGE_A(0, 0, cA, vc); PG8_STAGE_A(0, 1, cA, vc);
    if (wr == 1) PG8_BAR;
    PG8_WAIT_V(2); PG8_BAR;
    PG8_STAGE(PG8_SB(1, 0), cB + kstep, voffB); PG8_STAGE_A(1, 0, cA + kstep, vc); PG8_STAGE(PG8_SB(1, 1), cB + hstep + kstep, voffB);
    PG8_WAIT_V(6); PG8_BAR;
#pragma nounroll
    for (;;) {
        const bool has_next = S.next(ui + 1, nxt);
        const char* nA = has_next ? (const char*)g.A + (GATHER ? (size_t)0 : (size_t)nxt.pl * tstep) : cA;
        const char* nB = has_next ? (const char*)g.Bt + (size_t)nxt.e * g.bstride + (size_t)nxt.pn * tstep : cB;
        if constexpr (GATHER) { if (has_next) PG8_GATHER_OFFS(vn, nxt); else { _Pragma("unroll") for (int _h = 0; _h < 2; ++_h) _Pragma("unroll") for (int _i = 0; _i < 2; ++_i) vn[_h][_i] = vc[_h][_i]; } }
        if constexpr (PEEL) {
            const int t = 0;
            const bool last = (t == nt - 2);
            const char* a1 = cA + (size_t)(t + 1) * kstep;
            const char* a2 = last ? nA : cA + (size_t)(t + 2) * kstep; const char* b2 = last ? nB : cB + (size_t)(t + 2) * kstep;
            const char* a3 = a2 + kstep; const char* b3 = b2 + kstep;
            unsigned v2[2][2];
#pragma unroll
            for (int _h = 0; _h < 2; ++_h)
#pragma unroll
                for (int _i = 0; _i < 2; ++_i) v2[_h][_i] = (GATHER && last) ? vn[_h][_i] : vc[_h][_i];
            if (t == 2) E.stage_side(lds + SIDE_OFF, cur, wid, lane);
            PG8_LDB(B0, 0, 0); PG8_LDB(B1, 0, 1); PG8_SCHED; PG8_LDA(At, 0, 0); PG8_STAGE_A(1, 1, a1, vc);
            PG8_WAIT_V(8); PG8_WAIT_L(0); PG8_BAR; PG8_MMA0(0, 0, At, B0); PG8_MMA0(0, 1, At, B1); PG8_BAR; PG8_SCHED;
            PG8_LDA(At, 0, 1); PG8_STAGE(PG8_SB(0, 0), b2, voffB); PG8_STAGE(PG8_SB(0, 1), b2 + hstep, voffB); PG8_STAGE_A(0, 0, a2, v2);
            PG8_WAIT_V(8); PG8_WAIT_L(0); PG8_BAR; PG8_MMA0(1, 0, At, B0); PG8_MMA0(1, 1, At, B1); PG8_BAR; PG8_SCHED;
            PG8_LDB(B0, 1, 0); PG8_LDB(B1, 1, 1); PG8_SCHED; PG8_LDA(At, 1, 0); PG8_STAGE_A(0, 1, a2, v2);
            PG8_WAIT_V(8); PG8_WAIT_L(0); PG8_BAR; PG8_MMA(0, 0, At, B0); PG8_MMA(0, 1, At, B1); PG8_BAR; PG8_SCHED;
            PG8_LDA(At, 1, 1); PG8_STAGE(PG8_SB(1, 0), b3, voffB); PG8_STAGE(PG8_SB(1, 1), b3 + hstep, voffB); PG8_STAGE_A(1, 0, a3, v2);
            PG8_WAIT_V(8); PG8_WAIT_L(0); PG8_BAR; PG8_MMA(1, 0, At, B0); PG8_MMA(1, 1, At, B1); PG8_BAR; PG8_SCHED;
        }
#pragma nounroll
        for (int t = PEEL ? 2 : 0; t < nt; t += 2) {
            const bool last = (t == nt - 2);
            const char* a1 = cA + (size_t)(t + 1) * kstep;
            const char* a2 = last ? nA : cA + (size_t)(t + 2) * kstep; const char* b2 = last ? nB : cB + (size_t)(t + 2) * kstep;
            const char* a3 = a2 + kstep; const char* b3 = b2 + kstep;
            unsigned v2[2][2];
#pragma unroll
            for (int _h = 0; _h < 2; ++_h)
#pragma unroll
                for (int _i = 0; _i < 2; ++_i) v2[_h][_i] = (GATHER && last) ? vn[_h][_i] : vc[_h][_i];
            if (t == 2) E.stage_side(lds + SIDE_OFF, cur, wid, lane);
            PG8_LDB(B0, 0, 0); PG8_LDB(B1, 0, 1); PG8_SCHED; PG8_LDA(At, 0, 0); PG8_STAGE_A(1, 1, a1, vc);
            PG8_WAIT_V(8); PG8_WAIT_L(0); PG8_BAR; PG8_MMA(0, 0, At, B0); PG8_MMA(0, 1, At, B1); PG8_BAR; PG8_SCHED;
            PG8_LDA(At, 0, 1); PG8_STAGE(PG8_SB(0, 0), b2, voffB); PG8_STAGE(PG8_SB(0, 1), b2 + hstep, voffB); PG8_STAGE_A(0, 0, a2, v2);
            PG8_WAIT_V(8); PG8_WAIT_L(0); PG8_BAR; PG8_MMA(1, 0, At, B0); PG8_MMA(1, 1, At, B1); PG8_BAR; PG8_SCHED;
            PG8_LDB(B0, 1, 0); PG8_LDB(B1, 1, 1); PG8_SCHED; PG8_LDA(At, 1, 0); PG8_STAGE_A(0, 1, a2, v2);
            PG8_WAIT_V(8); PG8_WAIT_L(0); PG8_BAR; PG8_MMA(0, 0, At, B0); PG8_MMA(0, 1, At, B1); PG8_BAR; PG8_SCHED;
            PG8_LDA(At, 1, 1); PG8_STAGE(PG8_SB(1, 0), b3, voffB); PG8_STAGE(PG8_SB(1, 1), b3 + hstep, voffB); PG8_STAGE_A(1, 0, a3, v2);
            PG8_WAIT_V(8); PG8_WAIT_L(0); PG8_BAR; PG8_MMA(1, 0, At, B0); PG8_MMA(1, 1, At, B1); PG8_BAR; PG8_SCHED;
        }
        if constexpr (FP8) asm volatile("s_nop 15\n\ts_nop 15" ::: "memory");
        if (wr == 0) PG8_BAR;
        E(acc, cur, wr, wc, fr, fq, lds + SIDE_OFF);
        if (!has_next) break;
        if constexpr (!PEEL) {
#pragma unroll
        for (int a = 0; a < 2; ++a)
#pragma unroll
            for (int b = 0; b < 2; ++b)
#pragma unroll
                for (int m = 0; m < 4; ++m)
#pragma unroll
                    for (int n = 0; n < 2; ++n) acc[a][b][m][n] = (f32x4){0.f, 0.f, 0.f, 0.f};
        }
        cur = nxt; cA = nA; cB = nB; ++ui;
        if constexpr (GATHER) { _Pragma("unroll") for (int _h = 0; _h < 2; ++_h) _Pragma("unroll") for (int _i = 0; _i < 2; ++_i) vc[_h][_i] = vn[_h][_i]; }
        if (wr == 1) PG8_BAR;
    }
    PG8_WAIT_V(0);
    PG8_BAR;
#undef PG8_SA
#undef PG8_SB
#undef PG8_STAGE
#undef PG8_STAGE_A
#undef PG8_LDA
#undef PG8_LDB
#undef PG8_MMA
#undef PG8_MMA0
#undef PG8_WAIT_V
#undef PG8_WAIT_L
#undef PG8_BAR
#undef PG8_SCHED
#undef PG8_GATHER_OFFS
}
}
constexpr int NWAVES = 8;
constexpr int BATCH = 4, SEQ = 8192, D = 1024, T = BATCH * SEQ;
constexpr int AW = 512, NH = 8, HD = 64, LW = 512, INC = 2560, FF = 3584, NE = 8;
constexpr float RMS_EPS = 1e-6f;
constexpr float QSCALE = 0.125f * 1.4426950408889634f;
constexpr int MAXPAN = 264;
constexpr int CHPAN = 146;
constexpr float MOE_WGU_SCALE = 32.f, MOE_WD_SCALE = 64.f, MOE_ACT_SCALE = 16.f;

constexpr size_t MiB = 1u << 20;
constexpr size_t WS_CTL = 0, CTL_ZERO_BYTES = 1 * MiB;
constexpr size_t WS_SUM = 1 * MiB;
constexpr size_t WS_TOKE = 3 * MiB, WS_TOKP = WS_TOKE + 256 * 1024, WS_TOKR = WS_TOKP + 256 * 1024;
constexpr size_t WS_RSTDA = 513 * MiB, WS_RSTDF = WS_RSTDA + 128 * 1024;
constexpr size_t WS_CCV = 3 * MiB;
constexpr size_t WS_ROWTOK = 514 * MiB, WS_ROWGATE = 515 * MiB;
constexpr size_t WS_WFR = 4 * MiB + 640 * 1024;
constexpr size_t WS_ROPE = 5 * MiB;
constexpr size_t WS_LSE = 7 * MiB;
constexpr size_t WS_WIN = 10 * MiB, WS_WOUT = 20 * MiB, WS_WGU = 24 * MiB, WS_WD = 38 * MiB;
constexpr size_t WS_RA = 45 * MiB;
constexpr size_t WS_RB = 109 * MiB;
constexpr size_t WS_RC = 269 * MiB;
constexpr size_t WS_MOEW = 365 * MiB;
constexpr size_t WS_XB = 449 * MiB;
constexpr size_t WS_END = 533 * MiB;
constexpr size_t WS_ACTM = WS_RB, WS_FSLOT = WS_RB + 128 * MiB;
static_assert((size_t)CHPAN * 256 * FF <= 128 * MiB && WS_FSLOT + 128 * MiB <= WS_MOEW && WS_RB + 224 * MiB <= WS_MOEW && WS_RC + 96 * MiB <= WS_MOEW && WS_MOEW + 84 * MiB <= WS_XB && WS_XB + 64 * MiB <= WS_END, "ws map");
constexpr int CW_BAR = 4096;
constexpr int CW_LRU = 20480;
constexpr int CW_CNT = 16384;

constexpr int LDS_BYTES = 159744;
constexpr int LDSCTL_OFF = 158720;

#define GAS __attribute__((address_space(1)))
#define LAS __attribute__((address_space(3)))
typedef unsigned short bf16;
typedef unsigned v4u __attribute__((ext_vector_type(4)));
typedef unsigned v2u __attribute__((ext_vector_type(2)));
typedef float f32x4 __attribute__((ext_vector_type(4)));
typedef float f32x2 __attribute__((ext_vector_type(2)));
typedef float f32x16 __attribute__((ext_vector_type(16)));
typedef short bf16x8 __attribute__((ext_vector_type(8)));
typedef short v4i16_t __attribute__((ext_vector_type(4)));
typedef GAS unsigned gu32;
#define RLX_AGENT __ATOMIC_RELAXED, __HIP_MEMORY_SCOPE_AGENT
#define LDS_WAIT() asm volatile("s_waitcnt lgkmcnt(0)" ::: "memory")
#define VM_WAIT() asm volatile("s_waitcnt vmcnt(0)" ::: "memory")
__device__ __forceinline__ unsigned f2bf(float f) { unsigned u = __builtin_bit_cast(unsigned, f); return (u + 0x7fffu + ((u >> 16) & 1u)) >> 16; }
__device__ __forceinline__ unsigned pk2(float lo, float hi) { typedef float f2_t __attribute__((ext_vector_type(2))); typedef __bf16 b2_t __attribute__((ext_vector_type(2))); const f2_t v = {lo, hi}; return __builtin_bit_cast(unsigned, __builtin_convertvector(v, b2_t)); }
__device__ __forceinline__ float bf_lo(unsigned w) { return __builtin_bit_cast(float, w << 16); }
__device__ __forceinline__ float bf_hi(unsigned w) { return __builtin_bit_cast(float, w & 0xffff0000u); }

#define XB_TMO      128
#define XB_XCNT(j)  (256  + 64 * (j))
#define XB_XSUB(j)  (1280 + 64 * (j))
#define XB_XGEN(j)  (2304 + 64 * (j))
#define XB_TOP      3328
#define XB_TOPGEN   3392
#define XCD_BAR_WORDS 3456
#define XB_SPIN_CAP (1u << 18)

__device__ __forceinline__ unsigned xb_ld(unsigned* p)              { return __hip_atomic_load(p, __ATOMIC_RELAXED, __HIP_MEMORY_SCOPE_AGENT); }
__device__ __forceinline__ unsigned xb_add(unsigned* p, unsigned v) { return __hip_atomic_fetch_add(p, v, __ATOMIC_RELAXED, __HIP_MEMORY_SCOPE_AGENT); }
__device__ __forceinline__ unsigned xb_xcc_id() { return (unsigned)__builtin_amdgcn_s_getreg((3 << 11) | 20) & 0xFu; }
#define XB_SPIN(cond, bar) do { unsigned _sp = 0; while (cond) { __builtin_amdgcn_s_sleep(1); \
    if ((++_sp & 255u) == 0u) { if (xb_ld(&(bar)[XB_TMO])) break; if (_sp > XB_SPIN_CAP) { atomicAdd(&(bar)[XB_TMO], 1u); break; } } } } while (0)

struct XcdBarrier {
    unsigned* bar; unsigned x;
    volatile LAS unsigned* st;
};
__device__ __forceinline__ XcdBarrier xcd_barrier_post(unsigned* bar, volatile LAS unsigned* st) {
    XcdBarrier b; b.bar = bar; b.x = xb_xcc_id(); b.st = st;
    if (threadIdx.x == 0) (void)xb_add(&bar[XB_XCNT(b.x)], 1u);
    return b;
}
__device__ __forceinline__ void xcd_barrier_complete(unsigned* bar, unsigned x, unsigned& nloc, unsigned& nx) {
    const unsigned G = gridDim.x * gridDim.y * gridDim.z;
    unsigned sum, cnt, mine, sp = 0u;
    for (;;) {
        sum = 0u; cnt = 0u; mine = 0u;
#pragma unroll
        for (unsigned j = 0; j < 16; ++j) { const unsigned c = xb_ld(&bar[XB_XCNT(j)]); sum += c; cnt += (c > 0u) ? 1u : 0u; mine = (j == x) ? c : mine; }
        if (sum == G) break;
        __builtin_amdgcn_s_sleep(1);
        if ((++sp & 255u) == 0u) { if (xb_ld(&bar[XB_TMO])) break; if (sp > XB_SPIN_CAP) { atomicAdd(&bar[XB_TMO], 1u); break; } }
    }
    nloc = mine > 0u ? mine : 1u; nx = cnt > 0u ? cnt : 1u;
}
__device__ __forceinline__ void xcd_barrier(const XcdBarrier& b) {
    asm volatile("s_waitcnt vmcnt(0)" ::: "memory");
    __syncthreads();
    if (threadIdx.x == 0) {
        unsigned* bar = b.bar; { const unsigned long long u_ = (unsigned long long)bar; bar = (unsigned*)(((unsigned long long)(unsigned)__builtin_amdgcn_readfirstlane((int)(u_ >> 32)) << 32) | (unsigned)__builtin_amdgcn_readfirstlane((int)u_)); } asm volatile("" : "+s"(bar));
        __builtin_amdgcn_s_waitcnt(0);
        unsigned nloc = b.st[0], nx = b.st[1];
        unsigned bx_ = b.x; asm volatile("" : "+s"(bx_));
        if (nloc == 0u) { xcd_barrier_complete(bar, bx_, nloc, nx); b.st[0] = nloc; b.st[1] = nx; }
        const unsigned old = xb_add(&bar[XB_XSUB(bx_)], 1u);
        const unsigned gen = old / nloc;
        if (old + 1u == (gen + 1u) * nloc) {
            __builtin_amdgcn_fence(__ATOMIC_RELEASE, "agent");
            asm volatile("s_waitcnt vmcnt(0)" ::: "memory");
            const unsigned og = xb_add(&bar[XB_TOP], 1u);
            const unsigned tg = og / nx;
            if (og + 1u == (tg + 1u) * nx) xb_add(&bar[XB_TOPGEN], 1u);
            else XB_SPIN(xb_ld(&bar[XB_TOPGEN]) == tg, bar);
            __builtin_amdgcn_fence(__ATOMIC_ACQUIRE, "agent");
            xb_add(&bar[XB_XGEN(bx_)], 1u);
            asm volatile("s_waitcnt vmcnt(0)" ::: "memory");
        } else {
            XB_SPIN(xb_ld(&bar[XB_XGEN(bx_)]) == gen, bar);
            __builtin_amdgcn_fence(__ATOMIC_ACQUIRE, "agent");
            asm volatile("s_waitcnt vmcnt(0)" ::: "memory");
        }
    }
    __syncthreads();
}

struct Args {
    const float* x; const int* pos; const float* pre_mix_g; const float* w_in; const float* conv_w; const float* conv_b;
    const float* w_rgate; const float* b_rgate; const float* w_igate; const float* b_igate; const float* lam;
    const float* attn_out_g; const float* lru_out_g; const float* w_out; const float* post_mix_g; const float* pre_ffn_g; const float* post_ffn_g;
    const float* dw_gate; const float* dw_up; const float* dw_down; const float* router_w; const float* mw_gate; const float* mw_up; const float* mw_down;
    float* out; unsigned char* ws;
};
struct Frame {
    LAS unsigned char* lds;
    int vcu, G;
};
#define DPP_ADD(v, ctrl) ((v) + __builtin_bit_cast(float, __builtin_amdgcn_update_dpp(0, __builtin_bit_cast(int, (v)), (ctrl), 0xF, 0xF, true)))
__device__ __forceinline__ float wave_sum(float v) {
    v = DPP_ADD(v, 0xB1);
    v = DPP_ADD(v, 0x4E);
    v = DPP_ADD(v, 0x141);
    v = DPP_ADD(v, 0x140);
    const int b = __builtin_bit_cast(int, v);
    const float r0 = __builtin_bit_cast(float, __builtin_amdgcn_readlane(b, 0)), r1 = __builtin_bit_cast(float, __builtin_amdgcn_readlane(b, 16));
    const float r2 = __builtin_bit_cast(float, __builtin_amdgcn_readlane(b, 32)), r3 = __builtin_bit_cast(float, __builtin_amdgcn_readlane(b, 48));
    return (r0 + r1) + (r2 + r3);
}
__device__ __forceinline__ void p0_transpose_item(const float* W, int K, int N, bf16* WT, int k0, int n0, int drow0, LAS float* scr, int lane) {
    float ld_[32];
#pragma unroll
    for (int i = 0; i < 32; ++i) { const int kk = 2 * i + (lane >> 5); ld_[i] = W[(size_t)(k0 + kk) * N + n0 + (lane & 31)]; }
#pragma unroll
    for (int i = 0; i < 32; ++i) { const int kk = 2 * i + (lane >> 5); scr[kk * 33 + (lane & 31)] = ld_[i]; }
    LDS_WAIT(); asm volatile("" ::: "memory");
    const int c = lane & 7;
#pragma unroll
    for (int j = 0; j < 4; ++j) { const int n = (lane >> 3) + 8 * j; const LAS float* s = scr + (8 * c) * 33 + n;
        v4u o; o.x = pk2(s[0 * 33], s[1 * 33]); o.y = pk2(s[2 * 33], s[3 * 33]); o.z = pk2(s[4 * 33], s[5 * 33]); o.w = pk2(s[6 * 33], s[7 * 33]);
        *(GAS v4u*)(WT + (size_t)(drow0 + n) * K + k0 + 8 * c) = o; }
    LDS_WAIT(); asm volatile("" ::: "memory");
}
__device__ __forceinline__ unsigned pk4f8(float a, float b, float c, float d) { int w = 0; w = __builtin_amdgcn_cvt_pk_fp8_f32(a, b, w, false); w = __builtin_amdgcn_cvt_pk_fp8_f32(c, d, w, true); return (unsigned)w; }
__device__ __forceinline__ void p0_transpose_item_f8(const float* W, int K, int N, unsigned char* WT, int k0, int n0, int drow0, float scale, LAS float* scr, int lane) {
    float ld_[64];
#pragma unroll
    for (int i = 0; i < 64; ++i) { const int kk = 2 * i + (lane >> 5); ld_[i] = W[(size_t)(k0 + kk) * N + n0 + (lane & 31)]; }
#pragma unroll
    for (int i = 0; i < 64; ++i) { const int kk = 2 * i + (lane >> 5); scr[kk * 33 + (lane & 31)] = ld_[i]; }
    LDS_WAIT(); asm volatile("" ::: "memory");
    const int c = lane & 7;
#pragma unroll
    for (int j = 0; j < 4; ++j) { const int n = (lane >> 3) + 8 * j; const LAS float* s = scr + (16 * c) * 33 + n;
        v4u o; o.x = pk4f8(s[0 * 33] * scale, s[1 * 33] * scale, s[2 * 33] * scale, s[3 * 33] * scale); o.y = pk4f8(s[4 * 33] * scale, s[5 * 33] * scale, s[6 * 33] * scale, s[7 * 33] * scale);
        o.z = pk4f8(s[8 * 33] * scale, s[9 * 33] * scale, s[10 * 33] * scale, s[11 * 33] * scale); o.w = pk4f8(s[12 * 33] * scale, s[13 * 33] * scale, s[14 * 33] * scale, s[15 * 33] * scale);
        *(GAS v4u*)(WT + (size_t)(drow0 + n) * K + k0 + 16 * c) = o; }
    LDS_WAIT(); asm volatile("" ::: "memory");
}
__device__ __forceinline__ void tr_plain_f8(const float* W, int K, int N, unsigned char* WT, int item, float scale, LAS float* scr, int lane) {
    const int nblk = N / 32, kb = item / nblk, nb = item % nblk; p0_transpose_item_f8(W, K, N, WT, 128 * kb, 32 * nb, 32 * nb, scale, scr, lane);
}
__device__ __forceinline__ void tr_gu_f8(const float* W, unsigned char* WT, int isup, int item, float scale, LAS float* scr, int lane) {
    const int nblk = FF / 32, kb = item / nblk, nb = item % nblk, n0 = 32 * nb; p0_transpose_item_f8(W, D, FF, WT, 128 * kb, n0, 256 * (n0 >> 7) + 128 * isup + (n0 & 127), scale, scr, lane);
}
__device__ __forceinline__ void tr_plain(const float* W, int K, int N, bf16* WT, int item, LAS float* scr, int lane) {
    const int nblk = N / 32, kb = item / nblk, nb = item % nblk; p0_transpose_item(W, K, N, WT, 64 * kb, 32 * nb, 32 * nb, scr, lane);
}
__device__ __forceinline__ void tr_gu(const float* W, bf16* WT, int isup, int item, LAS float* scr, int lane) {
    const int nblk = FF / 32, kb = item / nblk, nb = item % nblk, n0 = 32 * nb; p0_transpose_item(W, D, FF, WT, 64 * kb, n0, 256 * (n0 >> 7) + 128 * isup + (n0 & 127), scr, lane);
}
template <bool F8>
__device__ __forceinline__ void coop_item(const float* W, int K, int N, void* WT, int k0, int n0, int GU, float scale, LAS unsigned char* lds, int wave, int lane, const float* gk = nullptr) {
    LAS float* tl = (LAS float*)lds;
    float ld_[64];
#pragma unroll
    for (int r = 0; r < 16; ++r) { const float gr = gk ? gk[k0 + 16 * wave + r] : 1.f;
#pragma unroll
        for (int j = 0; j < 4; ++j) ld_[4 * r + j] = W[(size_t)(k0 + 16 * wave + r) * N + n0 + lane + 64 * j] * gr; }
#pragma unroll
    for (int r = 0; r < 16; ++r)
#pragma unroll
        for (int j = 0; j < 4; ++j) tl[(16 * wave + r) * 257 + lane + 64 * j] = ld_[4 * r + j];
    __syncthreads();
    if (F8) {
        const int c = lane & 7;
#pragma unroll
        for (int it = 0; it < 4; ++it) { const int nl = 32 * wave + 8 * it + (lane >> 3), n = n0 + nl; const LAS float* s = tl + (16 * c) * 257 + nl;
            const int drow = (GU < 0) ? n : 256 * (n >> 7) + 128 * GU + (n & 127);
            v4u o; o.x = pk4f8(s[0 * 257] * scale, s[1 * 257] * scale, s[2 * 257] * scale, s[3 * 257] * scale); o.y = pk4f8(s[4 * 257] * scale, s[5 * 257] * scale, s[6 * 257] * scale, s[7 * 257] * scale);
            o.z = pk4f8(s[8 * 257] * scale, s[9 * 257] * scale, s[10 * 257] * scale, s[11 * 257] * scale); o.w = pk4f8(s[12 * 257] * scale, s[13 * 257] * scale, s[14 * 257] * scale, s[15 * 257] * scale);
            *(GAS v4u*)((unsigned char*)WT + (size_t)drow * K + k0 + 16 * c) = o; }
    } else {
        const int c = lane & 15;
#pragma unroll
        for (int it = 0; it < 8; ++it) { const int nl = 32 * wave + 4 * it + (lane >> 4), n = n0 + nl; const LAS float* s = tl + (8 * c) * 257 + nl;
            const int drow = (GU < 0) ? n : 256 * (n >> 7) + 128 * GU + (n & 127);
            v4u o; o.x = pk2(s[0 * 257], s[1 * 257]); o.y = pk2(s[2 * 257], s[3 * 257]); o.z = pk2(s[4 * 257], s[5 * 257]); o.w = pk2(s[6 * 257], s[7 * 257]);
            *(GAS v4u*)((bf16*)WT + (size_t)drow * K + k0 + 8 * c) = o; }
    }
    __syncthreads();
}
constexpr int WGAIN_OFF = 135168;
struct WItem { const float* W; unsigned char* WT; int K, N, k0, n0, GU, f8, gko; float scale; };
struct WRegs { float v[64]; };
__device__ __forceinline__ void w_load(const WItem& q, WRegs& r, int wave, int lane) {
    const GAS float* src = (const GAS float*)q.W + (size_t)(q.k0 + 16 * wave) * q.N + q.n0 + lane;
#pragma unroll
    for (int i = 0; i < 16; ++i)
#pragma unroll
        for (int j = 0; j < 4; ++j) r.v[4 * i + j] = src[(size_t)i * q.N + 64 * j];
}
__device__ __forceinline__ void w_finish(const WItem& q, WRegs& r, LAS unsigned char* lds, int wave, int lane) {
    LAS float* tl = (LAS float*)lds;
    if (q.gko >= 0) {
        const LAS float* gl = (const LAS float*)(lds + WGAIN_OFF) + q.gko + q.k0 + 16 * wave;
#pragma unroll
        for (int i = 0; i < 16; ++i) { const float gi = gl[i];
#pragma unroll
            for (int j = 0; j < 4; ++j) tl[(16 * wave + i) * 257 + lane + 64 * j] = r.v[4 * i + j] * gi; }
    } else {
#pragma unroll
        for (int i = 0; i < 16; ++i)
#pragma unroll
            for (int j = 0; j < 4; ++j) tl[(16 * wave + i) * 257 + lane + 64 * j] = r.v[4 * i + j];
    }
    LDS_WAIT(); __builtin_amdgcn_s_barrier();
    const int K = q.K, GU = q.GU;
    if (q.f8) {
        const float scale = q.scale;
#pragma unroll
        for (int it = 0; it < 4; ++it) { const int c = (lane >> 4) + 4 * (it & 1), nl = 32 * wave + 16 * (it >> 1) + (lane & 15), n = q.n0 + nl; const LAS float* s = tl + (16 * c) * 257 + nl;
            const int drow = (GU < 0) ? n : 256 * (n >> 7) + 128 * GU + (n & 127);
            v4u o; o.x = pk4f8(s[0 * 257] * scale, s[1 * 257] * scale, s[2 * 257] * scale, s[3 * 257] * scale); o.y = pk4f8(s[4 * 257] * scale, s[5 * 257] * scale, s[6 * 257] * scale, s[7 * 257] * scale);
            o.z = pk4f8(s[8 * 257] * scale, s[9 * 257] * scale, s[10 * 257] * scale, s[11 * 257] * scale); o.w = pk4f8(s[12 * 257] * scale, s[13 * 257] * scale, s[14 * 257] * scale, s[15 * 257] * scale);
            *(GAS v4u*)(q.WT + (size_t)drow * K + q.k0 + 16 * c) = o; }
    } else {
#pragma unroll
        for (int it = 0; it < 8; ++it) { const int c = (lane >> 3) + 8 * (it & 1), nl = 32 * wave + 8 * (it >> 1) + (lane & 7), n = q.n0 + nl; const LAS float* s = tl + (8 * c) * 257 + nl;
            const int drow = (GU < 0) ? n : 256 * (n >> 7) + 128 * GU + (n & 127);
            v4u o; o.x = pk2(s[0 * 257], s[1 * 257]); o.y = pk2(s[2 * 257], s[3 * 257]); o.z = pk2(s[4 * 257], s[5 * 257]); o.w = pk2(s[6 * 257], s[7 * 257]);
            *(GAS v4u*)((bf16*)q.WT + (size_t)drow * K + q.k0 + 8 * c) = o; }
    }
    LDS_WAIT(); __builtin_amdgcn_s_barrier();
}
__device__ __forceinline__ void rms_store_bf16(const f32x4 (&v)[4], const float* g, bf16* orow, int lane) {
    float s = 0.f;
#pragma unroll
    for (int j = 0; j < 4; ++j) s += (v[j].x * v[j].x + v[j].y * v[j].y) + (v[j].z * v[j].z + v[j].w * v[j].w);
    const float rstd = __builtin_amdgcn_rsqf(wave_sum(s) * (1.f / D) + RMS_EPS);
    GAS unsigned long long* o8 = (GAS unsigned long long*)orow + lane;
#pragma unroll
    for (int j = 0; j < 4; ++j) { const f32x4 gg = *((const GAS f32x4*)g + lane + 64 * j);
        o8[64 * j] = (unsigned long long)pk2(v[j].x * rstd * gg.x, v[j].y * rstd * gg.y) | ((unsigned long long)pk2(v[j].z * rstd * gg.z, v[j].w * rstd * gg.w) << 32); }
}
template <class S, class L, class P>
__device__ __forceinline__ void row_pipe(int r0, int step, int end, L load, P proc) {
    if (r0 >= end) return;
    const int last = r0 + ((end - 1 - r0) / step) * step;
#define RP_CL(x) ((x) < last ? (x) : last)
    S s0, s1, s2, s3;
    load(r0, s0); load(RP_CL(r0 + step), s1); load(RP_CL(r0 + 2 * step), s2);
    for (int r = r0; ; r += 4 * step) {
        load(RP_CL(r + 3 * step), s3);
        proc(r, s0);
        if (r + step > last) break;
        load(RP_CL(r + 4 * step), s0);
        proc(r + step, s1);
        if (r + 2 * step > last) break;
        load(RP_CL(r + 5 * step), s1);
        proc(r + 2 * step, s2);
        if (r + 3 * step > last) break;
        load(RP_CL(r + 6 * step), s2);
        proc(r + 3 * step, s3);
        if (r + 4 * step > last) break;
    }
#undef RP_CL
}
struct Gain4 { f32x4 g[4]; };
__device__ __forceinline__ Gain4 ld_gain(const float* g, int lane) { Gain4 r;
#pragma unroll
    for (int j = 0; j < 4; ++j) r.g[j] = *((const GAS f32x4*)g + lane + 64 * j);
    return r; }
struct RawRow { v2u a[4]; };
__device__ __forceinline__ void ld_raw(const bf16* row, RawRow& r, int lane) {
    const GAS v2u* r8 = (const GAS v2u*)row + lane;
#pragma unroll
    for (int j = 0; j < 4; ++j) r.a[j] = r8[64 * j];
}
__device__ __forceinline__ void unpack_raw(const RawRow& r, f32x4 (&v)[4]) {
#pragma unroll
    for (int j = 0; j < 4; ++j) v[j] = (f32x4){bf_lo(r.a[j].x), bf_hi(r.a[j].x), bf_lo(r.a[j].y), bf_hi(r.a[j].y)};
}
__device__ __forceinline__ void load_bf16_row(const bf16* row, f32x4 (&v)[4], int lane) {
    const GAS v2u* r8 = (const GAS v2u*)row + lane;
#pragma unroll
    for (int j = 0; j < 4; ++j) { const v2u w = r8[64 * j]; v[j] = (f32x4){bf_lo(w.x), bf_hi(w.x), bf_lo(w.y), bf_hi(w.y)}; }
}
namespace att {
constexpr int KSLOT = 16384, VRING = 4 * KSLOT, RING = 8 * KSLOT;
static_assert(RING <= LDSCTL_OFF, "attention LDS");
__device__ __forceinline__ int crow(int r, int hi) { return (r & 3) + 8 * (r >> 2) + 4 * hi; }
typedef float f32x4_t __attribute__((ext_vector_type(4)));
__device__ __forceinline__ float max3f(float a, float b, float c) { float r; asm("v_max3_f32 %0, %1, %2, %3" : "=v"(r) : "v"(a), "v"(b), "v"(c)); return r; }
__device__ __forceinline__ void glds16(const void* gsrc, unsigned lds_dst) { unsigned keep; lds_dst = (unsigned)__builtin_amdgcn_readfirstlane((int)lds_dst);

    asm volatile("s_mov_b32 %0, m0\n\ts_mov_b32 m0, %2\n\ts_nop 0\n\tglobal_load_lds_dwordx4 %1, off\n\ts_mov_b32 m0, %0" : "=&s"(keep) : "v"(gsrc), "s"(lds_dst) : "memory"); }
__device__ __forceinline__ void dma_block(const bf16* K, const bf16* V, size_t rowbase  , int dsh, int h, LAS unsigned char* lds, int blk, int wid, int lane) {
    const unsigned sb = (unsigned)__builtin_amdgcn_readfirstlane((int)(unsigned)(uintptr_t)lds) + (unsigned)(blk & 3) * KSLOT;
#pragma unroll
    for (int i = 0; i < 2; ++i) { const int p = 2 * wid + i; const int key = 8 * p + (lane >> 3), ch = (lane & 7) ^ ((lane >> 3) & 7);
        const size_t eo = (rowbase + ((size_t)key << dsh)) * AW + h * HD + 8 * ch;
        glds16(K + eo, sb + p * 1024); glds16(V + eo, sb + VRING + p * 1024); }
}
__device__ __forceinline__ void item(int idx, const bf16* Q, const bf16* K, const bf16* V, bf16* O, float* LSE, LAS unsigned char* lds) {
    int tid = threadIdx.x; asm volatile("" : "+v"(tid));
    const int lane = tid & 63, wid = __builtin_amdgcn_readfirstlane(tid >> 6), r16 = lane & 15, g4 = lane >> 4;
    int br, b, h, g, n0, nblk;
    if (idx < 256) { br = 0; b = idx >> 6; h = (idx >> 3) & 7; g = 0; n0 = 8 * (idx & 7); nblk = 8; }
    else if (idx < 512) { const int j = idx - 256; br = 1; b = j >> 6; h = (j >> 3) & 7; g = (j & 7) >> 1; n0 = 8 * (j & 1); nblk = 8; }
    else { const int j = idx - 512; br = 2; b = j >> 7; h = (j >> 4) & 7; g = j & 15; n0 = 0; nblk = 4; }
    const int dsh = 2 * br;
    const size_t seq0 = (size_t)b * SEQ + g;
    const int nend = n0 + nblk;
    if (n0 > 0) dma_block(K, V, seq0 + ((size_t)(128 * (n0 - 1)) << dsh), dsh, h, lds, n0 - 1, wid, lane);
    else {
#pragma unroll
        for (int i = 0; i < 2; ++i) { *(LAS v4u*)(lds + 3 * KSLOT + tid * 16 + i * 8192) = (v4u){0u, 0u, 0u, 0u}; *(LAS v4u*)(lds + VRING + 3 * KSLOT + tid * 16 + i * 8192) = (v4u){0u, 0u, 0u, 0u}; }
    }
    dma_block(K, V, seq0 + ((size_t)(128 * n0) << dsh), dsh, h, lds, n0, wid, lane);
    dma_block(K, V, seq0 + ((size_t)(128 * (n0 + 1)) << dsh), dsh, h, lds, n0 + 1, wid, lane);
    const int qi = 16 * wid + r16;
    bf16x8 qf[2];
    { const size_t rowq = seq0 + ((size_t)(128 * n0 + qi) << dsh);
#pragma unroll
      for (int ks = 0; ks < 2; ++ks) qf[ks] = *(const GAS bf16x8*)(Q + rowq * AW + h * HD + 32 * ks + 8 * g4); }
    asm volatile("s_waitcnt vmcnt(0) lgkmcnt(0)\n\ts_barrier" ::: "memory");
    int kl[2], vl[4];
#pragma unroll
    for (int ks = 0; ks < 2; ++ks) kl[ks] = r16 * 128 + 16 * ((4 * ks + g4) ^ (r16 & 7));
#pragma unroll
    for (int dt = 0; dt < 4; ++dt) vl[dt] = VRING + (4 * g4 + (r16 >> 2)) * 128 + (((2 * dt + ((r16 & 3) >> 1)) ^ ((4 * g4 + (r16 >> 2)) & 7)) * 16) + (r16 & 1) * 8;
#define ATT_STEP(n, SPH, QC0, QC1, QX0, QX1) do { \
        const bool more = ((n) + 1 < nend), more2 = ((n) + 2 < nend); \
        { const bf16* qp = Q + (seq0 + ((size_t)(128 * ((n) + (more ? 1 : 0)) + qi) << dsh)) * AW + h * HD + 8 * g4; \
          asm volatile("global_load_dwordx4 %0, %2, off\n\tglobal_load_dwordx4 %1, %2, off offset:64" : "=&v"(QX0), "=&v"(QX1) : "v"(qp) : "memory"); } \
        if (more2) dma_block(K, V, seq0 + ((size_t)(128 * ((n) + 2)) << dsh), dsh, h, lds, (n) + 2, wid, lane); \
          \
        const int wbase = 128 * (SPH) + 16 * wid; \
        f32x4_t sc[9]; bf16x8 kf[9][2]; \
        _Pragma("unroll") \
        for (int j = 0; j < 9; ++j) { \
        _Pragma("unroll") \
            for (int ks = 0; ks < 2; ++ks) kf[j][ks] = ((SPH) < 3) ? *(const LAS bf16x8*)(lds + kbs[ks] + (128 * (SPH) + 16 * j) * 128) : *(const LAS bf16x8*)(lds + ((wbase + 16 * j) & 511) * 128 + kl[ks]); } \
        __builtin_amdgcn_sched_barrier(0); \
        _Pragma("unroll") \
        for (int j = 0; j < 9; ++j) sc[j] = __builtin_amdgcn_mfma_f32_16x16x32_bf16(kf[j][0], QC0, (f32x4_t){0.f, 0.f, 0.f, 0.f}, 0, 0, 0);     \
        _Pragma("unroll") \
        for (int j = 0; j < 9; ++j) sc[j] = __builtin_amdgcn_mfma_f32_16x16x32_bf16(kf[j][1], QC1, sc[j], 0, 0, 0); \
        __builtin_amdgcn_sched_barrier(0); \
        if ((n) == 0) {                                                  \
        _Pragma("unroll") \
            for (int j = 0; j < 8; ++j) if (wid + j < 8) sc[j] = (f32x4_t){-1e30f, -1e30f, -1e30f, -1e30f}; } \
        _Pragma("unroll") \
        for (int r = 0; r < 4; ++r) { if (4 * g4 + r < r16) sc[0][r] = -1e30f; if (4 * g4 + r > r16) sc[8][r] = -1e30f; }     \
        float mx = -1e30f; \
        _Pragma("unroll") \
        for (int j = 0; j < 9; ++j) { mx = max3f(mx, sc[j][0], sc[j][1]); mx = max3f(mx, sc[j][2], sc[j][3]); } \
        mx = max3f(mx, __shfl_xor(mx, 16), mx); mx = max3f(mx, __shfl_xor(mx, 32), mx); \
        float l = 0.f; \
        _Pragma("unroll") \
        for (int j = 0; j < 9; ++j) \
        _Pragma("unroll") \
            for (int r = 0; r < 4; ++r) { const float e = __builtin_amdgcn_exp2f(sc[j][r] - mx); sc[j][r] = e; l += e; } \
        l += __shfl_xor(l, 16); l += __shfl_xor(l, 32); \
        f32x4_t o[4]; \
        v4i16_t vlo[5][4], vh8[5][4]; bf16x8 pf[5]; \
        _Pragma("unroll") \
        for (int kk = 0; kk < 5; ++kk) { \
        _Pragma("unroll") \
            for (int dt = 0; dt < 4; ++dt) { \
                if ((SPH) < 3) { vlo[kk][dt] = __builtin_amdgcn_ds_read_tr16_b64_v4i16((LAS v4i16_t*)(lds + vbs[dt] + (128 * (SPH) + 32 * kk) * 128)); \
                                 vh8[kk][dt] = __builtin_amdgcn_ds_read_tr16_b64_v4i16((LAS v4i16_t*)(lds + vbs[dt] + (128 * (SPH) + 32 * kk + (kk < 4 ? 16 : 0)) * 128)); } \
                else { LAS unsigned char* va = lds + ((wbase + 32 * kk) & 511) * 128; \
                       LAS unsigned char* vb = (kk < 4) ? lds + ((wbase + 32 * kk + 16) & 511) * 128 : va;         \
                       vlo[kk][dt] = __builtin_amdgcn_ds_read_tr16_b64_v4i16((LAS v4i16_t*)(va + vl[dt])); vh8[kk][dt] = __builtin_amdgcn_ds_read_tr16_b64_v4i16((LAS v4i16_t*)(vb + vl[dt])); } } \
            v4u pw; pw.x = pk2(sc[2 * kk][0], sc[2 * kk][1]); pw.y = pk2(sc[2 * kk][2], sc[2 * kk][3]); \
            if (kk < 4) { pw.z = pk2(sc[2 * kk + 1][0], sc[2 * kk + 1][1]); pw.w = pk2(sc[2 * kk + 1][2], sc[2 * kk + 1][3]); } else { pw.z = 0u; pw.w = 0u; } \
            pf[kk] = __builtin_bit_cast(bf16x8, pw); } \
        __builtin_amdgcn_sched_barrier(0); \
        _Pragma("unroll") \
        for (int kk = 0; kk < 5; ++kk) \
        _Pragma("unroll") \
            for (int dt = 0; dt < 4; ++dt) { const bf16x8 vf = (bf16x8){vlo[kk][dt][0], vlo[kk][dt][1], vlo[kk][dt][2], vlo[kk][dt][3], vh8[kk][dt][0], vh8[kk][dt][1], vh8[kk][dt][2], vh8[kk][dt][3]}; \
                o[dt] = (kk == 0) ? __builtin_amdgcn_mfma_f32_16x16x32_bf16(vf, pf[kk], (f32x4_t){0.f, 0.f, 0.f, 0.f}, 0, 0, 0) : __builtin_amdgcn_mfma_f32_16x16x32_bf16(vf, pf[kk], o[dt], 0, 0, 0); } \
        __builtin_amdgcn_sched_barrier(0); \
        if (more2) asm volatile("s_waitcnt vmcnt(4)" ::: "memory");     \
        else asm volatile("s_waitcnt vmcnt(0)" ::: "memory"); \
        const float inv = __builtin_amdgcn_rcpf(l); \
        const size_t rowq = seq0 + ((size_t)(128 * (n) + qi) << dsh); \
        bf16* orow = O + ((size_t)br * T + rowq) * AW + h * HD; \
        _Pragma("unroll") \
        for (int dt = 0; dt < 4; ++dt) { v2u w; w.x = pk2(o[dt][0] * inv, o[dt][1] * inv); w.y = pk2(o[dt][2] * inv, o[dt][3] * inv); *(GAS v2u*)(orow + 16 * dt + 4 * g4) = w; } \
        if (g4 == 0) LSE[((size_t)br * T + rowq) * NH + h] = mx + __builtin_amdgcn_logf(l); \
        asm volatile("s_waitcnt lgkmcnt(0)\n\ts_barrier" ::: "memory"); } while (0)
    int kbs[2], vbs[4];
#pragma unroll
    for (int ks = 0; ks < 2; ++ks) kbs[ks] = kl[ks] + 16 * wid * 128;
#pragma unroll
    for (int dt = 0; dt < 4; ++dt) vbs[dt] = vl[dt] + 16 * wid * 128;
    bf16x8 qb0, qb1;
    for (int n4 = n0; n4 < nend; n4 += 4) { ATT_STEP(n4, 3, qf[0], qf[1], qb0, qb1); ATT_STEP(n4 + 1, 0, qb0, qb1, qf[0], qf[1]); ATT_STEP(n4 + 2, 1, qf[0], qf[1], qb0, qb1); ATT_STEP(n4 + 3, 2, qb0, qb1, qf[0], qf[1]); }
#undef ATT_STEP
}
}

namespace lru {
constexpr int USTR = 144, U_BYTES = 67 * USTR, C_BYTES = 64 * USTR, W_BYTES = U_BYTES + C_BYTES;
constexpr int OFF_SSQ = 8 * W_BYTES, OFF_CAR = OFF_SSQ + 8 * 64 * 4, OFF_RSL = OFF_CAR + 512 * 4, LDS_END = OFF_RSL + 64 * 4;
static_assert(W_BYTES % 16 == 0 && LDS_END <= LDSCTL_OFF, "lru LDS");
__device__ __forceinline__ float sigmoid_f(float x) { return __builtin_amdgcn_rcpf(1.f + __builtin_amdgcn_exp2f(-1.4426950408889634f * x)); }
__device__ __forceinline__ float gelu_tanh(float x) { const float t = __builtin_fmaf(-0.10294323972f, x * x, -2.30220819813f); return x * __builtin_amdgcn_rcpf(1.f + __builtin_amdgcn_exp2f(x * t)); }
__device__ __forceinline__ float bf2f(unsigned short h) { return __builtin_bit_cast(float, (unsigned)h << 16); }
__device__ __forceinline__ f32x2 pair_xy(float v) { const float o = __shfl_xor(v, 32); const bool up = (threadIdx.x & 32) != 0; return (f32x2){up ? o : v, up ? v : o}; }
struct LruConst { bf16x8 fr[16]; float w0, w1, w2, w3, cb, brv[2], biv[2], ccv[2]; };
__device__ __forceinline__ void load_const(int layer, const bf16* WFR, const float* conv_w, const float* conv_b, const float* b_r, const float* b_i, const float* lam, LruConst& k) {
    int tid = threadIdx.x; asm volatile("" : "+v"(tid));
    const int lane = tid & 63, wid = __builtin_amdgcn_readfirstlane(tid >> 6), r32 = lane & 31;
    const GAS bf16x8* wfr = (const GAS bf16x8*)(WFR + ((size_t)(layer * 8 + wid) * 16) * 512) + lane;
#pragma unroll
    for (int i = 0; i < 16; ++i) k.fr[i] = wfr[i * 64];
    const int gch = layer * LW + wid * 64 + lane;
    k.w0 = conv_w[layer * 4 * LW + 0 * LW + wid * 64 + lane]; k.w1 = conv_w[layer * 4 * LW + 1 * LW + wid * 64 + lane]; k.w2 = conv_w[layer * 4 * LW + 2 * LW + wid * 64 + lane]; k.w3 = conv_w[layer * 4 * LW + 3 * LW + wid * 64 + lane];
    k.cb = conv_b[gch];
#pragma unroll
    for (int nb = 0; nb < 2; ++nb) { const int ch = wid * 64 + 32 * nb + r32; k.brv[nb] = -1.4426950408889634f * b_r[layer * LW + ch]; k.biv[nb] = -1.4426950408889634f * b_i[layer * LW + ch];
        k.ccv[nb] = lam[layer * LW + ch]; }
}
struct URegs { v4u uv[9]; };
__device__ __forceinline__ void u_load(int cu, const bf16* U, URegs& q) {
    int tid = threadIdx.x; asm volatile("" : "+v"(tid));
    const int lane = tid & 63, wid = __builtin_amdgcn_readfirstlane(tid >> 6);
    const int b = cu >> 7, t0 = 64 * (cu & 127);
#pragma unroll
    for (int j = 0; j < 9; ++j) { const int i = lane + 64 * j, r = i >> 3, ch = i & 7; int t = t0 - 3 + r; t = t < 0 ? 0 : (t > SEQ - 1 ? SEQ - 1 : t);
        q.uv[j] = *(const GAS v4u*)(U + ((size_t)b * SEQ + t) * LW + wid * 64 + ch * 8); }
    __builtin_amdgcn_sched_barrier(0);
}
__device__ __forceinline__ void local_unit(int cu, int layer, const LruConst& kc, const URegs& uq, const bf16* Gt, f32x2* SUM, unsigned* cnt, const float* gout, bf16* MIX, LAS unsigned char* lds) {
    int tid = threadIdx.x; asm volatile("" : "+v"(tid));
    const int lane = tid & 63, wid = __builtin_amdgcn_readfirstlane(tid >> 6), r32 = lane & 31, hi = lane >> 5;
    const int b = cu >> 7, c = cu & 127, t0 = 64 * c;
    const size_t row0 = (size_t)b * SEQ + t0;
    LAS unsigned char* ul = lds + wid * W_BYTES; LAS unsigned char* cl = ul + U_BYTES;
    {
#pragma unroll
      for (int j = 0; j < 9; ++j) { const int i = lane + 64 * j, r = i >> 3, ch = i & 7; const int t = t0 - 3 + r;
          *(LAS v4u*)(ul + r * USTR + ch * 16) = (t >= 0) ? uq.uv[j] : (v4u){0u, 0u, 0u, 0u}; } }
    {
        const float w0 = kc.w0, w1 = kc.w1, w2 = kc.w2, w3 = kc.w3, cb = kc.cb;
        float u0 = bf2f(*(const LAS unsigned short*)(ul + 0 * USTR + 2 * lane)), u1 = bf2f(*(const LAS unsigned short*)(ul + 1 * USTR + 2 * lane)), u2 = bf2f(*(const LAS unsigned short*)(ul + 2 * USTR + 2 * lane));
#pragma unroll 16
        for (int t = 0; t < 64; ++t) { const float u3 = bf2f(*(const LAS unsigned short*)(ul + (t + 3) * USTR + 2 * lane));
            const float y = cb + w0 * u0 + w1 * u1 + w2 * u2 + w3 * u3;
            *(LAS unsigned short*)(cl + t * USTR + 2 * lane) = (unsigned short)pk2(y, 0.f);
            u0 = u1; u1 = u2; u2 = u3; }
    }
    float brv[2], biv[2], ccv[2], hrun[2], ptot[2];
#pragma unroll
    for (int nb = 0; nb < 2; ++nb) { brv[nb] = kc.brv[nb]; biv[nb] = kc.biv[nb]; ccv[nb] = kc.ccv[nb]; hrun[nb] = 0.f; ptot[nb] = 1.f; }
    asm volatile("s_waitcnt lgkmcnt(0)" ::: "memory");
#pragma unroll
    for (int tt = 0; tt < 2; ++tt) {
        bf16x8 ucf[4];
#pragma unroll
        for (int s = 0; s < 4; ++s) ucf[s] = *(const LAS bf16x8*)(cl + (32 * tt + r32) * USTR + (16 * s + 8 * hi) * 2);
#pragma unroll
        for (int nb = 0; nb < 2; ++nb) {
            f32x16 aR, aI;
#pragma unroll
            for (int r = 0; r < 16; ++r) { aR[r] = 0.f; aI[r] = 0.f; }
#pragma unroll
            for (int s = 0; s < 4; ++s) { const bf16x8 fr_ = kc.fr[(0 * 2 + nb) * 4 + s], fi_ = kc.fr[(1 * 2 + nb) * 4 + s];
                aR = __builtin_amdgcn_mfma_f32_32x32x16_bf16(ucf[s], fr_, aR, 0, 0, 0); aI = __builtin_amdgcn_mfma_f32_32x32x16_bf16(ucf[s], fi_, aI, 0, 0, 0); }
#pragma unroll
            for (int q = 0; q < 4; ++q) {
                float a4[4], b4[4];
#pragma unroll
                for (int k = 0; k < 4; ++k) { const int r = 4 * q + k, tl = 32 * tt + 8 * q + 4 * hi + k;
                    const float ucv = bf2f(*(const LAS unsigned short*)(cl + tl * USTR + 2 * (32 * nb + r32)));
                    const float rg = __builtin_amdgcn_rcpf(1.f + __builtin_amdgcn_exp2f(aR[r] + brv[nb])), ig = __builtin_amdgcn_rcpf(1.f + __builtin_amdgcn_exp2f(aI[r] + biv[nb]));
                    const float A = __builtin_amdgcn_exp2f(ccv[nb] * rg);
                    a4[k] = A; b4[k] = __builtin_amdgcn_sqrtf(fmaxf(1.f - A * A, 0.f)) * ig * ucv; }
                const float Ag = (a4[0] * a4[1]) * (a4[2] * a4[3]);
                const float Bg = ((b4[0] * a4[1] + b4[1]) * a4[2] + b4[2]) * a4[3] + b4[3];
                const f32x2 Ax = pair_xy(Ag), Bx = pair_xy(Bg);
                const float hA = Ax.x * hrun[nb] + Bx.x, hB = Ax.y * hA + Bx.y;
                float h = hi ? hA : hrun[nb];
                float p = hi ? ptot[nb] * Ax.x : ptot[nb];
                hrun[nb] = hB; ptot[nb] *= Ax.x * Ax.y;
#pragma unroll
                for (int k = 0; k < 4; ++k) { const int tl = 32 * tt + 8 * q + 4 * hi + k;
                    h = a4[k] * h + b4[k]; p = a4[k] * p;
                    *(LAS unsigned short*)(cl + tl * USTR + 2 * (32 * nb + r32)) = (unsigned short)pk2(h, 0.f);
                    *(LAS unsigned short*)(ul + tl * USTR + 2 * (32 * nb + r32)) = (unsigned short)pk2(p, 0.f); }
                __builtin_amdgcn_sched_barrier(0);
            }
        }
    }
    if (hi == 0) {
#pragma unroll
        for (int nb = 0; nb < 2; ++nb) { const f32x2 sv = (f32x2){ptot[nb], hrun[nb]};
            __hip_atomic_store((unsigned long long*)(SUM + ((size_t)b * 128 + c) * 512 + wid * 64 + 32 * nb + r32), __builtin_bit_cast(unsigned long long, sv), __ATOMIC_RELAXED, __HIP_MEMORY_SCOPE_AGENT); }
    }
    asm volatile("s_waitcnt vmcnt(0) lgkmcnt(0)" ::: "memory");
    const int ch8 = lane & 7;
    v4u gg[8];
#pragma unroll
    for (int i = 0; i < 8; ++i) gg[i] = *(const GAS v4u*)(Gt + (row0 + 8 * i + (lane >> 3)) * LW + wid * 64 + 8 * ch8);
    const f32x4 g0 = *(const GAS f32x4*)(gout + layer * LW + wid * 64 + 8 * ch8), g1 = *(const GAS f32x4*)(gout + layer * LW + wid * 64 + 8 * ch8 + 4);
    __syncthreads();
    if (tid == 0) {
        (void)__hip_atomic_fetch_add(cnt, 1u, __ATOMIC_RELAXED, __HIP_MEMORY_SCOPE_AGENT);
        unsigned sp = 0;
        while (__hip_atomic_load(cnt, __ATOMIC_RELAXED, __HIP_MEMORY_SCOPE_AGENT) < 128u) { __builtin_amdgcn_s_sleep(2); if (++sp > (1u << 20)) break; }
        __builtin_amdgcn_fence(__ATOMIC_ACQUIRE, "agent");
        asm volatile("s_waitcnt vmcnt(0)" ::: "memory");
    }
    __syncthreads();
    {
        float hc = 0.f; const f32x2* spq = SUM + ((size_t)b * 128) * 512 + tid;
        for (int cc = 0; cc < c; cc += 32) { f32x2 ab[32];
#pragma unroll
            for (int k = 0; k < 32; ++k) { const int i = cc + k; ab[k] = spq[(size_t)(i < c ? i : 0) * 512]; }
#pragma unroll
            for (int k = 0; k < 32; ++k) { const int i = cc + k; const f32x2 u_ = (i < c) ? ab[k] : (f32x2){1.f, 0.f}; hc = u_.x * hc + u_.y; } }
        ((LAS float*)(lds + OFF_CAR))[tid] = hc;
    }
    __syncthreads();
    {
        LAS float* ssq = (LAS float*)(lds + OFF_SSQ); LAS float* rsl = (LAS float*)(lds + OFF_RSL); const LAS float* car = (const LAS float*)(lds + OFF_CAR);
        const f32x4 c0 = *(const LAS f32x4*)(car + wid * 64 + 8 * ch8), c1 = *(const LAS f32x4*)(car + wid * 64 + 8 * ch8 + 4);
        float rec[8][8];
#pragma unroll
        for (int i = 0; i < 8; ++i) { const int tk = 8 * i + (lane >> 3); float s = 0.f;
            const v4u hl = *(const LAS v4u*)(cl + tk * USTR + ch8 * 16), pc = *(const LAS v4u*)(ul + tk * USTR + ch8 * 16);
#pragma unroll
            for (int e = 0; e < 4; ++e) { const float ca = (e == 0) ? c0.x : (e == 1) ? c0.z : (e == 2) ? c1.x : c1.z, cb_ = (e == 0) ? c0.y : (e == 1) ? c0.w : (e == 2) ? c1.y : c1.w;
                const float h0 = bf_lo(hl[e]) + bf_lo(pc[e]) * ca, h1 = bf_hi(hl[e]) + bf_hi(pc[e]) * cb_;
                const float r0 = gelu_tanh(bf_lo(gg[i][e])) * h0, r1 = gelu_tanh(bf_hi(gg[i][e])) * h1;
                rec[i][2 * e] = r0; rec[i][2 * e + 1] = r1; s += r0 * r0 + r1 * r1; }
            s = DPP_ADD(s, 0xB1); s = DPP_ADD(s, 0x4E); s = DPP_ADD(s, 0x141);
            if (ch8 == 0) ssq[wid * 64 + tk] = s; }
        __syncthreads();
        if (tid < 64) { float s = 0.f;
#pragma unroll
            for (int w = 0; w < 8; ++w) s += ssq[w * 64 + tid];
            rsl[tid] = __builtin_amdgcn_rsqf(s * (1.f / LW) + RMS_EPS); }
        __syncthreads();
#pragma unroll
        for (int i = 0; i < 8; ++i) { const int tk = 8 * i + (lane >> 3); const float rs = rsl[tk];
            v4u o; o.x = pk2(rec[i][0] * rs * g0.x, rec[i][1] * rs * g0.y); o.y = pk2(rec[i][2] * rs * g0.z, rec[i][3] * rs * g0.w);
            o.z = pk2(rec[i][4] * rs * g1.x, rec[i][5] * rs * g1.y); o.w = pk2(rec[i][6] * rs * g1.z, rec[i][7] * rs * g1.w);
            *(GAS v4u*)(MIX + (row0 + tk) * D + AW + wid * 64 + 8 * ch8) = o; }
    }
    __syncthreads();
}
constexpr int OFF_CARA = 8 * 64 * 4, OFF_CARB = OFF_CARA + 512 * 4 + 64 * 4;
__device__ __forceinline__ void carry2(int cuA, int cuB, const f32x2* SUM, LAS unsigned char* lds) {
    int tid = threadIdx.x; asm volatile("" : "+v"(tid));
    const int cA = cuA & 127, cB = (cuB >= 0) ? (cuB & 127) : 0, cmax = cA > cB ? cA : cB;
    const f32x2* spA = SUM + ((size_t)(cuA >> 7) * 128) * 512 + tid; const f32x2* spB = SUM + ((size_t)((cuB >= 0 ? cuB : cuA) >> 7) * 128) * 512 + tid;
    float hA = 0.f, hB = 0.f;
    for (int cc = 0; cc < cmax; cc += 32) { f32x2 a[32], b[32];
#pragma unroll
        for (int k = 0; k < 32; ++k) { const int i = cc + k; a[k] = spA[(size_t)(i < cA ? i : 0) * 512]; b[k] = spB[(size_t)(i < cB ? i : 0) * 512]; }
#pragma unroll
        for (int k = 0; k < 32; ++k) { const int i = cc + k; const f32x2 ua = (i < cA) ? a[k] : (f32x2){1.f, 0.f}, ub = (i < cB) ? b[k] : (f32x2){1.f, 0.f};
            hA = ua.x * hA + ua.y; hB = ub.x * hB + ub.y; } }
    ((LAS float*)(lds + OFF_CARA))[tid] = hA; ((LAS float*)(lds + OFF_CARB))[tid] = hB;
}
struct FinRegs { v4u hl[8], pc[8], gg[8]; f32x4 g0, g1; };
__device__ __forceinline__ void finish_load(int cu, int layer, const bf16* HL, const bf16* PC, const bf16* Gt, const float* gout, FinRegs& q) {
    int tid = threadIdx.x; asm volatile("" : "+v"(tid));
    const int lane = tid & 63, wid = __builtin_amdgcn_readfirstlane(tid >> 6), ch8 = lane & 7;
    const size_t row0 = (size_t)(cu >> 7) * SEQ + 64 * (cu & 127);
#pragma unroll
    for (int i = 0; i < 8; ++i) { const size_t e = (row0 + 8 * i + (lane >> 3)) * LW + wid * 64 + 8 * ch8;
        q.hl[i] = *(const GAS v4u*)(HL + e); q.pc[i] = *(const GAS v4u*)(PC + e); q.gg[i] = *(const GAS v4u*)(Gt + e); }
    q.g0 = *(const GAS f32x4*)(gout + layer * LW + wid * 64 + 8 * ch8); q.g1 = *(const GAS f32x4*)(gout + layer * LW + wid * 64 + 8 * ch8 + 4);
    __builtin_amdgcn_sched_barrier(0);
}
__device__ __forceinline__ void finish_unit(int cu, int layer, const FinRegs& q, const LAS float* car, const float* gout, bf16* MIX, LAS unsigned char* lds) {
    int tid = threadIdx.x; asm volatile("" : "+v"(tid));
    const int lane = tid & 63, wid = __builtin_amdgcn_readfirstlane(tid >> 6), ch8 = lane & 7;
    const int b = cu >> 7, c = cu & 127;
    const size_t row0 = (size_t)b * SEQ + 64 * c;
    LAS float* ssq = (LAS float*)lds; LAS float* rsl = ssq + 8 * 64 + 512;
    const v4u (&hl)[8] = q.hl; const v4u (&pc)[8] = q.pc; const v4u (&gg)[8] = q.gg;
    const f32x4 c0 = *(const LAS f32x4*)(car + wid * 64 + 8 * ch8), c1 = *(const LAS f32x4*)(car + wid * 64 + 8 * ch8 + 4);
    float rec[8][8];
#pragma unroll
    for (int i = 0; i < 8; ++i) { float s = 0.f;
#pragma unroll
        for (int e = 0; e < 4; ++e) { const float ca = (e == 0) ? c0.x : (e == 1) ? c0.z : (e == 2) ? c1.x : c1.z, cb_ = (e == 0) ? c0.y : (e == 1) ? c0.w : (e == 2) ? c1.y : c1.w;
            const float h0 = bf_lo(hl[i][e]) + bf_lo(pc[i][e]) * ca, h1 = bf_hi(hl[i][e]) + bf_hi(pc[i][e]) * cb_;
            const float r0 = gelu_tanh(bf_lo(gg[i][e])) * h0, r1 = gelu_tanh(bf_hi(gg[i][e])) * h1;
            rec[i][2 * e] = r0; rec[i][2 * e + 1] = r1; s += r0 * r0 + r1 * r1; }
        s = DPP_ADD(s, 0xB1); s = DPP_ADD(s, 0x4E); s = DPP_ADD(s, 0x141);
        if (ch8 == 0) ssq[wid * 64 + 8 * i + (lane >> 3)] = s; }
    __syncthreads();
    if (tid < 64) { float s = 0.f;
#pragma unroll
        for (int w = 0; w < 8; ++w) s += ssq[w * 64 + tid];
        rsl[tid] = __builtin_amdgcn_rsqf(s * (1.f / LW) + RMS_EPS); }
    __syncthreads();
    const f32x4 g0 = q.g0, g1 = q.g1;
#pragma unroll
    for (int i = 0; i < 8; ++i) { const int tk = 8 * i + (lane >> 3); const float rs = rsl[tk];
        v4u o; o.x = pk2(rec[i][0] * rs * g0.x, rec[i][1] * rs * g0.y); o.y = pk2(rec[i][2] * rs * g0.z, rec[i][3] * rs * g0.w);
        o.z = pk2(rec[i][4] * rs * g1.x, rec[i][5] * rs * g1.y); o.w = pk2(rec[i][6] * rs * g1.z, rec[i][7] * rs * g1.w);
        *(GAS v4u*)(MIX + (row0 + tk) * D + AW + wid * 64 + 8 * ch8) = o; }
    __syncthreads();
}
}

__device__ __forceinline__ void attn_combine(int cu, int layer, const bf16* OBR, const float* LSE, const float* gain, bf16* MIX) {
    int tid = threadIdx.x; asm volatile("" : "+v"(tid));
    const int lane = tid & 63, wid = __builtin_amdgcn_readfirstlane(tid >> 6), head = lane >> 3;
    const f32x4 g0 = *(const GAS f32x4*)(gain + layer * AW + 8 * lane), g1 = *(const GAS f32x4*)(gain + layer * AW + 8 * lane + 4);
    const size_t rowb = (size_t)(cu >> 7) * SEQ + 64 * (cu & 127) + wid;
#pragma unroll
    for (int bt = 0; bt < 2; ++bt) {
        float l0[4], l1[4], l2[4]; v4u a[4], b[4], d[4];
#pragma unroll
        for (int k = 0; k < 4; ++k) { const size_t row = rowb + 8 * (4 * bt + k);
            l0[k] = LSE[((size_t)0 * T + row) * NH + head]; l1[k] = LSE[((size_t)1 * T + row) * NH + head]; l2[k] = LSE[((size_t)2 * T + row) * NH + head];
            a[k] = *(const GAS v4u*)(OBR + ((size_t)0 * T + row) * AW + 8 * lane); b[k] = *(const GAS v4u*)(OBR + ((size_t)1 * T + row) * AW + 8 * lane); d[k] = *(const GAS v4u*)(OBR + ((size_t)2 * T + row) * AW + 8 * lane); }
        __builtin_amdgcn_sched_barrier(0);
#pragma unroll
        for (int k = 0; k < 4; ++k) { const size_t row = rowb + 8 * (4 * bt + k);
            const float mx = fmaxf(l0[k], fmaxf(l1[k], l2[k]));
            float w0 = __builtin_amdgcn_exp2f(l0[k] - mx), w1 = __builtin_amdgcn_exp2f(l1[k] - mx), w2 = __builtin_amdgcn_exp2f(l2[k] - mx);
            const float iw = __builtin_amdgcn_rcpf(w0 + w1 + w2); w0 *= iw; w1 *= iw; w2 *= iw;
            float acc[8]; float ss = 0.f;
#pragma unroll
            for (int e = 0; e < 4; ++e) { const float lo = w0 * bf_lo(a[k][e]) + w1 * bf_lo(b[k][e]) + w2 * bf_lo(d[k][e]), hh = w0 * bf_hi(a[k][e]) + w1 * bf_hi(b[k][e]) + w2 * bf_hi(d[k][e]);
                acc[2 * e] = lo; acc[2 * e + 1] = hh; ss += lo * lo + hh * hh; }
            const float rstd = __builtin_amdgcn_rsqf(wave_sum(ss) * (1.f / AW) + RMS_EPS);
            v4u w; w.x = pk2(acc[0] * rstd * g0.x, acc[1] * rstd * g0.y); w.y = pk2(acc[2] * rstd * g0.z, acc[3] * rstd * g0.w);
            w.z = pk2(acc[4] * rstd * g1.x, acc[5] * rstd * g1.y); w.w = pk2(acc[6] * rstd * g1.z, acc[7] * rstd * g1.w);
            *(GAS v4u*)(MIX + row * D + 8 * lane) = w; }
    }
}

__device__ __forceinline__ void mix_unit(int cu, int layer, const bf16* OBR, const float* LSE, const float* again, const bf16* HL, const bf16* PC, const bf16* Gt, const LAS float* car, const float* lgain, bf16* MIX) {
    int tid = threadIdx.x; asm volatile("" : "+v"(tid));
    const int lane = tid & 63, wid = __builtin_amdgcn_readfirstlane(tid >> 6), head = lane >> 3;
    const f32x4 g0 = *(const GAS f32x4*)(again + layer * AW + 8 * lane), g1 = *(const GAS f32x4*)(again + layer * AW + 8 * lane + 4);
    const f32x4 h0 = *(const GAS f32x4*)(lgain + layer * LW + 8 * lane), h1 = *(const GAS f32x4*)(lgain + layer * LW + 8 * lane + 4);
    const f32x4 c0 = *(const LAS f32x4*)(car + 8 * lane), c1 = *(const LAS f32x4*)(car + 8 * lane + 4);
    const size_t rowb = (size_t)(cu >> 7) * SEQ + 64 * (cu & 127) + 8 * wid;
#pragma unroll
    for (int bt = 0; bt < 2; ++bt) {
        float l0[4], l1[4], l2[4]; v4u a[4], b[4], d[4], hl[4], pc[4], gg[4];
#pragma unroll
        for (int k = 0; k < 4; ++k) { const size_t row = rowb + 4 * bt + k;
            l0[k] = LSE[((size_t)0 * T + row) * NH + head]; l1[k] = LSE[((size_t)1 * T + row) * NH + head]; l2[k] = LSE[((size_t)2 * T + row) * NH + head];
            a[k] = *(const GAS v4u*)(OBR + ((size_t)0 * T + row) * AW + 8 * lane); b[k] = *(const GAS v4u*)(OBR + ((size_t)1 * T + row) * AW + 8 * lane); d[k] = *(const GAS v4u*)(OBR + ((size_t)2 * T + row) * AW + 8 * lane);
            hl[k] = *(const GAS v4u*)(HL + row * LW + 8 * lane); pc[k] = *(const GAS v4u*)(PC + row * LW + 8 * lane); gg[k] = *(const GAS v4u*)(Gt + row * LW + 8 * lane); }
        __builtin_amdgcn_sched_barrier(0);
#pragma unroll
        for (int k = 0; k < 4; ++k) { const size_t row = rowb + 4 * bt + k;
            const float mx = fmaxf(l0[k], fmaxf(l1[k], l2[k]));
            float w0 = __builtin_amdgcn_exp2f(l0[k] - mx), w1 = __builtin_amdgcn_exp2f(l1[k] - mx), w2 = __builtin_amdgcn_exp2f(l2[k] - mx);
            const float iw = __builtin_amdgcn_rcpf(w0 + w1 + w2); w0 *= iw; w1 *= iw; w2 *= iw;
            float acc[8], rec[8]; float ss = 0.f, s2 = 0.f;
#pragma unroll
            for (int e = 0; e < 4; ++e) { const float lo = w0 * bf_lo(a[k][e]) + w1 * bf_lo(b[k][e]) + w2 * bf_lo(d[k][e]), hh = w0 * bf_hi(a[k][e]) + w1 * bf_hi(b[k][e]) + w2 * bf_hi(d[k][e]);
                acc[2 * e] = lo; acc[2 * e + 1] = hh; ss += lo * lo + hh * hh;
                const float ca = (e == 0) ? c0.x : (e == 1) ? c0.z : (e == 2) ? c1.x : c1.z, cb_ = (e == 0) ? c0.y : (e == 1) ? c0.w : (e == 2) ? c1.y : c1.w;
                const float x0 = bf_lo(hl[k][e]) + bf_lo(pc[k][e]) * ca, x1 = bf_hi(hl[k][e]) + bf_hi(pc[k][e]) * cb_;
                const float r0 = lru::gelu_tanh(bf_lo(gg[k][e])) * x0, r1 = lru::gelu_tanh(bf_hi(gg[k][e])) * x1;
                rec[2 * e] = r0; rec[2 * e + 1] = r1; s2 += r0 * r0 + r1 * r1; }
            const float rstd = __builtin_amdgcn_rsqf(wave_sum(ss) * (1.f / AW) + RMS_EPS), rstd2 = __builtin_amdgcn_rsqf(wave_sum(s2) * (1.f / LW) + RMS_EPS);
            v4u w; w.x = pk2(acc[0] * rstd * g0.x, acc[1] * rstd * g0.y); w.y = pk2(acc[2] * rstd * g0.z, acc[3] * rstd * g0.w);
            w.z = pk2(acc[4] * rstd * g1.x, acc[5] * rstd * g1.y); w.w = pk2(acc[6] * rstd * g1.z, acc[7] * rstd * g1.w);
            *(GAS v4u*)(MIX + row * D + 8 * lane) = w;
            v4u o; o.x = pk2(rec[0] * rstd2 * h0.x, rec[1] * rstd2 * h0.y); o.y = pk2(rec[2] * rstd2 * h0.z, rec[3] * rstd2 * h0.w);
            o.z = pk2(rec[4] * rstd2 * h1.x, rec[5] * rstd2 * h1.y); o.w = pk2(rec[6] * rstd2 * h1.z, rec[7] * rstd2 * h1.w);
            *(GAS v4u*)(MIX + row * D + AW + 8 * lane) = o; }
    }
}
__device__ __forceinline__ void post_mix_row(const RawRow& mraw, const RawRow& xraw, bf16* xout, const Gain4& gpost, const Gain4& gpre2, bf16* hrow, unsigned char* h8row, float* rstd_out, f32x4 (&hn)[4], int lane) {
    f32x4 m[4], xv[4]; unpack_raw(mraw, m); unpack_raw(xraw, xv);
    float s = 0.f;
#pragma unroll
    for (int j = 0; j < 4; ++j) s += (m[j].x * m[j].x + m[j].y * m[j].y) + (m[j].z * m[j].z + m[j].w * m[j].w);
    const float rstd = __builtin_amdgcn_rsqf(wave_sum(s) * (1.f / D) + RMS_EPS);
    float s2 = 0.f;
    GAS unsigned long long* x8 = (GAS unsigned long long*)xout + lane;
#pragma unroll
    for (int j = 0; j < 4; ++j) { const f32x4 gg = gpost.g[j];
        f32x4 y; y.x = xv[j].x + m[j].x * rstd * gg.x; y.y = xv[j].y + m[j].y * rstd * gg.y; y.z = xv[j].z + m[j].z * rstd * gg.z; y.w = xv[j].w + m[j].w * rstd * gg.w;
        x8[64 * j] = (unsigned long long)pk2(y.x, y.y) | ((unsigned long long)pk2(y.z, y.w) << 32); hn[j] = y; s2 += (y.x * y.x + y.y * y.y) + (y.z * y.z + y.w * y.w); }
    const float rstd2 = __builtin_amdgcn_rsqf(wave_sum(s2) * (1.f / D) + RMS_EPS);
    if (rstd_out && lane == 0) *rstd_out = rstd2;
    GAS unsigned long long* o8 = (GAS unsigned long long*)hrow + lane;
#pragma unroll
    for (int j = 0; j < 4; ++j) { const f32x4 gg = gpre2.g[j];
        hn[j].x *= rstd2 * gg.x; hn[j].y *= rstd2 * gg.y; hn[j].z *= rstd2 * gg.z; hn[j].w *= rstd2 * gg.w;
        if (hrow) o8[64 * j] = (unsigned long long)pk2(hn[j].x, hn[j].y) | ((unsigned long long)pk2(hn[j].z, hn[j].w) << 32);
        if (h8row) *((GAS unsigned*)h8row + lane + 64 * j) = pg8::pk4_fp8(hn[j].x, hn[j].y, hn[j].z, hn[j].w); }
}
__device__ __forceinline__ void post_ffn_row(f32x4 (&f)[4], const RawRow& xraw, bf16* xout, float* orow32, const Gain4& gpost, const float* gnext, bf16* hrow, float* rstd_out, int lane) {
    f32x4 xv[4]; unpack_raw(xraw, xv);
    float s = 0.f;
#pragma unroll
    for (int j = 0; j < 4; ++j) s += (f[j].x * f[j].x + f[j].y * f[j].y) + (f[j].z * f[j].z + f[j].w * f[j].w);
    const float rstd = __builtin_amdgcn_rsqf(wave_sum(s) * (1.f / D) + RMS_EPS);
    f32x4 y[4];
    GAS unsigned long long* x8 = (GAS unsigned long long*)xout + lane;
#pragma unroll
    for (int j = 0; j < 4; ++j) { const f32x4 gg = gpost.g[j];
        y[j].x = xv[j].x + f[j].x * rstd * gg.x; y[j].y = xv[j].y + f[j].y * rstd * gg.y; y[j].z = xv[j].z + f[j].z * rstd * gg.z; y[j].w = xv[j].w + f[j].w * rstd * gg.w;
        if (orow32) *((GAS f32x4*)orow32 + lane + 64 * j) = y[j];
        if (xout) x8[64 * j] = (unsigned long long)pk2(y[j].x, y[j].y) | ((unsigned long long)pk2(y[j].z, y[j].w) << 32); }
    if (gnext) rms_store_bf16(y, gnext, hrow, lane);
    if (rstd_out) { float s2 = 0.f;
#pragma unroll
        for (int j = 0; j < 4; ++j) s2 += (y[j].x * y[j].x + y[j].y * y[j].y) + (y[j].z * y[j].z + y[j].w * y[j].w);
        const float r2 = __builtin_amdgcn_rsqf(wave_sum(s2) * (1.f / D) + RMS_EPS); if (lane == 0) *rstd_out = r2; }
}

constexpr int I_IN = 8 * 10, I_OUT = 8 * 4, I_G = 8 * 14, I_D = 28 * 4, I_E = 2 * I_G + I_D, NIT_DENSE = 2 * I_IN + 2 * I_OUT + 2 * I_G + I_D;
constexpr int EDEF = 5, NIT_P0 = NIT_DENSE + EDEF * I_E, NIT_DEF = (NE - EDEF) * I_E;
__device__ __forceinline__ WItem w_item_of(const Args& a, unsigned char* ws, int it) {
            WItem q; q.gko = -1; q.GU = -1; q.f8 = 0; q.scale = 1.f; int r = it;
            if (r < 2 * I_IN) { const int l = r / I_IN, s = r % I_IN; q.W = a.w_in + (size_t)l * D * INC; q.K = D; q.N = INC; q.WT = (unsigned char*)((bf16*)(ws + WS_WIN) + (size_t)l * INC * D); q.k0 = 128 * (s / 10); q.n0 = 256 * (s % 10); q.gko = l * D; return q; } r -= 2 * I_IN;
            if (r < 2 * I_OUT) { const int l = r / I_OUT, s = r % I_OUT; q.W = a.w_out + (size_t)l * D * D; q.K = D; q.N = D; q.WT = (unsigned char*)((bf16*)(ws + WS_WOUT) + (size_t)l * D * D); q.k0 = 128 * (s / 4); q.n0 = 256 * (s % 4); return q; } r -= 2 * I_OUT;
            if (r < 2 * I_G) { const int up = r / I_G, s = r % I_G; q.W = up ? a.dw_up : a.dw_gate; q.K = D; q.N = FF; q.WT = (unsigned char*)(ws + WS_WGU); q.k0 = 128 * (s / 14); q.n0 = 256 * (s % 14); q.GU = up; q.f8 = 1; q.scale = MOE_WGU_SCALE; return q; } r -= 2 * I_G;
            if (r < I_D) { q.W = a.dw_down; q.K = FF; q.N = D; q.WT = (unsigned char*)(ws + WS_WD); q.k0 = 128 * (r / 4); q.n0 = 256 * (r % 4); return q; } r -= I_D;
            const int e = r / (2 * I_G + I_D); r -= e * (2 * I_G + I_D);
            unsigned char* we = (unsigned char*)(ws + WS_MOEW) + (size_t)e * (3 * (size_t)D * FF);
            q.f8 = 1;
            if (r < 2 * I_G) { const int up = r / I_G, s = r % I_G; q.W = (up ? a.mw_up : a.mw_gate) + (size_t)e * D * FF; q.K = D; q.N = FF; q.WT = we; q.k0 = 128 * (s / 14); q.n0 = 256 * (s % 14); q.GU = up; q.scale = MOE_WGU_SCALE; return q; } r -= 2 * I_G;
            q.W = a.mw_down + (size_t)e * FF * D; q.K = FF; q.N = D; q.WT = we + (size_t)2 * D * FF; q.k0 = 128 * (r / 4); q.n0 = 256 * (r % 4); q.scale = MOE_WD_SCALE; return q; }
__device__ __forceinline__ void convert_items(const Args& a, unsigned char* ws, LAS unsigned char* lds, int first, int cnt, int slot, int nslots, int wave, int lane) {
        if (slot < 0 || slot >= cnt) return;
        const int n = (cnt - slot + nslots - 1) / nslots;
        WRegs ra, rb; WItem ia = w_item_of(a, ws, first + slot), ib = ia;
        w_load(ia, ra, wave, lane);
        int k = 0;
        for (;;) {
            if (k + 1 >= n) { w_finish(ia, ra, lds, wave, lane); break; }
            ib = w_item_of(a, ws, first + slot + (k + 1) * nslots); w_load(ib, rb, wave, lane);
            w_finish(ia, ra, lds, wave, lane);
            if (k + 2 >= n) { w_finish(ib, rb, lds, wave, lane); break; }
            ia = w_item_of(a, ws, first + slot + (k + 2) * nslots); w_load(ia, ra, wave, lane);
            w_finish(ib, rb, lds, wave, lane);
            k += 2;
        }
}


#ifndef ONLY
#define PH(n) 1
#else
#define PH(n) (ONLY == (n))
#endif
#define CAS __attribute__((address_space(4)))
__global__ void __launch_bounds__(NWAVES * 64, 2) hymba_fwd(Args a) {
    extern __shared__ __attribute__((aligned(16))) unsigned char lds_raw[];
    Frame F;
    F.lds = (LAS unsigned char*)lds_raw;
    F.G = gridDim.x; { const int bx = blockIdx.x; F.vcu = (F.G % 8 == 0) ? (bx % 8) * (F.G / 8) + bx / 8 : bx; }
    unsigned char* const ws0 = a.ws; size_t wso = 0; unsigned char* ws = ws0;
#define ctl ((gu32*)(ws + WS_CTL))
    volatile LAS unsigned* MISC = (volatile LAS unsigned*)(F.lds + LDSCTL_OFF);
    for (int u = threadIdx.x; u < (LDS_BYTES - LDSCTL_OFF) / 4; u += NWAVES * 64) ((LAS unsigned*)(F.lds + LDSCTL_OFF))[u] = 0u;
    __syncthreads();
    __builtin_amdgcn_s_setreg(1 | (23 << 6) | (0 << 11), 1);
    XcdBarrier bar = xcd_barrier_post((unsigned*)(ctl + CW_BAR), MISC + 8);
#define GRID_BAR() xcd_barrier(bar)
#define FRESH() int tid_ = threadIdx.x; asm volatile("" : "+v"(tid_)); const int lane_ = tid_ & 63, wave_ = __builtin_amdgcn_readfirstlane(tid_ >> 6); \
    int vcu_ = F.vcu, G_ = F.G, bidx_ = blockIdx.x; asm volatile("" : "+s"(vcu_), "+s"(G_), "+s"(bidx_)); const int gw = vcu_ * NWAVES + wave_, NGW = G_ * NWAVES; (void)lane_; (void)gw; (void)NGW; (void)bidx_
#define SUM ((f32x2*)(ws + WS_SUM))
#define ROWTOK ((int*)(ws + WS_ROWTOK))
#define ROWGATE ((float*)(ws + WS_ROWGATE))
#define COST ((float*)(ws + WS_ROPE))
#define SINT ((float*)(ws + WS_ROPE) + (size_t)T * 8)
#define LSE ((float*)(ws + WS_LSE))
#define WFR ((bf16*)(ws + WS_WFR))
#define WIN ((bf16*)(ws + WS_WIN))
#define WOUT ((bf16*)(ws + WS_WOUT))
#define WGU ((bf16*)(ws + WS_WGU))
#define WD ((bf16*)(ws + WS_WD))
#define MOEW ((bf16*)(ws + WS_MOEW))
#define RA ((bf16*)(ws + WS_RA))
#define ZB ((bf16*)(ws + WS_RB))
#define OBR ((bf16*)(ws + WS_RC))
#define QB ZB
#define KB (ZB + (size_t)T * 512)
#define VB (ZB + (size_t)2 * T * 512)
#define UB (ZB + (size_t)3 * T * 512)
#define GB (ZB + (size_t)4 * T * 512)
#define MIXB RA
#define MB VB
#define HLB RA
#define PCB (RA + (size_t)T * 512)
#define ACT ZB
#define ACTM ((bf16*)(ws + WS_ACTM))
#define FSLOT ((bf16*)(ws + WS_FSLOT))
#define RSTDA ((float*)(ws + WS_RSTDA))
#define RSTDF ((float*)(ws + WS_RSTDF))
#define XB ((bf16*)(ws + WS_XB))

#if PH(0)
    {
        FRESH();
        for (int i = tid_; i < 3 * D; i += NWAVES * 64) ((LAS float*)(F.lds + WGAIN_OFF))[i] = (i < 2 * D) ? a.pre_mix_g[i] : a.pre_ffn_g[i - 2 * D];
        __syncthreads();
        convert_items(a, ws, F.lds, 0, NIT_P0, vcu_, G_, wave_, lane_);
        const int gt = vcu_ * (NWAVES * 64) + tid_, NGT = G_ * NWAVES * 64;
        for (int i = gt; i < T * 8; i += NGT) { const int row = i >> 3, f = i & 7;
            const float inv = powf(500000.0f, -(float)f * 0.125f); const float ang = (float)a.pos[row] * inv; float sn, cs; sincosf(ang, &sn, &cs); COST[i] = cs; SINT[i] = sn; }
        for (int i = gt; i < NE * T; i += NGT) ROWTOK[i] = -1;
        for (int i = gt; i < 2 * LW; i += NGT) { const float lm = a.lam[i]; const float sp = (lm > 15.f) ? __expf(-lm) : log1pf(__expf(-lm));
            ((float*)(ws + WS_CCV))[i] = -8.f * sp * 1.4426950408889634f; }
        for (int i = gt; i < 2 * 8 * 16 * 64; i += NGT) {
            const int ln = i & 63, s_ = (i >> 6) & 3, mb = (i >> 8) & 1, gate = (i >> 9) & 1, lg = i >> 10;
            const float* w = (gate ? a.w_igate : a.w_rgate) + (size_t)lg * 64 * 64; const int i0 = 16 * s_ + 8 * (ln >> 5), j = 32 * mb + (ln & 31);
            const float sg = -1.4426950408889634f;
            v4u o; o.x = pk2(sg * w[(i0 + 0) * 64 + j], sg * w[(i0 + 1) * 64 + j]); o.y = pk2(sg * w[(i0 + 2) * 64 + j], sg * w[(i0 + 3) * 64 + j]); o.z = pk2(sg * w[(i0 + 4) * 64 + j], sg * w[(i0 + 5) * 64 + j]); o.w = pk2(sg * w[(i0 + 6) * 64 + j], sg * w[(i0 + 7) * 64 + j]);
            *(GAS v4u*)(WFR + (size_t)i * 8) = o; }
        {
            struct XS { f32x4 v[4]; };
            const float* xin = a.x;
            row_pipe<XS>(gw, NGW, T,
                [&](int m, XS& q) {
#pragma unroll
                    for (int j = 0; j < 4; ++j) q.v[j] = *((const GAS f32x4*)(xin + (size_t)m * D) + lane_ + 64 * j); },
                [&](int m, XS& q) { float s = 0.f;
#pragma unroll
                    for (int j = 0; j < 4; ++j) s += (q.v[j].x * q.v[j].x + q.v[j].y * q.v[j].y) + (q.v[j].z * q.v[j].z + q.v[j].w * q.v[j].w);
                    const float rs = __builtin_amdgcn_rsqf(wave_sum(s) * (1.f / D) + RMS_EPS); if (lane_ == 0) RSTDA[m] = rs;
                    GAS unsigned long long* x8 = (GAS unsigned long long*)(XB + (size_t)m * D) + lane_;
#pragma unroll
                    for (int j = 0; j < 4; ++j) x8[64 * j] = (unsigned long long)pk2(q.v[j].x, q.v[j].y) | ((unsigned long long)pk2(q.v[j].z, q.v[j].w) << 32); });
        }
    }
#endif
    GRID_BAR();

    for (int layer = 0; layer < 2; ++layer) {
        asm volatile("" : "+s"(wso)); ws = ws0 + wso;
#if PH(2)
        {
            FRESH();
            pg8::Gemm g{XB, WIN + (size_t)layer * INC * D, T, INC, D, 0, nullptr}; pg8::StaticOrder S; S.init(T, INC, G_, bidx_);
            pg8::EpiZ E{ZB, (size_t)T * 512, COST, SINT, QSCALE, RSTDA};
            pg8::gemm_phase<pg8::EpiZ, pg8::StaticOrder, false>(F.lds, g, S, E);
        }
#endif
        GRID_BAR();
#if PH(3)
        {
            FRESH();
            lru::LruConst kc; lru::load_const(layer, WFR, a.conv_w, a.conv_b, a.b_rgate, a.b_igate, (const float*)(ws + WS_CCV), kc);
            for (int cu = vcu_; cu < BATCH * 128; cu += G_) { lru::URegs ua; lru::u_load(cu, UB, ua);
                lru::local_unit(cu, layer, kc, ua, GB, SUM, (unsigned*)(ctl + CW_LRU + 64 * (4 * layer + (cu >> 7))), a.lru_out_g, MIXB, F.lds); }
        }
        { FRESH();
          for (int u = vcu_; u < 768; u += G_) { const int bh = u / 24, kq = u % 24;
              if (kq < 8) att::item(bh * 8 + kq, QB, KB, VB, OBR, LSE, F.lds);
              else if (kq < 16) att::item(256 + bh * 8 + (kq - 8), QB, KB, VB, OBR, LSE, F.lds);
              else { att::item(512 + bh * 16 + 2 * (kq - 16), QB, KB, VB, OBR, LSE, F.lds); att::item(513 + bh * 16 + 2 * (kq - 16), QB, KB, VB, OBR, LSE, F.lds); } } }
#endif
        GRID_BAR();
#if PH(4)
        {
            FRESH();
            for (int cu = vcu_; cu < BATCH * 128; cu += G_) attn_combine(cu, layer, OBR, LSE, a.attn_out_g, MIXB);
        }
#endif
        GRID_BAR();
#if PH(5)
        {
            FRESH();
            pg8::Gemm g{MIXB, WOUT + (size_t)layer * D * D, T, D, D, 0, nullptr}; pg8::StaticOrder S; S.init(T, D, G_, bidx_);
            pg8::EpiBf16 E{MB, D};
            pg8::gemm_phase<pg8::EpiBf16, pg8::StaticOrder, false, false, true>(F.lds, g, S, E);
        }
#endif
        GRID_BAR();
#if PH(6)
        {
        FRESH();
        if (layer == 0) {
            struct MX { RawRow m, x; };
            const Gain4 gpost = ld_gain(a.post_mix_g + layer * D, lane_), gpre2 = ld_gain(a.pre_ffn_g + layer * D, lane_);
            row_pipe<MX>(gw, NGW, T,
                [&](int m, MX& q) { ld_raw(MB + (size_t)m * D, q.m, lane_); ld_raw(XB + (size_t)m * D, q.x, lane_); },
                [&](int m, MX& q) { f32x4 hn[4]; post_mix_row(q.m, q.x, XB + (size_t)m * D, gpost, gpre2, nullptr, (unsigned char*)RA + (size_t)m * D, nullptr, hn, lane_); });
        } else {
            LAS float* rt = (LAS float*)F.lds; LAS int* lcnt = (LAS int*)(F.lds + 32768); LAS int* gbase = lcnt + 8; LAS int* lsel = lcnt + 16; LAS float* lprob = (LAS float*)(lcnt + 16 + 4 * 128);
            for (int i = tid_; i < D * NE; i += NWAVES * 64) { const int k = i >> 3, e = i & 7; rt[e * D + k] = a.router_w[i]; }
            if (tid_ < 8) lcnt[tid_] = 0;
            __syncthreads();
            const int rows_per_wg = T / G_;
            for (int rb = 0; rb < rows_per_wg; rb += 128) {
                struct MX { RawRow m, x; };
                const Gain4 gpost = ld_gain(a.post_mix_g + layer * D, lane_), gpre2 = ld_gain(a.pre_ffn_g + layer * D, lane_); const int mbase = vcu_ * rows_per_wg + rb + wave_ * 16;
                row_pipe<MX>(0, 1, 16,
                  [&](int i, MX& q) { const int m = mbase + i; ld_raw(MB + (size_t)m * D, q.m, lane_); ld_raw(XB + (size_t)m * D, q.x, lane_); },
                  [&](int i, MX& q) {
                    const int lr = wave_ * 16 + i; const int m = mbase + i;
                    f32x4 hn[4];
                    post_mix_row(q.m, q.x, XB + (size_t)m * D, gpost, gpre2, nullptr, (unsigned char*)RA + (size_t)m * D, nullptr, hn, lane_);
                    float lg[8];
#pragma unroll
                    for (int e = 0; e < 8; ++e) { float s = 0.f;
#pragma unroll
                        for (int j = 0; j < 4; ++j) { const f32x4 w = *((const LAS f32x4*)(rt + e * D) + lane_ + 64 * j); s += (hn[j].x * w.x + hn[j].y * w.y) + (hn[j].z * w.z + hn[j].w * w.w); }
                        lg[e] = wave_sum(s); }
                    int e1 = 0; float v1 = lg[0];
#pragma unroll
                    for (int e = 1; e < 8; ++e) if (lg[e] > v1) { v1 = lg[e]; e1 = e; }
                    int e2 = -1; float v2 = -3.0e38f;
#pragma unroll
                    for (int e = 0; e < 8; ++e) if (e != e1 && lg[e] > v2) { v2 = lg[e]; e2 = e; }
                    if (lane_ == 0) { const float p2 = __builtin_amdgcn_rcpf(1.f + __builtin_amdgcn_exp2f(1.4426950408889634f * (v1 - v2))); const float p1 = 1.f - p2;
                        const int r1 = __hip_atomic_fetch_add(&lcnt[e1], 1, __ATOMIC_RELAXED, __HIP_MEMORY_SCOPE_WORKGROUP), r2 = __hip_atomic_fetch_add(&lcnt[e2], 1, __ATOMIC_RELAXED, __HIP_MEMORY_SCOPE_WORKGROUP);
                        lsel[lr * 4 + 0] = e1; lsel[lr * 4 + 1] = e2; lsel[lr * 4 + 2] = r1; lsel[lr * 4 + 3] = r2; lprob[lr * 2 + 0] = p1; lprob[lr * 2 + 1] = p2; }
                  });
                __syncthreads();
                if (tid_ < 8) { gbase[tid_] = (int)__hip_atomic_fetch_add(ctl + CW_CNT + 64 * tid_, (unsigned)lcnt[tid_], RLX_AGENT); }
                __syncthreads();
                if (tid_ < 128) { const int m = vcu_ * rows_per_wg + rb + tid_; const int e1 = lsel[tid_ * 4 + 0], e2 = lsel[tid_ * 4 + 1];
                    const int s1 = e1 * T + gbase[e1] + lsel[tid_ * 4 + 2], s2 = e2 * T + gbase[e2] + lsel[tid_ * 4 + 3];
                    ROWTOK[s1] = 2 * m; ROWGATE[s1] = lprob[tid_ * 2]; ROWTOK[s2] = 2 * m + 1; ROWGATE[s2] = lprob[tid_ * 2 + 1]; }
                __syncthreads();
                if (tid_ < 8) lcnt[tid_] = 0;
                __syncthreads();
            }
        }
        }
#endif
        GRID_BAR();
        if (layer == 0) {
#if PH(7)
            {
                FRESH();
                pg8::Gemm g{RA, WGU, T, 2 * FF, D / 2, 0, nullptr}; pg8::StaticOrder S; S.init(T, 2 * FF, G_, bidx_);
                pg8::EpiSwigluF8B E{ACT, FF, 1.f / MOE_WGU_SCALE};
                pg8::gemm_phase<pg8::EpiSwigluF8B, pg8::StaticOrder, false, true, true>(F.lds, g, S, E);
            }
#endif
            GRID_BAR();
#if PH(8)
            {
                FRESH();
                pg8::Gemm g{ACT, WD, T, D, FF, 0, nullptr}; pg8::StaticOrder S; S.init(T, D, G_, bidx_);
                pg8::EpiBf16 E{RA, D};
                pg8::gemm_phase<pg8::EpiBf16, pg8::StaticOrder, false, false, true>(F.lds, g, S, E);
            }
#endif
            GRID_BAR();
            { FRESH();
            struct FX { RawRow f, x; };
            const Gain4 gpost = ld_gain(a.post_ffn_g + layer * D, lane_);
            row_pipe<FX>(gw, NGW, T,
                [&](int m, FX& q) { ld_raw(RA + (size_t)m * D, q.f, lane_); ld_raw(XB + (size_t)m * D, q.x, lane_); },
                [&](int m, FX& q) { f32x4 f[4]; unpack_raw(q.f, f); post_ffn_row(f, q.x, XB + (size_t)m * D, nullptr, gpost, nullptr, nullptr, RSTDA + m, lane_); }); }
            GRID_BAR();
        } else {
            int ps[9]; ps[0] = 0;
#pragma unroll
            for (int e = 0; e < 8; ++e) { const int c = __builtin_amdgcn_readfirstlane((int)__hip_atomic_load(ctl + CW_CNT + 64 * e, RLX_AGENT)); ps[e + 1] = ps[e] + ((c + 255) >> 8); }
            const int P = ps[8];
            bool first = true;
            for (int p0 = 0; p0 < P || first; ) {
                int np = (P - p0) < CHPAN ? (P - p0) : CHPAN;
                if (first) { if (P > 128 && P - 128 < np) np = P - 128;
                             if (ps[EDEF] < np) np = ps[EDEF]; }
#if PH(10)
                {   FRESH();
                    pg8::Gemm g{RA, MOEW, T, 2 * FF, D / 2, (size_t)3 * D * FF, ROWTOK};
                    pg8::MoeOrder S{p0, np, 2 * FF / 256, np * (2 * FF / 256), G_, bidx_, T, ps[1], ps[2], ps[3], ps[4], ps[5], ps[6], ps[7]};
                    pg8::EpiSwigluF8 E{(unsigned char*)ACTM, FF, 1.f / MOE_WGU_SCALE, MOE_ACT_SCALE};
                    pg8::gemm_phase<pg8::EpiSwigluF8, pg8::MoeOrder, true, true, true>(F.lds, g, S, E);
                }
#endif
                const int Gn = F.G; const int tailg = (np * (2 * FF / 256)) % Gn; const int n1 = (first && tailg > 0) ? ((Gn - tailg) < NIT_DEF ? (Gn - tailg) : NIT_DEF) : 0;
                if (first) { FRESH(); const int it = bidx_ - tailg;
                    if (it >= 0 && it < n1) { WRegs r1; const WItem q = w_item_of(a, ws, NIT_P0 + it); w_load(q, r1, wave_, lane_); w_finish(q, r1, F.lds, wave_, lane_); } }
                GRID_BAR();
#if PH(11)
                {   FRESH();
                    pg8::Gemm g{ACTM, MOEW + (size_t)D * FF, np * 256, D, FF / 2, (size_t)3 * D * FF, nullptr};
                    pg8::MoeOrder S{p0, np, D / 256, np * (D / 256), G_, bidx_, T, ps[1], ps[2], ps[3], ps[4], ps[5], ps[6], ps[7]};
                    pg8::EpiMoeDown E{FSLOT, (size_t)T * D, ROWTOK, ROWGATE, 1.f / (MOE_WD_SCALE * MOE_ACT_SCALE)};
                    pg8::gemm_phase<pg8::EpiMoeDown, pg8::MoeOrder, false, true, true>(F.lds, g, S, E);
                }
#endif
                if (first) {
                    FRESH();
                    const int tail = (np * (D / 256)) % G_;
                    { const int slot = bidx_ - tail, nslots = G_ - tail;
                      if (slot >= 0) for (int it = n1 + slot; it < NIT_DEF; it += nslots) { WRegs r1; const WItem q = w_item_of(a, ws, NIT_P0 + it); w_load(q, r1, wave_, lane_); w_finish(q, r1, F.lds, wave_, lane_); } }
                }
                GRID_BAR();
                p0 += np; first = false;
            }
            { FRESH();
            struct FFX { RawRow f0, f1, x; };
            const Gain4 gpost = ld_gain(a.post_ffn_g + layer * D, lane_); float* outp = a.out;
            row_pipe<FFX>(gw, NGW, T,
                [&](int m, FFX& q) { ld_raw(FSLOT + (size_t)m * D, q.f0, lane_); ld_raw(FSLOT + (size_t)T * D + (size_t)m * D, q.f1, lane_); ld_raw(XB + (size_t)m * D, q.x, lane_); },
                [&](int m, FFX& q) { f32x4 f0[4], f1[4]; unpack_raw(q.f0, f0); unpack_raw(q.f1, f1);
#pragma unroll
                    for (int j = 0; j < 4; ++j) f0[j] = f0[j] + f1[j];
                    post_ffn_row(f0, q.x, nullptr, outp + (size_t)m * D, gpost, nullptr, nullptr, nullptr, lane_); }); }
        }
    }
#undef GRID_BAR
#undef FRESH
#undef ctl
}

extern "C" void kernel_launch(void* const* d_in, const int* in_sizes, int n_in, void* d_out, int out_size, void* d_ws, size_t ws_size, hipStream_t stream) {
    static int grid = 0;
    if (grid == 0) {
        if (n_in != 24 || in_sizes[0] != T * D || out_size != T * D || ws_size < WS_END) { fprintf(stderr, "kernel_launch: unexpected shapes / workspace (n_in %d, ws %zu, need %zu); nothing launched\n", n_in, ws_size, (size_t)WS_END); grid = -1; return; }
        int dev = 0, cus = 0, per_cu = 0;
        if (hipGetDevice(&dev) != hipSuccess || hipDeviceGetAttribute(&cus, hipDeviceAttributeMultiprocessorCount, dev) != hipSuccess) { grid = -1; return; }
        if (hipFuncSetAttribute((const void*)hymba_fwd, hipFuncAttributeMaxDynamicSharedMemorySize, LDS_BYTES) != hipSuccess) { fprintf(stderr, "kernel_launch: hipFuncSetAttribute failed\n"); grid = -1; return; }
        if (hipOccupancyMaxActiveBlocksPerMultiprocessor(&per_cu, (const void*)hymba_fwd, NWAVES * 64, LDS_BYTES) != hipSuccess || per_cu < 1) { fprintf(stderr, "kernel_launch: occupancy query says %d\n", per_cu); }
        (void)hipGetLastError();
        grid = cus;
    }
    if (grid < 0) return;
    if (hipMemsetAsync((char*)d_ws + WS_CTL, 0, CTL_ZERO_BYTES, stream) != hipSuccess) return;
    Args a{};
    a.x = (const float*)d_in[0]; a.pos = (const int*)d_in[1]; a.pre_mix_g = (const float*)d_in[2]; a.w_in = (const float*)d_in[3]; a.conv_w = (const float*)d_in[4]; a.conv_b = (const float*)d_in[5];
    a.w_rgate = (const float*)d_in[6]; a.b_rgate = (const float*)d_in[7]; a.w_igate = (const float*)d_in[8]; a.b_igate = (const float*)d_in[9]; a.lam = (const float*)d_in[10];
    a.attn_out_g = (const float*)d_in[11]; a.lru_out_g = (const float*)d_in[12]; a.w_out = (const float*)d_in[13]; a.post_mix_g = (const float*)d_in[14]; a.pre_ffn_g = (const float*)d_in[15]; a.post_ffn_g = (const float*)d_in[16];
    a.dw_gate = (const float*)d_in[17]; a.dw_up = (const float*)d_in[18]; a.dw_down = (const float*)d_in[19]; a.router_w = (const float*)d_in[20]; a.mw_gate = (const float*)d_in[21]; a.mw_up = (const float*)d_in[22]; a.mw_down = (const float*)d_in[23];
    a.out = (float*)d_out; a.ws = (unsigned char*)d_ws;
    hipLaunchKernelGGL(hymba_fwd, dim3(grid), dim3(NWAVES * 64), LDS_BYTES, stream, a);
}
```

```cpp
#include <hip/hip_runtime.h>
#include <cstdio>
#include <cstdint>
#include <cmath>
namespace pg8 {
#define PG8_LAS __attribute__((address_space(3)))
typedef unsigned short bf16_t;
typedef short bf16x8 __attribute__((ext_vector_type(8)));
typedef float f32x4 __attribute__((ext_vector_type(4)));
typedef unsigned u32x4 __attribute__((ext_vector_type(4)));
typedef unsigned u32x2 __attribute__((ext_vector_type(2)));
typedef int v4i_t __attribute__((ext_vector_type(4)));
typedef int v8i_t __attribute__((ext_vector_type(8)));
constexpr int BM = 256, BK = 64, HALF = 128, HTB = HALF * BK * 2  , STAGE_BYTES = 8 * HTB, NXCD = 8, WGM = 8;

__host__ __device__ __forceinline__ int lds_byte(int r, int c) { const int st = (r >> 4) * 2 + (c >> 5), rr = r & 15, cc = c & 31, ob = rr * 64 + cc * 2; return st * 1024 + (ob ^ (((ob >> 9) & 1) << 5)); }
__host__ __device__ __forceinline__ void stage_rc(int b, int& R, int& C) { const int st = b / 1024, sb = b % 1024, swz = sb ^ (((sb >> 9) & 1) << 5); R = (st >> 1) * 16 + swz / 64; C = (st & 1) * 32 + (swz % 64) / 2; }
__host__ __device__ __forceinline__ int perm32(int rho) { const int n = rho >> 4, i = rho & 15; return 8 * (i >> 2) + 4 * n + (i & 3); }

struct Unit { int pm, pn, pl, e, gb; };
struct Gemm { const bf16_t* A; const bf16_t* Bt; int M, N, K; size_t bstride  ; const int* rowtok  ; };

__device__ __forceinline__ void tile_of(int wgid, int nM, int nN, int& pm, int& pn) {
    const int nwg = nM * nN;
    { const int q = nwg / NXCD, r = nwg % NXCD, xcd = wgid % NXCD, off = wgid / NXCD; wgid = (xcd < r ? xcd * (q + 1) : r * (q + 1) + (xcd - r) * q) + off; }
    const int nig = WGM * nN, gid = wgid / nig, fm = gid * WGM, gsz = (nM - fm) < WGM ? (nM - fm) : WGM;
    pm = fm + ((wgid % nig) % gsz); pn = (wgid % nig) / gsz;
}
struct StaticOrder {
    int nM, nN, nwg, G, c;
    __device__ void init(int M, int N, int G_, int c_) { nM = M / BM; nN = N / BM; nwg = nM * nN; G = G_; c = c_; }
    __device__ __forceinline__ bool next(int i, Unit& u) const {
        const long L = (long)i * G + c; if (L >= nwg) return false;
        int pm, pn; tile_of((int)L, nM, nN, pm, pn); u.pm = pm; u.pn = pn; u.pl = pm; u.e = 0; u.gb = pm * BM; return true;
    }
};
struct MoeOrder {
    int p0, np, nN, nwg, G, c, seg; int ps1, ps2, ps3, ps4, ps5, ps6, ps7;
    __device__ __forceinline__ bool next(int i, Unit& u) const {
        const long L = (long)i * G + c; if (L >= nwg) return false;
        int pm, pn; tile_of((int)L, np, nN, pm, pn); u.pl = pm; u.pn = pn; pm += p0; u.pm = pm;
        const int e = (pm >= ps1) + (pm >= ps2) + (pm >= ps3) + (pm >= ps4) + (pm >= ps5) + (pm >= ps6) + (pm >= ps7);
        int pse = 0; pse = (pm >= ps1) ? ps1 : pse; pse = (pm >= ps2) ? ps2 : pse; pse = (pm >= ps3) ? ps3 : pse; pse = (pm >= ps4) ? ps4 : pse; pse = (pm >= ps5) ? ps5 : pse; pse = (pm >= ps6) ? ps6 : pse; pse = (pm >= ps7) ? ps7 : pse;
        u.e = e; u.gb = e * seg + (pm - pse) * BM; return true;
    }
};

__device__ __forceinline__ unsigned cvt_pk_bf16(float lo, float hi) { unsigned r; asm volatile("v_cvt_pk_bf16_f32 %0, %1, %2" : "=v"(r) : "v"(lo), "v"(hi)); return r; }

constexpr int SIDE_OFF = STAGE_BYTES, SIDE_BYTES = 17 * 1024;
__device__ __forceinline__ void side_dma(const void* gsrc_lane, PG8_LAS unsigned char* ldst_wave) {
    __builtin_amdgcn_global_load_lds((const unsigned*)gsrc_lane, (PG8_LAS unsigned*)ldst_wave, 16, 0, 0);
}
struct EpiBf16 {
    static constexpr bool PERM = true;
    bf16_t* O; int ldc; float oscale = 1.f;
    __device__ __forceinline__ void stage_side(PG8_LAS unsigned char*, const Unit&, int, int) const {}
    __device__ __forceinline__ void operator()(const f32x4 (&acc)[2][2][4][2], const Unit& u, int wr, int wc, int fr, int fq, const PG8_LAS unsigned char* side) const {
        const int row0 = u.pm * BM + wr * 64 + fr, col0 = u.pn * BM + wc * 32 + 8 * fq;
#pragma unroll
        for (int ai = 0; ai < 2; ++ai)
#pragma unroll
            for (int m = 0; m < 4; ++m) { bf16_t* rowp = O + (size_t)(row0 + ai * HALF + m * 16) * ldc + col0;
#pragma unroll
                for (int bj = 0; bj < 2; ++bj) { const f32x4 v0 = acc[ai][bj][m][0] * oscale, v1 = acc[ai][bj][m][1] * oscale;
                    u32x4 w; w.x = cvt_pk_bf16(v0[0], v0[1]); w.y = cvt_pk_bf16(v0[2], v0[3]); w.z = cvt_pk_bf16(v1[0], v1[1]); w.w = cvt_pk_bf16(v1[2], v1[3]);
                    *(u32x4*)(rowp + bj * HALF) = w; } }
    }
};
struct EpiZ {
    static constexpr bool PERM = true;
    bf16_t* Z; size_t tstride; const float* cosT; const float* sinT; float qscale; const float* rstd;
    __device__ __forceinline__ void stage_side(PG8_LAS unsigned char* side, const Unit& u, int wid, int lane) const {
        if (wid == 0) side_dma(rstd + (size_t)u.pm * BM + 4 * lane, side);
        if (u.pn < 4) { const size_t r0 = ((size_t)u.pm * BM + 32 * wid) * 8 + 4 * lane;
            side_dma(cosT + r0, side + 1024 + wid * 1024); side_dma(sinT + r0, side + 9216 + wid * 1024); }
    }
    __device__ __forceinline__ void operator()(const f32x4 (&acc)[2][2][4][2], const Unit& u, int wr, int wc, int fr, int fq, const PG8_LAS unsigned char* side) const {
        const int t = u.pn >> 1; bf16_t* base = Z + (size_t)t * tstride;
        const int row0 = u.pm * BM + wr * 64 + fr, col0 = (u.pn & 1) * 256 + wc * 32 + 8 * fq;
        const bool rotw = (t < 2) && ((wc & 1) == 0);
        const float sc = (t == 0) ? qscale : 1.f;
#pragma unroll
        for (int ai = 0; ai < 2; ++ai)
#pragma unroll
            for (int m = 0; m < 4; ++m) { const int row = row0 + ai * HALF + m * 16, rl = wr * 64 + fr + ai * HALF + m * 16; const float rs = ((const PG8_LAS float*)side)[rl] * sc;
                f32x4 v[2][2];
#pragma unroll
                for (int bj = 0; bj < 2; ++bj)
#pragma unroll
                    for (int n = 0; n < 2; ++n) v[bj][n] = acc[ai][bj][m][n] * rs;
                if (rotw) {
                    f32x4 c4[2], s4[2];
#pragma unroll
                    for (int n = 0; n < 2; ++n) { c4[n] = *(const PG8_LAS f32x4*)(side + 1024 + rl * 32 + 16 * n); s4[n] = *(const PG8_LAS f32x4*)(side + 9216 + rl * 32 + 16 * n); }
                    const float sg = (fq == 0) ? -1.f : 1.f;
#pragma unroll
                    for (int bj = 0; bj < 2; ++bj)
#pragma unroll
                        for (int n = 0; n < 2; ++n)
#pragma unroll
                            for (int e = 0; e < 4; ++e) { const float mine = v[bj][n][e]; const float other = __shfl_xor(mine, 16);
                                const float r = mine * c4[n][e] + sg * other * s4[n][e]; v[bj][n][e] = (fq < 2) ? r : mine; }
                }
                bf16_t* rowp = base + (size_t)row * 512 + col0;
#pragma unroll
                for (int bj = 0; bj < 2; ++bj) { const f32x4 v0 = v[bj][0], v1 = v[bj][1];
                    u32x4 w; w.x = cvt_pk_bf16(v0[0], v0[1]); w.y = cvt_pk_bf16(v0[2], v0[3]); w.z = cvt_pk_bf16(v1[0], v1[1]); w.w = cvt_pk_bf16(v1[2], v1[3]);
                    *(u32x4*)(rowp + bj * HALF) = w; } }
    }
};
__device__ __forceinline__ float silu_f(float x) { return x * __builtin_amdgcn_rcpf(1.f + __builtin_amdgcn_exp2f(-1.4426950408889634f * x)); }
struct EpiSwiglu {
    static constexpr bool PERM = true;
    bf16_t* O; int ldc; const float* rstd;
    __device__ __forceinline__ void stage_side(PG8_LAS unsigned char* side, const Unit& u, int wid, int lane) const { if (wid == 0) side_dma(rstd + (size_t)u.pl * BM + 4 * lane, side); }
    __device__ __forceinline__ void operator()(const f32x4 (&acc)[2][2][4][2], const Unit& u, int wr, int wc, int fr, int fq, const PG8_LAS unsigned char* side) const {
        const int row0 = u.pl * BM + wr * 64 + fr, col0 = u.pn * HALF + wc * 32 + 8 * fq;
#pragma unroll
        for (int ai = 0; ai < 2; ++ai)
#pragma unroll
            for (int m = 0; m < 4; ++m) { bf16_t* rowp = O + (size_t)(row0 + ai * HALF + m * 16) * ldc + col0; const float rs = ((const PG8_LAS float*)side)[wr * 64 + fr + ai * HALF + m * 16];
                f32x4 v[2];
                const float kg = -1.4426950408889634f * rs, ir2 = __builtin_amdgcn_rcpf(rs * rs);
#pragma unroll
                for (int n = 0; n < 2; ++n) { const f32x4 g = acc[ai][0][m][n], up = acc[ai][1][m][n];
#pragma unroll
                    for (int e = 0; e < 4; ++e) v[n][e] = (g[e] * up[e]) * __builtin_amdgcn_rcpf(__builtin_fmaf(__builtin_amdgcn_exp2f(kg * g[e]), ir2, ir2)); }
                u32x4 w; w.x = cvt_pk_bf16(v[0][0], v[0][1]); w.y = cvt_pk_bf16(v[0][2], v[0][3]); w.z = cvt_pk_bf16(v[1][0], v[1][1]); w.w = cvt_pk_bf16(v[1][2], v[1][3]);
                *(u32x4*)rowp = w; }
    }
};

__device__ __forceinline__ float clamp448(float v) { return __builtin_amdgcn_fmed3f(v, -448.f, 448.f); }
__device__ __forceinline__ unsigned pk4_fp8(float a, float b, float c, float d) { int w = 0; w = __builtin_amdgcn_cvt_pk_fp8_f32(a, b, w, false); w = __builtin_amdgcn_cvt_pk_fp8_f32(c, d, w, true); return (unsigned)w; }
struct EpiSwiglu8 {
    static constexpr bool PERM = true;
    unsigned char* O; int ldc; const float* rstd; float ascale;
    __device__ __forceinline__ void stage_side(PG8_LAS unsigned char* side, const Unit& u, int wid, int lane) const { if (wid == 0) side_dma(rstd + (size_t)u.pl * BM + 4 * lane, side); }
    __device__ __forceinline__ void operator()(const f32x4 (&acc)[2][2][4][2], const Unit& u, int wr, int wc, int fr, int fq, const PG8_LAS unsigned char* side) const {
        const int row0 = u.pl * BM + wr * 64 + fr, col0 = u.pn * HALF + wc * 32 + 8 * fq;
        const float ia = 1.f / ascale;
#pragma unroll
        for (int ai = 0; ai < 2; ++ai)
#pragma unroll
            for (int m = 0; m < 4; ++m) { unsigned char* rowp = O + (size_t)(row0 + ai * HALF + m * 16) * ldc + col0; const float rs = ((const PG8_LAS float*)side)[wr * 64 + fr + ai * HALF + m * 16];
                f32x4 v[2];
                const float kg = -1.4426950408889634f * rs, ir2 = __builtin_amdgcn_rcpf(rs * rs) * ia;
#pragma unroll
                for (int n = 0; n < 2; ++n) { const f32x4 g = acc[ai][0][m][n], up = acc[ai][1][m][n];
                    const f32x4 t = g * kg; const f32x4 ex = (f32x4){__builtin_amdgcn_exp2f(t[0]), __builtin_amdgcn_exp2f(t[1]), __builtin_amdgcn_exp2f(t[2]), __builtin_amdgcn_exp2f(t[3])};
                    const f32x4 dn = ex * ir2 + ir2; const f32x4 rc = (f32x4){__builtin_amdgcn_rcpf(dn[0]), __builtin_amdgcn_rcpf(dn[1]), __builtin_amdgcn_rcpf(dn[2]), __builtin_amdgcn_rcpf(dn[3])};
                    v[n] = (g * up) * rc; }
                u32x2 w; w.x = pk4_fp8(v[0][0], v[0][1], v[0][2], v[0][3]); w.y = pk4_fp8(v[1][0], v[1][1], v[1][2], v[1][3]);
                *(u32x2*)rowp = w; }
    }
};
struct EpiSwigluF8 {
    static constexpr bool PERM = true;
    unsigned char* O; int ldc; float wscale, ascale;
    __device__ __forceinline__ void stage_side(PG8_LAS unsigned char*, const Unit&, int, int) const {}
    __device__ __forceinline__ void operator()(const f32x4 (&acc)[2][2][4][2], const Unit& u, int wr, int wc, int fr, int fq, const PG8_LAS unsigned char* side) const {
        const int row0 = u.pl * BM + wr * 64 + fr, col0 = u.pn * HALF + wc * 32 + 8 * fq;
        const float ic = 1.f / (wscale * wscale * ascale);
#pragma unroll
        for (int ai = 0; ai < 2; ++ai)
#pragma unroll
            for (int m = 0; m < 4; ++m) { unsigned char* rowp = O + (size_t)(row0 + ai * HALF + m * 16) * ldc + col0;
                f32x4 v[2];
#pragma unroll
                for (int n = 0; n < 2; ++n) { const f32x4 g = acc[ai][0][m][n], up = acc[ai][1][m][n];
                    const f32x4 t = g * (-1.4426950408889634f * wscale); const f32x4 ex = (f32x4){__builtin_amdgcn_exp2f(t[0]), __builtin_amdgcn_exp2f(t[1]), __builtin_amdgcn_exp2f(t[2]), __builtin_amdgcn_exp2f(t[3])};
                    const f32x4 dn = ex * ic + ic; const f32x4 rc = (f32x4){__builtin_amdgcn_rcpf(dn[0]), __builtin_amdgcn_rcpf(dn[1]), __builtin_amdgcn_rcpf(dn[2]), __builtin_amdgcn_rcpf(dn[3])};
                    v[n] = (g * up) * rc; }
                u32x2 w; w.x = pk4_fp8(v[0][0], v[0][1], v[0][2], v[0][3]); w.y = pk4_fp8(v[1][0], v[1][1], v[1][2], v[1][3]);
                *(u32x2*)rowp = w; }
    }
};
struct EpiSwigluF8B {
    static constexpr bool PERM = true;
    bf16_t* O; int ldc; float wscale;
    __device__ __forceinline__ void stage_side(PG8_LAS unsigned char*, const Unit&, int, int) const {}
    __device__ __forceinline__ void operator()(const f32x4 (&acc)[2][2][4][2], const Unit& u, int wr, int wc, int fr, int fq, const PG8_LAS unsigned char* side) const {
        const int row0 = u.pl * BM + wr * 64 + fr, col0 = u.pn * HALF + wc * 32 + 8 * fq;
        const float ic = 1.f / (wscale * wscale);
#pragma unroll
        for (int ai = 0; ai < 2; ++ai)
#pragma unroll
            for (int m = 0; m < 4; ++m) { bf16_t* rowp = O + (size_t)(row0 + ai * HALF + m * 16) * ldc + col0;
                f32x4 v[2];
#pragma unroll
                for (int n = 0; n < 2; ++n) { const f32x4 g = acc[ai][0][m][n], up = acc[ai][1][m][n];
                    const f32x4 t = g * (-1.4426950408889634f * wscale); const f32x4 ex = (f32x4){__builtin_amdgcn_exp2f(t[0]), __builtin_amdgcn_exp2f(t[1]), __builtin_amdgcn_exp2f(t[2]), __builtin_amdgcn_exp2f(t[3])};
                    const f32x4 dn = ex * ic + ic; const f32x4 rc = (f32x4){__builtin_amdgcn_rcpf(dn[0]), __builtin_amdgcn_rcpf(dn[1]), __builtin_amdgcn_rcpf(dn[2]), __builtin_amdgcn_rcpf(dn[3])};
                    v[n] = (g * up) * rc; }
                u32x4 w; w.x = cvt_pk_bf16(v[0][0], v[0][1]); w.y = cvt_pk_bf16(v[0][2], v[0][3]); w.z = cvt_pk_bf16(v[1][0], v[1][1]); w.w = cvt_pk_bf16(v[1][2], v[1][3]);
                *(u32x4*)rowp = w; }
    }
};
struct EpiMoeDown {
    static constexpr bool PERM = true;
    bf16_t* F; size_t kstride; const int* rowtok; const float* rowgate; float oscale;
    __device__ __forceinline__ void stage_side(PG8_LAS unsigned char* side, const Unit& u, int wid, int lane) const {
        if (wid == 0) side_dma(rowtok + (size_t)u.gb + 4 * lane, side);
        if (wid == 1) side_dma(rowgate + (size_t)u.gb + 4 * lane, side + 1024);
    }
    __device__ __forceinline__ void operator()(const f32x4 (&acc)[2][2][4][2], const Unit& u, int wr, int wc, int fr, int fq, const PG8_LAS unsigned char* side) const {
        const int col0 = u.pn * BM + wc * 32 + 8 * fq;
#pragma unroll
        for (int ai = 0; ai < 2; ++ai)
#pragma unroll
            for (int m = 0; m < 4; ++m) { const int sl = wr * 64 + fr + ai * HALF + m * 16; const int tk = ((const PG8_LAS int*)side)[sl]; const float gt = ((const PG8_LAS float*)(side + 1024))[sl] * oscale;
                if (tk >= 0) { bf16_t* rowp = F + (size_t)(tk & 1) * kstride + (size_t)(tk >> 1) * 1024 + col0;
#pragma unroll
                    for (int bj = 0; bj < 2; ++bj) { const f32x4 v0 = acc[ai][bj][m][0] * gt, v1 = acc[ai][bj][m][1] * gt;
                        u32x4 w; w.x = cvt_pk_bf16(v0[0], v0[1]); w.y = cvt_pk_bf16(v0[2], v0[3]); w.z = cvt_pk_bf16(v1[0], v1[1]); w.w = cvt_pk_bf16(v1[2], v1[3]);
                        *(u32x4*)(rowp + bj * HALF) = w; } } }
    }
};

template <class Epi, class Sched, bool GATHER, bool FP8 = false, bool PEEL = false>
__device__ __forceinline__ void gemm_phase(PG8_LAS unsigned char* lds, const Gemm g, const Sched& S, const Epi& E) {
    int tid = threadIdx.x; asm volatile("" : "+v"(tid));
    const int wid = __builtin_amdgcn_readfirstlane(tid >> 6), lane = tid & 63, wr = wid >> 2, wc = wid & 3, fr = lane & 15, fq = lane >> 4;
    const int K = g.K, nt = K / BK;
    unsigned voffB[2]; unsigned vc[2][2], vn[2][2]; int RA[2], CA[2];
#pragma unroll
    for (int i = 0; i < 2; ++i) { int R, C; stage_rc(tid * 16 + i * 8192, R, C); const int Rb = Epi::PERM ? ((R & ~31) + perm32(R & 31)) : R;
        RA[i] = R; CA[i] = C; voffB[i] = (unsigned)(Rb * K + C) * 2u;
        vc[0][i] = vc[1][i] = vn[0][i] = vn[1][i] = (unsigned)(R * K + C) * 2u; }
    const size_t kstep = (size_t)(BK * 2);
    const size_t hstep = (size_t)HALF * K * 2;
    const size_t hstepA = GATHER ? 0 : hstep;
    const size_t tstep = 2 * hstep;
    const unsigned ldsw = (unsigned)wid * 1024u;
    const int aoff = lds_byte(wr * 64 + fr, fq * 8), boff = lds_byte(wc * 32 + fr, fq * 8);
#define PG8_SA(b, h) (((b) * 2 + (h)) * HTB)
#define PG8_SB(b, h) ((4 + (b) * 2 + (h)) * HTB)
#define PG8_STAGE(bufoff, gbase, voff) do { _Pragma("unroll") for (int _i = 0; _i < 2; ++_i) { unsigned _o = (voff)[_i]; asm volatile("" : "+v"(_o));     \
        __builtin_amdgcn_global_load_lds((const unsigned*)((const char*)(gbase) + _o), (PG8_LAS unsigned*)(lds + (bufoff) + ldsw + _i * 8192), 16, 0, 0); } } while (0)
#define PG8_STAGE_A(b, h, P, VO) PG8_STAGE(PG8_SA(b, h), (P) + (h) * hstepA, (VO)[h])
#define PG8_LDA(dst, b, h) do { _Pragma("unroll") for (int m = 0; m < 4; ++m) { dst[m].lo = *(const PG8_LAS v4i_t*)(lds + PG8_SA(b, h) + aoff + m * 2048); dst[m].hi = *(const PG8_LAS v4i_t*)(lds + PG8_SA(b, h) + aoff + m * 2048 + 1024); } } while (0)
#define PG8_LDB(dst, b, h) do { _Pragma("unroll") for (int n = 0; n < 2; ++n) { dst[n].lo = *(const PG8_LAS v4i_t*)(lds + PG8_SB(b, h) + boff + n * 2048); dst[n].hi = *(const PG8_LAS v4i_t*)(lds + PG8_SB(b, h) + boff + n * 2048 + 1024); } } while (0)
#define PG8_MMA(ai, bj, At, Bt) do { __builtin_amdgcn_s_setprio(1); _Pragma("unroll") for (int m = 0; m < 4; ++m) _Pragma("unroll") for (int n = 0; n < 2; ++n) { \
        if constexpr (FP8) asm volatile("v_mfma_scale_f32_16x16x128_f8f6f4 %0, %1, %2, %0, %3, %3 op_sel_hi:[0,0,0]" : "+v"(acc[ai][bj][m][n]) : "v"(Bt[n]), "v"(At[m]), "v"(f8one));     \
        else { const v4i_t blo_ = Bt[n].lo, bhi_ = Bt[n].hi, alo_ = At[m].lo, ahi_ = At[m].hi;     \
               acc[ai][bj][m][n] = __builtin_amdgcn_mfma_f32_16x16x32_bf16(__builtin_bit_cast(bf16x8, blo_), __builtin_bit_cast(bf16x8, alo_), acc[ai][bj][m][n], 0, 0, 0); \
               acc[ai][bj][m][n] = __builtin_amdgcn_mfma_f32_16x16x32_bf16(__builtin_bit_cast(bf16x8, bhi_), __builtin_bit_cast(bf16x8, ahi_), acc[ai][bj][m][n], 0, 0, 0); } } \
        __builtin_amdgcn_s_setprio(0); } while (0)
#define PG8_MMA0(ai, bj, At, Bt) do { __builtin_amdgcn_s_setprio(1); \
        if constexpr (FP8) { _Pragma("unroll") for (int m = 0; m < 4; ++m) _Pragma("unroll") for (int n = 0; n < 2; ++n) \
            asm volatile("v_mfma_scale_f32_16x16x128_f8f6f4 %0, %1, %2, 0, %3, %3 op_sel_hi:[0,0,0]" : "=&v"(acc[ai][bj][m][n]) : "v"(Bt[n]), "v"(At[m]), "v"(f8one)); } \
        else { _Pragma("unroll") for (int m = 0; m < 4; ++m) _Pragma("unroll") for (int n = 0; n < 2; ++n) { const v4i_t blo_ = Bt[n].lo, alo_ = At[m].lo; \
                   asm volatile("v_mfma_f32_16x16x32_bf16 %0, %1, %2, 0" : "=&v"(acc[ai][bj][m][n]) : "v"(blo_), "v"(alo_)); }     \
               _Pragma("unroll") for (int m = 0; m < 4; ++m) _Pragma("unroll") for (int n = 0; n < 2; ++n) { const v4i_t bhi_ = Bt[n].hi, ahi_ = At[m].hi; \
                   acc[ai][bj][m][n] = __builtin_amdgcn_mfma_f32_16x16x32_bf16(__builtin_bit_cast(bf16x8, bhi_), __builtin_bit_cast(bf16x8, ahi_), acc[ai][bj][m][n], 0, 0, 0); } } \
        __builtin_amdgcn_s_setprio(0); } while (0)
#define PG8_WAIT_V(n) asm volatile("s_waitcnt vmcnt(" #n ")" ::: "memory")
#define PG8_WAIT_L(n) asm volatile("s_waitcnt lgkmcnt(" #n ")" ::: "memory")
#define PG8_BAR __builtin_amdgcn_s_barrier()
#define PG8_SCHED __builtin_amdgcn_sched_barrier(0)
#define PG8_GATHER_OFFS(dst, U) do { _Pragma("unroll") for (int _h = 0; _h < 2; ++_h) _Pragma("unroll") for (int _i = 0; _i < 2; ++_i) { \
        int _tk = g.rowtok[(U).gb + _h * HALF + RA[_i]]; _tk = _tk < 0 ? 0 : (_tk >> 1); dst[_h][_i] = (unsigned)(_tk * K + CA[_i]) * 2u; } } while (0)
    Unit cur, nxt; int ui = 0;
    if (!S.next(0, cur)) return;
    f32x4 acc[2][2][4][2];
    if constexpr (!PEEL) {
#pragma unroll
    for (int a = 0; a < 2; ++a)
#pragma unroll
        for (int b = 0; b < 2; ++b)
#pragma unroll
            for (int m = 0; m < 4; ++m)
#pragma unroll
                for (int n = 0; n < 2; ++n) acc[a][b][m][n] = (f32x4){0.f, 0.f, 0.f, 0.f};
    }
    const int f8one = 0x7F7F7F7F;
    v8i_t At[4], B0[2], B1[2];
    if constexpr (GATHER) PG8_GATHER_OFFS(vc, cur);
    const char* cA = (const char*)g.A + (GATHER ? (size_t)0 : (size_t)cur.pl * tstep); const char* cB = (const char*)g.Bt + (size_t)cur.e * g.bstride + (size_t)cur.pn * tstep;
    PG8_STAGE(PG8_SB(0, 0), cB, voffB); PG8_STAGE(PG8_SB(0, 1), cB + hstep, voffB); PG8_STAGE_A(0, 0, cA, vc); PG8_STAGE_A(0, 1, cA, vc);
    if (wr == 1) PG8_BAR;
    PG8_WAIT_V(2); PG8_BAR;
    PG8_STAGE(PG8_SB(1, 0), cB + kstep, voffB); PG8_STAGE_A(1, 0, cA + kstep, vc); PG8_STAGE(PG8_SB(1, 1), cB + hstep + kstep, voffB);
    PG8_WAIT_V(6); PG8_BAR;
#pragma nounroll
    for (;;) {
        const bool has_next = S.next(ui + 1, nxt);
        const char* nA = has_next ? (const char*)g.A + (GATHER ? (size_t)0 : (size_t)nxt.pl * tstep) : cA;
        const char* nB = has_next ? (const char*)g.Bt + (size_t)nxt.e * g.bstride + (size_t)nxt.pn * tstep : cB;
        if constexpr (GATHER) { if (has_next) PG8_GATHER_OFFS(vn, nxt); else { _Pragma("unroll") for (int _h = 0; _h < 2; ++_h) _Pragma("unroll") for (int _i = 0; _i < 2; ++_i) vn[_h][_i] = vc[_h][_i]; } }
        if constexpr (PEEL) {
            const int t = 0;
            const bool last = (t == nt - 2);
            const char* a1 = cA + (size_t)(t + 1) * kstep;
            const char* a2 = last ? nA : cA + (size_t)(t + 2) * kstep; const char* b2 = last ? nB : cB + (size_t)(t + 2) * kstep;
            const char* a3 = a2 + kstep; const char* b3 = b2 + kstep;
            unsigned v2[2][2];
#pragma unroll
            for (int _h = 0; _h < 2; ++_h)
#pragma unroll
                for (int _i = 0; _i < 2; ++_i) v2[_h][_i] = (GATHER && last) ? vn[_h][_i] : vc[_h][_i];
            if (t == 2) E.stage_side(lds + SIDE_OFF, cur, wid, lane);
            PG8_LDB(B0, 0, 0); PG8_LDB(B1, 0, 1); PG8_SCHED; PG8_LDA(At, 0, 0); PG8_STAGE_A(1, 1, a1, vc);
            PG8_WAIT_V(8); PG8_WAIT_L(0); PG8_BAR; PG8_MMA0(0, 0, At, B0); PG8_MMA0(0, 1, At, B1); PG8_BAR; PG8_SCHED;
            PG8_LDA(At, 0, 1); PG8_STAGE(PG8_SB(0, 0), b2, voffB); PG8_STAGE(PG8_SB(0, 1), b2 + hstep, voffB); PG8_STAGE_A(0, 0, a2, v2);
            PG8_WAIT_V(8); PG8_WAIT_L(0); PG8_BAR; PG8_MMA0(1, 0, At, B0); PG8_MMA0(1, 1, At, B1); PG8_BAR; PG8_SCHED;
            PG8_LDB(B0, 1, 0); PG8_LDB(B1, 1, 1); PG8_SCHED; PG8_LDA(At, 1, 0); PG8_STAGE_A(0, 1, a2, v2);
            PG8_WAIT_V(8); PG8_WAIT_L(0); PG8_BAR; PG8_MMA(0, 0, At, B0); PG8_MMA(0, 1, At, B1); PG8_BAR; PG8_SCHED;
            PG8_LDA(At, 1, 1); PG8_STAGE(PG8_SB(1, 0), b3, voffB); PG8_STAGE(PG8_SB(1, 1), b3 + hstep, voffB); PG8_STAGE_A(1, 0, a3, v2);
            PG8_WAIT_V(8); PG8_WAIT_L(0); PG8_BAR; PG8_MMA(1, 0, At, B0); PG8_MMA(1, 1, At, B1); PG8_BAR; PG8_SCHED;
        }
#pragma nounroll
        for (int t = PEEL ? 2 : 0; t < nt; t += 2) {
            const bool last = (t == nt - 2);
            const char* a1 = cA + (size_t)(t + 1) * kstep;
            const char* a2 = last ? nA : cA + (size_t)(t + 2) * kstep; const char* b2 = last ? nB : cB + (size_t)(t + 2) * kstep;
            const char* a3 = a2 + kstep; const char* b3 = b2 + kstep;
            unsigned v2[2][2];
#pragma unroll
            for (int _h = 0; _h < 2; ++_h)
#pragma unroll
                for (int _i = 0; _i < 2; ++_i) v2[_h][_i] = (GATHER && last) ? vn[_h][_i] : vc[_h][_i];
            if (t == 2) E.stage_side(lds + SIDE_OFF, cur, wid, lane);
            PG8_LDB(B0, 0, 0); PG8_LDB(B1, 0, 1); PG8_SCHED; PG8_LDA(At, 0, 0); PG8_STAGE_A(1, 1, a1, vc);
            PG8_WAIT_V(8); PG8_WAIT_L(0); PG8_BAR; PG8_MMA(0, 0, At, B0); PG8_MMA(0, 1, At, B1); PG8_BAR; PG8_SCHED;
            PG8_LDA(At, 0, 1); PG8_STAGE(PG8_SB(0, 0), b2, voffB); PG8_STAGE(PG8_SB(0, 1), b2 + hstep, voffB); PG8_STAGE_A(0, 0, a2, v2);
            PG8_WAIT_V(8); PG8_WAIT_L(0); PG8_BAR; PG8_MMA(1, 0, At, B0); PG8_MMA(1, 1, At, B1); PG8_BAR; PG8_SCHED;
            PG8_LDB(B0, 1, 0); PG8_LDB(B1, 1, 1); PG8_SCHED; PG8_LDA(At, 1, 0); PG8_STAGE_A(0, 1, a2, v2);
            PG8_WAIT_V(8); PG8_WAIT_L(0); PG8_BAR; PG8_MMA(0, 0, At, B0); PG8_MMA(0, 1, At, B1); PG8_BAR; PG8_SCHED;
            PG8_LDA(At, 1, 1); PG8_STAGE(PG8_SB(1, 0), b3, voffB); PG8_STAGE(PG8_SB(1, 1), b3 + hstep, voffB); PG8_STAGE_A(1, 0, a3, v2);
            PG8_WAIT_V(8); PG8_WAIT_L(0); PG8_BAR; PG8_MMA(1, 0, At, B0); PG8_MMA(1, 1, At, B1); PG8_BAR; PG8_SCHED;
        }
        if constexpr (FP8) asm volatile("s_nop 15\n\ts_nop 15" ::: "memory");
        if (wr == 0) PG8_BAR;
        E(acc, cur, wr, wc, fr, fq, lds + SIDE_OFF);
        if (!has_next) break;
        if constexpr (!PEEL) {
#pragma unroll
        for (int a = 0; a < 2; ++a)
#pragma unroll
            for (int b = 0; b < 2; ++b)
#pragma unroll
                for (int m = 0; m < 4; ++m)
#pragma unroll
                    for (int n = 0; n < 2; ++n) acc[a][b][m][n] = (f32x4){0.f, 0.f, 0.f, 0.f};
        }
        cur = nxt; cA = nA; cB = nB; ++ui;
        if constexpr (GATHER) { _Pragma("unroll") for (int _h = 0; _h < 2; ++_h) _Pragma("unroll") for (int _i = 0; _i < 2; ++_i) vc[_h][_i] = vn[_h][_i]; }
        if (wr == 1) PG8_BAR;
    }
    PG8_WAIT_V(0);
    PG8_BAR;
#undef PG8_SA
#undef PG8_SB
#undef PG8_STAGE
#undef PG8_STAGE_A
#undef PG8_LDA
#undef PG8_LDB
#undef PG8_MMA
#undef PG8_MMA0
#undef PG8_WAIT_V
#undef PG8_WAIT_L
#undef PG8_BAR
#undef PG8_SCHED
#undef PG8_GATHER_OFFS
}
}
constexpr int NWAVES = 8;
constexpr int BATCH = 4, SEQ = 8192, D = 1024, T = BATCH * SEQ;
constexpr int AW = 512, NH = 8, HD = 64, LW = 512, INC = 2560, FF = 3584, NE = 8;
constexpr float RMS_EPS = 1e-6f;
constexpr float QSCALE = 0.125f * 1.4426950408889634f;
constexpr int MAXPAN = 264;
constexpr int CHPAN = 146;
constexpr float MOE_WGU_SCALE = 32.f, MOE_WD_SCALE = 64.f, MOE_ACT_SCALE = 16.f;

constexpr size_t MiB = 1u << 20;
constexpr size_t WS_CTL = 0, CTL_ZERO_BYTES = 1 * MiB;
constexpr size_t WS_SUM = 1 * MiB;
constexpr size_t WS_TOKE = 3 * MiB, WS_TOKP = WS_TOKE + 256 * 1024, WS_TOKR = WS_TOKP + 256 * 1024;
constexpr size_t WS_RSTDA = 513 * MiB, WS_RSTDF = WS_RSTDA + 128 * 1024;
constexpr size_t WS_CCV = 3 * MiB;
constexpr size_t WS_ROWTOK = 514 * MiB, WS_ROWGATE = 515 * MiB;
constexpr size_t WS_WFR = 4 * MiB + 640 * 1024;
constexpr size_t WS_ROPE = 5 * MiB;
constexpr size_t WS_LSE = 7 * MiB;
constexpr size_t WS_WIN = 10 * MiB, WS_WOUT = 20 * MiB, WS_WGU = 24 * MiB, WS_WD = 38 * MiB;
constexpr size_t WS_RA = 45 * MiB;
constexpr size_t WS_RB = 109 * MiB;
constexpr size_t WS_RC = 269 * MiB;
constexpr size_t WS_MOEW = 365 * MiB;
constexpr size_t WS_XB = 449 * MiB;
constexpr size_t WS_END = 533 * MiB;
constexpr size_t WS_ACTM = WS_RB, WS_FSLOT = WS_RB + 128 * MiB;
static_assert((size_t)CHPAN * 256 * FF <= 128 * MiB && WS_FSLOT + 128 * MiB <= WS_MOEW && WS_RB + 224 * MiB <= WS_MOEW && WS_RC + 96 * MiB <= WS_MOEW && WS_MOEW + 84 * MiB <= WS_XB && WS_XB + 64 * MiB <= WS_END, "ws map");
constexpr int CW_BAR = 4096;
constexpr int CW_LRU = 20480;
constexpr int CW_CNT = 16384;

constexpr int LDS_BYTES = 159744;
constexpr int LDSCTL_OFF = 158720;

#define GAS __attribute__((address_space(1)))
#define LAS __attribute__((address_space(3)))
typedef unsigned short bf16;
typedef unsigned v4u __attribute__((ext_vector_type(4)));
typedef unsigned v2u __attribute__((ext_vector_type(2)));
typedef float f32x4 __attribute__((ext_vector_type(4)));
typedef float f32x2 __attribute__((ext_vector_type(2)));
typedef float f32x16 __attribute__((ext_vector_type(16)));
typedef short bf16x8 __attribute__((ext_vector_type(8)));
typedef short v4i16_t __attribute__((ext_vector_type(4)));
typedef GAS unsigned gu32;
#define RLX_AGENT __ATOMIC_RELAXED, __HIP_MEMORY_SCOPE_AGENT
#define LDS_WAIT() asm volatile("s_waitcnt lgkmcnt(0)" ::: "memory")
#define VM_WAIT() asm volatile("s_waitcnt vmcnt(0)" ::: "memory")
__device__ __forceinline__ unsigned f2bf(float f) { unsigned u = __builtin_bit_cast(unsigned, f); return (u + 0x7fffu + ((u >> 16) & 1u)) >> 16; }
__device__ __forceinline__ unsigned pk2(float lo, float hi) { typedef float f2_t __attribute__((ext_vector_type(2))); typedef __bf16 b2_t __attribute__((ext_vector_type(2))); const f2_t v = {lo, hi}; return __builtin_bit_cast(unsigned, __builtin_convertvector(v, b2_t)); }
__device__ __forceinline__ float bf_lo(unsigned w) { return __builtin_bit_cast(float, w << 16); }
__device__ __forceinline__ float bf_hi(unsigned w) { return __builtin_bit_cast(float, w & 0xffff0000u); }

#define XB_TMO      128
#define XB_XCNT(j)  (256  + 64 * (j))
#define XB_XSUB(j)  (1280 + 64 * (j))
#define XB_XGEN(j)  (2304 + 64 * (j))
#define XB_TOP      3328
#define XB_TOPGEN   3392
#define XCD_BAR_WORDS 3456
#define XB_SPIN_CAP (1u << 18)

__device__ __forceinline__ unsigned xb_ld(unsigned* p)              { return __hip_atomic_load(p, __ATOMIC_RELAXED, __HIP_MEMORY_SCOPE_AGENT); }
__device__ __forceinline__ unsigned xb_add(unsigned* p, unsigned v) { return __hip_atomic_fetch_add(p, v, __ATOMIC_RELAXED, __HIP_MEMORY_SCOPE_AGENT); }
__device__ __forceinline__ unsigned xb_xcc_id() { return (unsigned)__builtin_amdgcn_s_getreg((3 << 11) | 20) & 0xFu; }
#define XB_SPIN(cond, bar) do { unsigned _sp = 0; while (cond) { __builtin_amdgcn_s_sleep(1); \
    if ((++_sp & 255u) == 0u) { if (xb_ld(&(bar)[XB_TMO])) break; if (_sp > XB_SPIN_CAP) { atomicAdd(&(bar)[XB_TMO], 1u); break; } } } } while (0)

struct XcdBarrier {
    unsigned* bar; unsigned x;
    volatile LAS unsigned* st;
};
__device__ __forceinline__ XcdBarrier xcd_barrier_post(unsigned* bar, volatile LAS unsigned* st) {
    XcdBarrier b; b.bar = bar; b.x = xb_xcc_id(); b.st = st;
    if (threadIdx.x == 0) (void)xb_add(&bar[XB_XCNT(b.x)], 1u);
    return b;
}
__device__ __forceinline__ void xcd_barrier_complete(unsigned* bar, unsigned x, unsigned& nloc, unsigned& nx) {
    const unsigned G = gridDim.x * gridDim.y * gridDim.z;
    unsigned sum, cnt, mine, sp = 0u;
    for (;;) {
        sum = 0u; cnt = 0u; mine = 0u;
#pragma unroll
        for (unsigned j = 0; j < 16; ++j) { const unsigned c = xb_ld(&bar[XB_XCNT(j)]); sum += c; cnt += (c > 0u) ? 1u : 0u; mine = (j == x) ? c : mine; }
        if (sum == G) break;
        __builtin_amdgcn_s_sleep(1);
        if ((++sp & 255u) == 0u) { if (xb_ld(&bar[XB_TMO])) break; if (sp > XB_SPIN_CAP) { atomicAdd(&bar[XB_TMO], 1u); break; } }
    }
    nloc = mine > 0u ? mine : 1u; nx = cnt > 0u ? cnt : 1u;
}
__device__ __forceinline__ void xcd_barrier(const XcdBarrier& b) {
    asm volatile("s_waitcnt vmcnt(0)" ::: "memory");
    __syncthreads();
    if (threadIdx.x == 0) {
        unsigned* bar = b.bar; { const unsigned long long u_ = (unsigned long long)bar; bar = (unsigned*)(((unsigned long long)(unsigned)__builtin_amdgcn_readfirstlane((int)(u_ >> 32)) << 32) | (unsigned)__builtin_amdgcn_readfirstlane((int)u_)); } asm volatile("" : "+s"(bar));
        __builtin_amdgcn_s_waitcnt(0);
        unsigned nloc = b.st[0], nx = b.st[1];
        unsigned bx_ = b.x; asm volatile("" : "+s"(bx_));
        if (nloc == 0u) { xcd_barrier_complete(bar, bx_, nloc, nx); b.st[0] = nloc; b.st[1] = nx; }
        const unsigned old = xb_add(&bar[XB_XSUB(bx_)], 1u);
        const unsigned gen = old / nloc;
        if (old + 1u == (gen + 1u) * nloc) {
            __builtin_amdgcn_fence(__ATOMIC_RELEASE, "agent");
            asm volatile("s_waitcnt vmcnt(0)" ::: "memory");
            const unsigned og = xb_add(&bar[XB_TOP], 1u);
            const unsigned tg = og / nx;
            if (og + 1u == (tg + 1u) * nx) xb_add(&bar[XB_TOPGEN], 1u);
            else XB_SPIN(xb_ld(&bar[XB_TOPGEN]) == tg, bar);
            __builtin_amdgcn_fence(__ATOMIC_ACQUIRE, "agent");
            xb_add(&bar[XB_XGEN(bx_)], 1u);
            asm volatile("s_waitcnt vmcnt(0)" ::: "memory");
        } else {
            XB_SPIN(xb_ld(&bar[XB_XGEN(bx_)]) == gen, bar);
            __builtin_amdgcn_fence(__ATOMIC_ACQUIRE, "agent");
            asm volatile("s_waitcnt vmcnt(0)" ::: "memory");
        }
    }
    __syncthreads();
}

struct Args {
    const float* x; const int* pos; const float* pre_mix_g; const float* w_in; const float* conv_w; const float* conv_b;
    const float* w_rgate; const float* b_rgate; const float* w_igate; const float* b_igate; const float* lam;
    const float* attn_out_g; const float* lru_out_g; const float* w_out; const float* post_mix_g; const float* pre_ffn_g; const float* post_ffn_g;
    const float* dw_gate; const float* dw_up; const float* dw_down; const float* router_w; const float* mw_gate; const float* mw_up; const float* mw_down;
    float* out; unsigned char* ws;
};
struct Frame {
    LAS unsigned char* lds;
    int vcu, G;
};
#define DPP_ADD(v, ctrl) ((v) + __builtin_bit_cast(float, __builtin_amdgcn_update_dpp(0, __builtin_bit_cast(int, (v)), (ctrl), 0xF, 0xF, true)))
__device__ __forceinline__ float wave_sum(float v) {
    v = DPP_ADD(v, 0xB1);
    v = DPP_ADD(v, 0x4E);
    v = DPP_ADD(v, 0x141);
    v = DPP_ADD(v, 0x140);
    const int b = __builtin_bit_cast(int, v);
    const float r0 = __builtin_bit_cast(float, __builtin_amdgcn_readlane(b, 0)), r1 = __builtin_bit_cast(float, __builtin_amdgcn_readlane(b, 16));
    const float r2 = __builtin_bit_cast(float, __builtin_amdgcn_readlane(b, 32)), r3 = __builtin_bit_cast(float, __builtin_amdgcn_readlane(b, 48));
    return (r0 + r1) + (r2 + r3);
}
__device__ __forceinline__ void p0_transpose_item(const float* W, int K, int N, bf16* WT, int k0, int n0, int drow0, LAS float* scr, int lane) {
    float ld_[32];
#pragma unroll
    for (int i = 0; i < 32; ++i) { const int kk = 2 * i + (lane >> 5); ld_[i] = W[(size_t)(k0 + kk) * N + n0 + (lane & 31)]; }
#pragma unroll
    for (int i = 0; i < 32; ++i) { const int kk = 2 * i + (lane >> 5); scr[kk * 33 + (lane & 31)] = ld_[i]; }
    LDS_WAIT(); asm volatile("" ::: "memory");
    const int c = lane & 7;
#pragma unroll
    for (int j = 0; j < 4; ++j) { const int n = (lane >> 3) + 8 * j; const LAS float* s = scr + (8 * c) * 33 + n;
        v4u o; o.x = pk2(s[0 * 33], s[1 * 33]); o.y = pk2(s[2 * 33], s[3 * 33]); o.z = pk2(s[4 * 33], s[5 * 33]); o.w = pk2(s[6 * 33], s[7 * 33]);
        *(GAS v4u*)(WT + (size_t)(drow0 + n) * K + k0 + 8 * c) = o; }
    LDS_WAIT(); asm volatile("" ::: "memory");
}
__device__ __forceinline__ unsigned pk4f8(float a, float b, float c, float d) { int w = 0; w = __builtin_amdgcn_cvt_pk_fp8_f32(a, b, w, false); w = __builtin_amdgcn_cvt_pk_fp8_f32(c, d, w, true); return (unsigned)w; }
__device__ __forceinline__ void p0_transpose_item_f8(const float* W, int K, int N, unsigned char* WT, int k0, int n0, int drow0, float scale, LAS float* scr, int lane) {
    float ld_[64];
#pragma unroll
    for (int i = 0; i < 64; ++i) { const int kk = 2 * i + (lane >> 5); ld_[i] = W[(size_t)(k0 + kk) * N + n0 + (lane & 31)]; }
#pragma unroll
    for (int i = 0; i < 64; ++i) { const int kk = 2 * i + (lane >> 5); scr[kk * 33 + (lane & 31)] = ld_[i]; }
    LDS_WAIT(); asm volatile("" ::: "memory");
    const int c = lane & 7;
#pragma unroll
    for (int j = 0; j < 4; ++j) { const int n = (lane >> 3) + 8 * j; const LAS float* s = scr + (16 * c) * 33 + n;
        v4u o; o.x = pk4f8(s[0 * 33] * scale, s[1 * 33] * scale, s[2 * 33] * scale, s[3 * 33] * scale); o.y = pk4f8(s[4 * 33] * scale, s[5 * 33] * scale, s[6 * 33] * scale, s[7 * 33] * scale);
        o.z = pk4f8(s[8 * 33] * scale, s[9 * 33] * scale, s[10 * 33] * scale, s[11 * 33] * scale); o.w = pk4f8(s[12 * 33] * scale, s[13 * 33] * scale, s[14 * 33] * scale, s[15 * 33] * scale);
        *(GAS v4u*)(WT + (size_t)(drow0 + n) * K + k0 + 16 * c) = o; }
    LDS_WAIT(); asm volatile("" ::: "memory");
}
__device__ __forceinline__ void tr_plain_f8(const float* W, int K, int N, unsigned char* WT, int item, float scale, LAS float* scr, int lane) {
    const int nblk = N / 32, kb = item / nblk, nb = item % nblk; p0_transpose_item_f8(W, K, N, WT, 128 * kb, 32 * nb, 32 * nb, scale, scr, lane);
}
__device__ __forceinline__ void tr_gu_f8(const float* W, unsigned char* WT, int isup, int item, float scale, LAS float* scr, int lane) {
    const int nblk = FF / 32, kb = item / nblk, nb = item % nblk, n0 = 32 * nb; p0_transpose_item_f8(W, D, FF, WT, 128 * kb, n0, 256 * (n0 >> 7) + 128 * isup + (n0 & 127), scale, scr, lane);
}
__device__ __forceinline__ void tr_plain(const float* W, int K, int N, bf16* WT, int item, LAS float* scr, int lane) {
    const int nblk = N / 32, kb = item / nblk, nb = item % nblk; p0_transpose_item(W, K, N, WT, 64 * kb, 32 * nb, 32 * nb, scr, lane);
}
__device__ __forceinline__ void tr_gu(const float* W, bf16* WT, int isup, int item, LAS float* scr, int lane) {
    const int nblk = FF / 32, kb = item / nblk, nb = item % nblk, n0 = 32 * nb; p0_transpose_item(W, D, FF, WT, 64 * kb, n0, 256 * (n0 >> 7) + 128 * isup + (n0 & 127), scr, lane);
}
template <bool F8>
__device__ __forceinline__ void coop_item(const float* W, int K, int N, void* WT, int k0, int n0, int GU, float scale, LAS unsigned char* lds, int wave, int lane, const float* gk = nullptr) {
    LAS float* tl = (LAS float*)lds;
    float ld_[64];
#pragma unroll
    for (int r = 0; r < 16; ++r) { const float gr = gk ? gk[k0 + 16 * wave + r] : 1.f;
#pragma unroll
        for (int j = 0; j < 4; ++j) ld_[4 * r + j] = W[(size_t)(k0 + 16 * wave + r) * N + n0 + lane + 64 * j] * gr; }
#pragma unroll
    for (int r = 0; r < 16; ++r)
#pragma unroll
        for (int j = 0; j < 4; ++j) tl[(16 * wave + r) * 257 + lane + 64 * j] = ld_[4 * r + j];
    __syncthreads();
    if (F8) {
        const int c = lane & 7;
#pragma unroll
        for (int it = 0; it < 4; ++it) { const int nl = 32 * wave + 8 * it + (lane >> 3), n = n0 + nl; const LAS float* s = tl + (16 * c) * 257 + nl;
            const int drow = (GU < 0) ? n : 256 * (n >> 7) + 128 * GU + (n & 127);
            v4u o; o.x = pk4f8(s[0 * 257] * scale, s[1 * 257] * scale, s[2 * 257] * scale, s[3 * 257] * scale); o.y = pk4f8(s[4 * 257] * scale, s[5 * 257] * scale, s[6 * 257] * scale, s[7 * 257] * scale);
            o.z = pk4f8(s[8 * 257] * scale, s[9 * 257] * scale, s[10 * 257] * scale, s[11 * 257] * scale); o.w = pk4f8(s[12 * 257] * scale, s[13 * 257] * scale, s[14 * 257] * scale, s[15 * 257] * scale);
            *(GAS v4u*)((unsigned char*)WT + (size_t)drow * K + k0 + 16 * c) = o; }
    } else {
        const int c = lane & 15;
#pragma unroll
        for (int it = 0; it < 8; ++it) { const int nl = 32 * wave + 4 * it + (lane >> 4), n = n0 + nl; const LAS float* s = tl + (8 * c) * 257 + nl;
            const int drow = (GU < 0) ? n : 256 * (n >> 7) + 128 * GU + (n & 127);
            v4u o; o.x = pk2(s[0 * 257], s[1 * 257]); o.y = pk2(s[2 * 257], s[3 * 257]); o.z = pk2(s[4 * 257], s[5 * 257]); o.w = pk2(s[6 * 257], s[7 * 257]);
            *(GAS v4u*)((bf16*)WT + (size_t)drow * K + k0 + 8 * c) = o; }
    }
    __syncthreads();
}
constexpr int WGAIN_OFF = 135168;
struct WItem { const float* W; unsigned char* WT; int K, N, k0, n0, GU, f8, gko; float scale; };
struct WRegs { float v[64]; };
__device__ __forceinline__ void w_load(const WItem& q, WRegs& r, int wave, int lane) {
    const GAS float* src = (const GAS float*)q.W + (size_t)(q.k0 + 16 * wave) * q.N + q.n0 + lane;
#pragma unroll
    for (int i = 0; i < 16; ++i)
#pragma unroll
        for (int j = 0; j < 4; ++j) r.v[4 * i + j] = src[(size_t)i * q.N + 64 * j];
}
__device__ __forceinline__ void w_finish(const WItem& q, WRegs& r, LAS unsigned char* lds, int wave, int lane) {
    LAS float* tl = (LAS float*)lds;
    if (q.gko >= 0) {
        const LAS float* gl = (const LAS float*)(lds + WGAIN_OFF) + q.gko + q.k0 + 16 * wave;
#pragma unroll
        for (int i = 0; i < 16; ++i) { const float gi = gl[i];
#pragma unroll
            for (int j = 0; j < 4; ++j) tl[(16 * wave + i) * 257 + lane + 64 * j] = r.v[4 * i + j] * gi; }
    } else {
#pragma unroll
        for (int i = 0; i < 16; ++i)
#pragma unroll
            for (int j = 0; j < 4; ++j) tl[(16 * wave + i) * 257 + lane + 64 * j] = r.v[4 * i + j];
    }
    LDS_WAIT(); __builtin_amdgcn_s_barrier();
    const int K = q.K, GU = q.GU;
    if (q.f8) {
        const float scale = q.scale;
#pragma unroll
        for (int it = 0; it < 4; ++it) { const int c = (lane >> 4) + 4 * (it & 1), nl = 32 * wave + 16 * (it >> 1) + (lane & 15), n = q.n0 + nl; const LAS float* s = tl + (16 * c) * 257 + nl;
            const int drow = (GU < 0) ? n : 256 * (n >> 7) + 128 * GU + (n & 127);
            v4u o; o.x = pk4f8(s[0 * 257] * scale, s[1 * 257] * scale, s[2 * 257] * scale, s[3 * 257] * scale); o.y = pk4f8(s[4 * 257] * scale, s[5 * 257] * scale, s[6 * 257] * scale, s[7 * 257] * scale);
            o.z = pk4f8(s[8 * 257] * scale, s[9 * 257] * scale, s[10 * 257] * scale, s[11 * 257] * scale); o.w = pk4f8(s[12 * 257] * scale, s[13 * 257] * scale, s[14 * 257] * scale, s[15 * 257] * scale);
            *(GAS v4u*)(q.WT + (size_t)drow * K + q.k0 + 16 * c) = o; }
    } else {
#pragma unroll
        for (int it = 0; it < 8; ++it) { const int c = (lane >> 3) + 8 * (it & 1), nl = 32 * wave + 8 * (it >> 1) + (lane & 7), n = q.n0 + nl; const LAS float* s = tl + (8 * c) * 257 + nl;
            const int drow = (GU < 0) ? n : 256 * (n >> 7) + 128 * GU + (n & 127);
            v4u o; o.x = pk2(s[0 * 257], s[1 * 257]); o.y = pk2(s[2 * 257], s[3 * 257]); o.z = pk2(s[4 * 257], s[5 * 257]); o.w = pk2(s[6 * 257], s[7 * 257]);
            *(GAS v4u*)((bf16*)q.WT + (size_t)drow * K + q.k0 + 8 * c) = o; }
    }
    LDS_WAIT(); __builtin_amdgcn_s_barrier();
}
__device__ __forceinline__ void rms_store_bf16(const f32x4 (&v)[4], const float* g, bf16* orow, int lane) {
    float s = 0.f;
#pragma unroll
    for (int j = 0; j < 4; ++j) s += (v[j].x * v[j].x + v[j].y * v[j].y) + (v[j].z * v[j].z + v[j].w * v[j].w);
    const float rstd = __builtin_amdgcn_rsqf(wave_sum(s) * (1.f / D) + RMS_EPS);
    GAS unsigned long long* o8 = (GAS unsigned long long*)orow + lane;
#pragma unroll
    for (int j = 0; j < 4; ++j) { const f32x4 gg = *((const GAS f32x4*)g + lane + 64 * j);
        o8[64 * j] = (unsigned long long)pk2(v[j].x * rstd * gg.x, v[j].y * rstd * gg.y) | ((unsigned long long)pk2(v[j].z * rstd * gg.z, v[j].w * rstd * gg.w) << 32); }
}
template <class S, class L, class P>
__device__ __forceinline__ void row_pipe(int r0, int step, int end, L load, P proc) {
    if (r0 >= end) return;
    const int last = r0 + ((end - 1 - r0) / step) * step;
#define RP_CL(x) ((x) < last ? (x) : last)
    S s0, s1, s2, s3;
    load(r0, s0); load(RP_CL(r0 + step), s1); load(RP_CL(r0 + 2 * step), s2);
    for (int r = r0; ; r += 4 * step) {
        load(RP_CL(r + 3 * step), s3);
        proc(r, s0);
        if (r + step > last) break;
        load(RP_CL(r + 4 * step), s0);
        proc(r + step, s1);
        if (r + 2 * step > last) break;
        load(RP_CL(r + 5 * step), s1);
        proc(r + 2 * step, s2);
        if (r + 3 * step > last) break;
        load(RP_CL(r + 6 * step), s2);
        proc(r + 3 * step, s3);
        if (r + 4 * step > last) break;
    }
#undef RP_CL
}
struct Gain4 { f32x4 g[4]; };
__device__ __forceinline__ Gain4 ld_gain(const float* g, int lane) { Gain4 r;
#pragma unroll
    for (int j = 0; j < 4; ++j) r.g[j] = *((const GAS f32x4*)g + lane + 64 * j);
    return r; }
struct RawRow { v2u a[4]; };
__device__ __forceinline__ void ld_raw(const bf16* row, RawRow& r, int lane) {
    const GAS v2u* r8 = (const GAS v2u*)row + lane;
#pragma unroll
    for (int j = 0; j < 4; ++j) r.a[j] = r8[64 * j];
}
__device__ __forceinline__ void unpack_raw(const RawRow& r, f32x4 (&v)[4]) {
#pragma unroll
    for (int j = 0; j < 4; ++j) v[j] = (f32x4){bf_lo(r.a[j].x), bf_hi(r.a[j].x), bf_lo(r.a[j].y), bf_hi(r.a[j].y)};
}
__device__ __forceinline__ void load_bf16_row(const bf16* row, f32x4 (&v)[4], int lane) {
    const GAS v2u* r8 = (const GAS v2u*)row + lane;
#pragma unroll
    for (int j = 0; j < 4; ++j) { const v2u w = r8[64 * j]; v[j] = (f32x4){bf_lo(w.x), bf_hi(w.x), bf_lo(w.y), bf_hi(w.y)}; }
}
namespace att {
constexpr int KSLOT = 16384, VRING = 4 * KSLOT, RING = 8 * KSLOT;
static_assert(RING <= LDSCTL_OFF, "attention LDS");
__device__ __forceinline__ int crow(int r, int hi) { return (r & 3) + 8 * (r >> 2) + 4 * hi; }
typedef float f32x4_t __attribute__((ext_vector_type(4)));
__device__ __forceinline__ float max3f(float a, float b, float c) { float r; asm("v_max3_f32 %0, %1, %2, %3" : "=v"(r) : "v"(a), "v"(b), "v"(c)); return r; }
__device__ __forceinline__ void glds16(const void* gsrc, unsigned lds_dst) { unsigned keep; lds_dst = (unsigned)__builtin_amdgcn_readfirstlane((int)lds_dst);

    asm volatile("s_mov_b32 %0, m0\n\ts_mov_b32 m0, %2\n\ts_nop 0\n\tglobal_load_lds_dwordx4 %1, off\n\ts_mov_b32 m0, %0" : "=&s"(keep) : "v"(gsrc), "s"(lds_dst) : "memory"); }
__device__ __forceinline__ void dma_block(const bf16* K, const bf16* V, size_t rowbase  , int dsh, int h, LAS unsigned char* lds, int blk, int wid, int lane) {
    const unsigned sb = (unsigned)__builtin_amdgcn_readfirstlane((int)(unsigned)(uintptr_t)lds) + (unsigned)(blk & 3) * KSLOT;
#pragma unroll
    for (int i = 0; i < 2; ++i) { const int p = 2 * wid + i; const int key = 8 * p + (lane >> 3), ch = (lane & 7) ^ ((lane >> 3) & 7);
        const size_t eo = (rowbase + ((size_t)key << dsh)) * AW + h * HD + 8 * ch;
        glds16(K + eo, sb + p * 1024); glds16(V + eo, sb + VRING + p * 1024); }
}
__device__ __forceinline__ void item(int idx, const bf16* Q, const bf16* K, const bf16* V, bf16* O, float* LSE, LAS unsigned char* lds) {
    int tid = threadIdx.x; asm volatile("" : "+v"(tid));
    const int lane = tid & 63, wid = __builtin_amdgcn_readfirstlane(tid >> 6), r16 = lane & 15, g4 = lane >> 4;
    int br, b, h, g, n0, nblk;
    if (idx < 256) { br = 0; b = idx >> 6; h = (idx >> 3) & 7; g = 0; n0 = 8 * (idx & 7); nblk = 8; }
    else if (idx < 512) { const int j = idx - 256; br = 1; b = j >> 6; h = (j >> 3) & 7; g = (j & 7) >> 1; n0 = 8 * (j & 1); nblk = 8; }
    else { const int j = idx - 512; br = 2; b = j >> 7; h = (j >> 4) & 7; g = j & 15; n0 = 0; nblk = 4; }
    const int dsh = 2 * br;
    const size_t seq0 = (size_t)b * SEQ + g;
    const int nend = n0 + nblk;
    if (n0 > 0) dma_block(K, V, seq0 + ((size_t)(128 * (n0 - 1)) << dsh), dsh, h, lds, n0 - 1, wid, lane);
    else {
#pragma unroll
        for (int i = 0; i < 2; ++i) { *(LAS v4u*)(lds + 3 * KSLOT + tid * 16 + i * 8192) = (v4u){0u, 0u, 0u, 0u}; *(LAS v4u*)(lds + VRING + 3 * KSLOT + tid * 16 + i * 8192) = (v4u){0u, 0u, 0u, 0u}; }
    }
    dma_block(K, V, seq0 + ((size_t)(128 * n0) << dsh), dsh, h, lds, n0, wid, lane);
    dma_block(K, V, seq0 + ((size_t)(128 * (n0 + 1)) << dsh), dsh, h, lds, n0 + 1, wid, lane);
    const int qi = 16 * wid + r16;
    bf16x8 qf[2];
    { const size_t rowq = seq0 + ((size_t)(128 * n0 + qi) << dsh);
#pragma unroll
      for (int ks = 0; ks < 2; ++ks) qf[ks] = *(const GAS bf16x8*)(Q + rowq * AW + h * HD + 32 * ks + 8 * g4); }
    asm volatile("s_waitcnt vmcnt(0) lgkmcnt(0)\n\ts_barrier" ::: "memory");
    int kl[2], vl[4];
#pragma unroll
    for (int ks = 0; ks < 2; ++ks) kl[ks] = r16 * 128 + 16 * ((4 * ks + g4) ^ (r16 & 7));
#pragma unroll
    for (int dt = 0; dt < 4; ++dt) vl[dt] = VRING + (4 * g4 + (r16 >> 2)) * 128 + (((2 * dt + ((r16 & 3) >> 1)) ^ ((4 * g4 + (r16 >> 2)) & 7)) * 16) + (r16 & 1) * 8;
#define ATT_STEP(n, SPH, QC0, QC1, QX0, QX1) do { \
        const bool more = ((n) + 1 < nend), more2 = ((n) + 2 < nend); \
        { const bf16* qp = Q + (seq0 + ((size_t)(128 * ((n) + (more ? 1 : 0)) + qi) << dsh)) * AW + h * HD + 8 * g4; \
          asm volatile("global_load_dwordx4 %0, %2, off\n\tglobal_load_dwordx4 %1, %2, off offset:64" : "=&v"(QX0), "=&v"(QX1) : "v"(qp) : "memory"); } \
        if (more2) dma_block(K, V, seq0 + ((size_t)(128 * ((n) + 2)) << dsh), dsh, h, lds, (n) + 2, wid, lane); \
          \
        const int wbase = 128 * (SPH) + 16 * wid; \
        f32x4_t sc[9]; bf16x8 kf[9][2]; \
        _Pragma("unroll") \
        for (int j = 0; j < 9; ++j) { \
        _Pragma("unroll") \
            for (int ks = 0; ks < 2; ++ks) kf[j][ks] = ((SPH) < 3) ? *(const LAS bf16x8*)(lds + kbs[ks] + (128 * (SPH) + 16 * j) * 128) : *(const LAS bf16x8*)(lds + ((wbase + 16 * j) & 511) * 128 + kl[ks]); } \
        __builtin_amdgcn_sched_barrier(0); \
        _Pragma("unroll") \
        for (int j = 0; j < 9; ++j) sc[j] = __builtin_amdgcn_mfma_f32_16x16x32_bf16(kf[j][0], QC0, (f32x4_t){0.f, 0.f, 0.f, 0.f}, 0, 0, 0);     \
        _Pragma("unroll") \
        for (int j = 0; j < 9; ++j) sc[j] = __builtin_amdgcn_mfma_f32_16x16x32_bf16(kf[j][1], QC1, sc[j], 0, 0, 0); \
        __builtin_amdgcn_sched_barrier(0); \
        if ((n) == 0) {                                                  \
        _Pragma("unroll") \
            for (int j = 0; j < 8; ++j) if (wid + j < 8) sc[j] = (f32x4_t){-1e30f, -1e30f, -1e30f, -1e30f}; } \
        _Pragma("unroll") \
        for (int r = 0; r < 4; ++r) { if (4 * g4 + r < r16) sc[0][r] = -1e30f; if (4 * g4 + r > r16) sc[8][r] = -1e30f; }     \
        float mx = -1e30f; \
        _Pragma("unroll") \
        for (int j = 0; j < 9; ++j) { mx = max3f(mx, sc[j][0], sc[j][1]); mx = max3f(mx, sc[j][2], sc[j][3]); } \
        mx = max3f(mx, __shfl_xor(mx, 16), mx); mx = max3f(mx, __shfl_xor(mx, 32), mx); \
        float l = 0.f; \
        _Pragma("unroll") \
        for (int j = 0; j < 9; ++j) \
        _Pragma("unroll") \
            for (int r = 0; r < 4; ++r) { const float e = __builtin_amdgcn_exp2f(sc[j][r] - mx); sc[j][r] = e; l += e; } \
        l += __shfl_xor(l, 16); l += __shfl_xor(l, 32); \
        f32x4_t o[4]; \
        v4i16_t vlo[5][4], vh8[5][4]; bf16x8 pf[5]; \
        _Pragma("unroll") \
        for (int kk = 0; kk < 5; ++kk) { \
        _Pragma("unroll") \
            for (int dt = 0; dt < 4; ++dt) { \
                if ((SPH) < 3) { vlo[kk][dt] = __builtin_amdgcn_ds_read_tr16_b64_v4i16((LAS v4i16_t*)(lds + vbs[dt] + (128 * (SPH) + 32 * kk) * 128)); \
                                 vh8[kk][dt] = __builtin_amdgcn_ds_read_tr16_b64_v4i16((LAS v4i16_t*)(lds + vbs[dt] + (128 * (SPH) + 32 * kk + (kk < 4 ? 16 : 0)) * 128)); } \
                else { LAS unsigned char* va = lds + ((wbase + 32 * kk) & 511) * 128; \
                       LAS unsigned char* vb = (kk < 4) ? lds + ((wbase + 32 * kk + 16) & 511) * 128 : va;         \
                       vlo[kk][dt] = __builtin_amdgcn_ds_read_tr16_b64_v4i16((LAS v4i16_t*)(va + vl[dt])); vh8[kk][dt] = __builtin_amdgcn_ds_read_tr16_b64_v4i16((LAS v4i16_t*)(vb + vl[dt])); } } \
            v4u pw; pw.x = pk2(sc[2 * kk][0], sc[2 * kk][1]); pw.y = pk2(sc[2 * kk][2], sc[2 * kk][3]); \
            if (kk < 4) { pw.z = pk2(sc[2 * kk + 1][0], sc[2 * kk + 1][1]); pw.w = pk2(sc[2 * kk + 1][2], sc[2 * kk + 1][3]); } else { pw.z = 0u; pw.w = 0u; } \
            pf[kk] = __builtin_bit_cast(bf16x8, pw); } \
        __builtin_amdgcn_sched_barrier(0); \
        _Pragma("unroll") \
        for (int kk = 0; kk < 5; ++kk) \
        _Pragma("unroll") \
            for (int dt = 0; dt < 4; ++dt) { const bf16x8 vf = (bf16x8){vlo[kk][dt][0], vlo[kk][dt][1], vlo[kk][dt][2], vlo[kk][dt][3], vh8[kk][dt][0], vh8[kk][dt][1], vh8[kk][dt][2], vh8[kk][dt][3]}; \
                o[dt] = (kk == 0) ? __builtin_amdgcn_mfma_f32_16x16x32_bf16(vf, pf[kk], (f32x4_t){0.f, 0.f, 0.f, 0.f}, 0, 0, 0) : __builtin_amdgcn_mfma_f32_16x16x32_bf16(vf, pf[kk], o[dt], 0, 0, 0); } \
        __builtin_amdgcn_sched_barrier(0); \
        if (more2) asm volatile("s_waitcnt vmcnt(4)" ::: "memory");     \
        else asm volatile("s_waitcnt vmcnt(0)" ::: "memory"); \
        const float inv = __builtin_amdgcn_rcpf(l); \
        const size_t rowq = seq0 + ((size_t)(128 * (n) + qi) << dsh); \
        bf16* orow = O + ((size_t)br * T + rowq) * AW + h * HD; \
        _Pragma("unroll") \
        for (int dt = 0; dt < 4; ++dt) { v2u w; w.x = pk2(o[dt][0] * inv, o[dt][1] * inv); w.y = pk2(o[dt][2] * inv, o[dt][3] * inv); *(GAS v2u*)(orow + 16 * dt + 4 * g4) = w; } \
        if (g4 == 0) LSE[((size_t)br * T + rowq) * NH + h] = mx + __builtin_amdgcn_logf(l); \
        asm volatile("s_waitcnt lgkmcnt(0)\n\ts_barrier" ::: "memory"); } while (0)
    int kbs[2], vbs[4];
#pragma unroll
    for (int ks = 0; ks < 2; ++ks) kbs[ks] = kl[ks] + 16 * wid * 128;
#pragma unroll
    for (int dt = 0; dt < 4; ++dt) vbs[dt] = vl[dt] + 16 * wid * 128;
    bf16x8 qb0, qb1;
    for (int n4 = n0; n4 < nend; n4 += 4) { ATT_STEP(n4, 3, qf[0], qf[1], qb0, qb1); ATT_STEP(n4 + 1, 0, qb0, qb1, qf[0], qf[1]); ATT_STEP(n4 + 2, 1, qf[0], qf[1], qb0, qb1); ATT_STEP(n4 + 3, 2, qb0, qb1, qf[0], qf[1]); }
#undef ATT_STEP
}
}

namespace lru {
constexpr int USTR = 144, U_BYTES = 67 * USTR, C_BYTES = 64 * USTR, W_BYTES = U_BYTES + C_BYTES;
constexpr int OFF_SSQ = 8 * W_BYTES, OFF_CAR = OFF_SSQ + 8 * 64 * 4, OFF_RSL = OFF_CAR + 512 * 4, LDS_END = OFF_RSL + 64 * 4;
static_assert(W_BYTES % 16 == 0 && LDS_END <= LDSCTL_OFF, "lru LDS");
__device__ __forceinline__ float sigmoid_f(float x) { return __builtin_amdgcn_rcpf(1.f + __builtin_amdgcn_exp2f(-1.4426950408889634f * x)); }
__device__ __forceinline__ float gelu_tanh(float x) { const float t = __builtin_fmaf(-0.10294323972f, x * x, -2.30220819813f); return x * __builtin_amdgcn_rcpf(1.f + __builtin_amdgcn_exp2f(x * t)); }
__device__ __forceinline__ float bf2f(unsigned short h) { return __builtin_bit_cast(float, (unsigned)h << 16); }
__device__ __forceinline__ f32x2 pair_xy(float v) { const float o = __shfl_xor(v, 32); const bool up = (threadIdx.x & 32) != 0; return (f32x2){up ? o : v, up ? v : o}; }
struct LruConst { bf16x8 fr[16]; float w0, w1, w2, w3, cb, brv[2], biv[2], ccv[2]; };
__device__ __forceinline__ void load_const(int layer, const bf16* WFR, const float* conv_w, const float* conv_b, const float* b_r, const float* b_i, const float* lam, LruConst& k) {
    int tid = threadIdx.x; asm volatile("" : "+v"(tid));
    const int lane = tid & 63, wid = __builtin_amdgcn_readfirstlane(tid >> 6), r32 = lane & 31;
    const GAS bf16x8* wfr = (const GAS bf16x8*)(WFR + ((size_t)(layer * 8 + wid) * 16) * 512) + lane;
#pragma unroll
    for (int i = 0; i < 16; ++i) k.fr[i] = wfr[i * 64];
    const int gch = layer * LW + wid * 64 + lane;
    k.w0 = conv_w[layer * 4 * LW + 0 * LW + wid * 64 + lane]; k.w1 = conv_w[layer * 4 * LW + 1 * LW + wid * 64 + lane]; k.w2 = conv_w[layer * 4 * LW + 2 * LW + wid * 64 + lane]; k.w3 = conv_w[layer * 4 * LW + 3 * LW + wid * 64 + lane];
    k.cb = conv_b[gch];
#pragma unroll
    for (int nb = 0; nb < 2; ++nb) { const int ch = wid * 64 + 32 * nb + r32; k.brv[nb] = -1.4426950408889634f * b_r[layer * LW + ch]; k.biv[nb] = -1.4426950408889634f * b_i[layer * LW + ch];
        k.ccv[nb] = lam[layer * LW + ch]; }
}
struct URegs { v4u uv[9]; };
__device__ __forceinline__ void u_load(int cu, const bf16* U, URegs& q) {
    int tid = threadIdx.x; asm volatile("" : "+v"(tid));
    const int lane = tid & 63, wid = __builtin_amdgcn_readfirstlane(tid >> 6);
    const int b = cu >> 7, t0 = 64 * (cu & 127);
#pragma unroll
    for (int j = 0; j < 9; ++j) { const int i = lane + 64 * j, r = i >> 3, ch = i & 7; int t = t0 - 3 + r; t = t < 0 ? 0 : (t > SEQ - 1 ? SEQ - 1 : t);
        q.uv[j] = *(const GAS v4u*)(U + ((size_t)b * SEQ + t) * LW + wid * 64 + ch * 8); }
    __builtin_amdgcn_sched_barrier(0);
}
__device__ __forceinline__ void local_unit(int cu, int layer, const LruConst& kc, const URegs& uq, const bf16* Gt, f32x2* SUM, unsigned* cnt, const float* gout, bf16* MIX, LAS unsigned char* lds) {
    int tid = threadIdx.x; asm volatile("" : "+v"(tid));
    const int lane = tid & 63, wid = __builtin_amdgcn_readfirstlane(tid >> 6), r32 = lane & 31, hi = lane >> 5;
    const int b = cu >> 7, c = cu & 127, t0 = 64 * c;
    const size_t row0 = (size_t)b * SEQ + t0;
    LAS unsigned char* ul = lds + wid * W_BYTES; LAS unsigned char* cl = ul + U_BYTES;
    {
#pragma unroll
      for (int j = 0; j < 9; ++j) { const int i = lane + 64 * j, r = i >> 3, ch = i & 7; const int t = t0 - 3 + r;
          *(LAS v4u*)(ul + r * USTR + ch * 16) = (t >= 0) ? uq.uv[j] : (v4u){0u, 0u, 0u, 0u}; } }
    {
        const float w0 = kc.w0, w1 = kc.w1, w2 = kc.w2, w3 = kc.w3, cb = kc.cb;
        float u0 = bf2f(*(const LAS unsigned short*)(ul + 0 * USTR + 2 * lane)), u1 = bf2f(*(const LAS unsigned short*)(ul + 1 * USTR + 2 * lane)), u2 = bf2f(*(const LAS unsigned short*)(ul + 2 * USTR + 2 * lane));
#pragma unroll 16
        for (int t = 0; t < 64; ++t) { const float u3 = bf2f(*(const LAS unsigned short*)(ul + (t + 3) * USTR + 2 * lane));
            const float y = cb + w0 * u0 + w1 * u1 + w2 * u2 + w3 * u3;
            *(LAS unsigned short*)(cl + t * USTR + 2 * lane) = (unsigned short)pk2(y, 0.f);
            u0 = u1; u1 = u2; u2 = u3; }
    }
    float brv[2], biv[2], ccv[2], hrun[2], ptot[2];
#pragma unroll
    for (int nb = 0; nb < 2; ++nb) { brv[nb] = kc.brv[nb]; biv[nb] = kc.biv[nb]; ccv[nb] = kc.ccv[nb]; hrun[nb] = 0.f; ptot[nb] = 1.f; }
    asm volatile("s_waitcnt lgkmcnt(0)" ::: "memory");
#pragma unroll
    for (int tt = 0; tt < 2; ++tt) {
        bf16x8 ucf[4];
#pragma unroll
        for (int s = 0; s < 4; ++s) ucf[s] = *(const LAS bf16x8*)(cl + (32 * tt + r32) * USTR + (16 * s + 8 * hi) * 2);
#pragma unroll
        for (int nb = 0; nb < 2; ++nb) {
            f32x16 aR, aI;
#pragma unroll
            for (int r = 0; r < 16; ++r) { aR[r] = 0.f; aI[r] = 0.f; }
#pragma unroll
            for (int s = 0; s < 4; ++s) { const bf16x8 fr_ = kc.fr[(0 * 2 + nb) * 4 + s], fi_ = kc.fr[(1 * 2 + nb) * 4 + s];
                aR = __builtin_amdgcn_mfma_f32_32x32x16_bf16(ucf[s], fr_, aR, 0, 0, 0); aI = __builtin_amdgcn_mfma_f32_32x32x16_bf16(ucf[s], fi_, aI, 0, 0, 0); }
#pragma unroll
            for (int q = 0; q < 4; ++q) {
                float a4[4], b4[4];
#pragma unroll
                for (int k = 0; k < 4; ++k) { const int r = 4 * q + k, tl = 32 * tt + 8 * q + 4 * hi + k;
                    const float ucv = bf2f(*(const LAS unsigned short*)(cl + tl * USTR + 2 * (32 * nb + r32)));
                    const float rg = __builtin_amdgcn_rcpf(1.f + __builtin_amdgcn_exp2f(aR[r] + brv[nb])), ig = __builtin_amdgcn_rcpf(1.f + __builtin_amdgcn_exp2f(aI[r] + biv[nb]));
                    const float A = __builtin_amdgcn_exp2f(ccv[nb] * rg);
                    a4[k] = A; b4[k] = __builtin_amdgcn_sqrtf(fmaxf(1.f - A * A, 0.f)) * ig * ucv; }
                const float Ag = (a4[0] * a4[1]) * (a4[2] * a4[3]);
                const float Bg = ((b4[0] * a4[1] + b4[1]) * a4[2] + b4[2]) * a4[3] + b4[3];
                const f32x2 Ax = pair_xy(Ag), Bx = pair_xy(Bg);
                const float hA = Ax.x * hrun[nb] + Bx.x, hB = Ax.y * hA + Bx.y;
                float h = hi ? hA : hrun[nb];
                float p = hi ? ptot[nb] * Ax.x : ptot[nb];
                hrun[nb] = hB; ptot[nb] *= Ax.x * Ax.y;
#pragma unroll
                for (int k = 0; k < 4; ++k) { const int tl = 32 * tt + 8 * q + 4 * hi + k;
                    h = a4[k] * h + b4[k]; p = a4[k] * p;
                    *(LAS unsigned short*)(cl + tl * USTR + 2 * (32 * nb + r32)) = (unsigned short)pk2(h, 0.f);
                    *(LAS unsigned short*)(ul + tl * USTR + 2 * (32 * nb + r32)) = (unsigned short)pk2(p, 0.f); }
                __builtin_amdgcn_sched_barrier(0);
            }
        }
    }
    if (hi == 0) {
#pragma unroll
        for (int nb = 0; nb < 2; ++nb) { const f32x2 sv = (f32x2){ptot[nb], hrun[nb]};
            __hip_atomic_store((unsigned long long*)(SUM + ((size_t)b * 128 + c) * 512 + wid * 64 + 32 * nb + r32), __builtin_bit_cast(unsigned long long, sv), __ATOMIC_RELAXED, __HIP_MEMORY_SCOPE_AGENT); }
    }
    asm volatile("s_waitcnt vmcnt(0) lgkmcnt(0)" ::: "memory");
    const int ch8 = lane & 7;
    v4u gg[8];
#pragma unroll
    for (int i = 0; i < 8; ++i) gg[i] = *(const GAS v4u*)(Gt + (row0 + 8 * i + (lane >> 3)) * LW + wid * 64 + 8 * ch8);
    const f32x4 g0 = *(const GAS f32x4*)(gout + layer * LW + wid * 64 + 8 * ch8), g1 = *(const GAS f32x4*)(gout + layer * LW + wid * 64 + 8 * ch8 + 4);
    __syncthreads();
    if (tid == 0) {
        (void)__hip_atomic_fetch_add(cnt, 1u, __ATOMIC_RELAXED, __HIP_MEMORY_SCOPE_AGENT);
        unsigned sp = 0;
        while (__hip_atomic_load(cnt, __ATOMIC_RELAXED, __HIP_MEMORY_SCOPE_AGENT) < 128u) { __builtin_amdgcn_s_sleep(2); if (++sp > (1u << 20)) break; }
        __builtin_amdgcn_fence(__ATOMIC_ACQUIRE, "agent");
        asm volatile("s_waitcnt vmcnt(0)" ::: "memory");
    }
    __syncthreads();
    {
        float hc = 0.f; const f32x2* spq = SUM + ((size_t)b * 128) * 512 + tid;
        for (int cc = 0; cc < c; cc += 32) { f32x2 ab[32];
#pragma unroll
            for (int k = 0; k < 32; ++k) { const int i = cc + k; ab[k] = spq[(size_t)(i < c ? i : 0) * 512]; }
#pragma unroll
            for (int k = 0; k < 32; ++k) { const int i = cc + k; const f32x2 u_ = (i < c) ? ab[k] : (f32x2){1.f, 0.f}; hc = u_.x * hc + u_.y; } }
        ((LAS float*)(lds + OFF_CAR))[tid] = hc;
    }
    __syncthreads();
    {
        LAS float* ssq = (LAS float*)(lds + OFF_SSQ); LAS float* rsl = (LAS float*)(lds + OFF_RSL); const LAS float* car = (const LAS float*)(lds + OFF_CAR);
        const f32x4 c0 = *(const LAS f32x4*)(car + wid * 64 + 8 * ch8), c1 = *(const LAS f32x4*)(car + wid * 64 + 8 * ch8 + 4);
        float rec[8][8];
#pragma unroll
        for (int i = 0; i < 8; ++i) { const int tk = 8 * i + (lane >> 3); float s = 0.f;
            const v4u hl = *(const LAS v4u*)(cl + tk * USTR + ch8 * 16), pc = *(const LAS v4u*)(ul + tk * USTR + ch8 * 16);
#pragma unroll
            for (int e = 0; e < 4; ++e) { const float ca = (e == 0) ? c0.x : (e == 1) ? c0.z : (e == 2) ? c1.x : c1.z, cb_ = (e == 0) ? c0.y : (e == 1) ? c0.w : (e == 2) ? c1.y : c1.w;
                const float h0 = bf_lo(hl[e]) + bf_lo(pc[e]) * ca, h1 = bf_hi(hl[e]) + bf_hi(pc[e]) * cb_;
                const float r0 = gelu_tanh(bf_lo(gg[i][e])) * h0, r1 = gelu_tanh(bf_hi(gg[i][e])) * h1;
                rec[i][2 * e] = r0; rec[i][2 * e + 1] = r1; s += r0 * r0 + r1 * r1; }
            s = DPP_ADD(s, 0xB1); s = DPP_ADD(s, 0x4E); s = DPP_ADD(s, 0x141);
            if (ch8 == 0) ssq[wid * 64 + tk] = s; }
        __syncthreads();
        if (tid < 64) { float s = 0.f;
#pragma unroll
            for (int w = 0; w < 8; ++w) s += ssq[w * 64 + tid];
            rsl[tid] = __builtin_amdgcn_rsqf(s * (1.f / LW) + RMS_EPS); }
        __syncthreads();
#pragma unroll
        for (int i = 0; i < 8; ++i) { const int tk = 8 * i + (lane >> 3); const float rs = rsl[tk];
            v4u o; o.x = pk2(rec[i][0] * rs * g0.x, rec[i][1] * rs * g0.y); o.y = pk2(rec[i][2] * rs * g0.z, rec[i][3] * rs * g0.w);
            o.z = pk2(rec[i][4] * rs * g1.x, rec[i][5] * rs * g1.y); o.w = pk2(rec[i][6] * rs * g1.z, rec[i][7] * rs * g1.w);
            *(GAS v4u*)(MIX + (row0 + tk) * D + AW + wid * 64 + 8 * ch8) = o; }
    }
    __syncthreads();
}
constexpr int OFF_CARA = 8 * 64 * 4, OFF_CARB = OFF_CARA + 512 * 4 + 64 * 4;
__device__ __forceinline__ void carry2(int cuA, int cuB, const f32x2* SUM, LAS unsigned char* lds) {
    int tid = threadIdx.x; asm volatile("" : "+v"(tid));
    const int cA = cuA & 127, cB = (cuB >= 0) ? (cuB & 127) : 0, cmax = cA > cB ? cA : cB;
    const f32x2* spA = SUM + ((size_t)(cuA >> 7) * 128) * 512 + tid; const f32x2* spB = SUM + ((size_t)((cuB >= 0 ? cuB : cuA) >> 7) * 128) * 512 + tid;
    float hA = 0.f, hB = 0.f;
    for (int cc = 0; cc < cmax; cc += 32) { f32x2 a[32], b[32];
#pragma unroll
        for (int k = 0; k < 32; ++k) { const int i = cc + k; a[k] = spA[(size_t)(i < cA ? i : 0) * 512]; b[k] = spB[(size_t)(i < cB ? i : 0) * 512]; }
#pragma unroll
        for (int k = 0; k < 32; ++k) { const int i = cc + k; const f32x2 ua = (i < cA) ? a[k] : (f32x2){1.f, 0.f}, ub = (i < cB) ? b[k] : (f32x2){1.f, 0.f};
            hA = ua.x * hA + ua.y; hB = ub.x * hB + ub.y; } }
    ((LAS float*)(lds + OFF_CARA))[tid] = hA; ((LAS float*)(lds + OFF_CARB))[tid] = hB;
}
struct FinRegs { v4u hl[8], pc[8], gg[8]; f32x4 g0, g1; };
__device__ __forceinline__ void finish_load(int cu, int layer, const bf16* HL, const bf16* PC, const bf16* Gt, const float* gout, FinRegs& q) {
    int tid = threadIdx.x; asm volatile("" : "+v"(tid));
    const int lane = tid & 63, wid = __builtin_amdgcn_readfirstlane(tid >> 6), ch8 = lane & 7;
    const size_t row0 = (size_t)(cu >> 7) * SEQ + 64 * (cu & 127);
#pragma unroll
    for (int i = 0; i < 8; ++i) { const size_t e = (row0 + 8 * i + (lane >> 3)) * LW + wid * 64 + 8 * ch8;
        q.hl[i] = *(const GAS v4u*)(HL + e); q.pc[i] = *(const GAS v4u*)(PC + e); q.gg[i] = *(const GAS v4u*)(Gt + e); }
    q.g0 = *(const GAS f32x4*)(gout + layer * LW + wid * 64 + 8 * ch8); q.g1 = *(const GAS f32x4*)(gout + layer * LW + wid * 64 + 8 * ch8 + 4);
    __builtin_amdgcn_sched_barrier(0);
}
__device__ __forceinline__ void finish_unit(int cu, int layer, const FinRegs& q, const LAS float* car, const float* gout, bf16* MIX, LAS unsigned char* lds) {
    int tid = threadIdx.x; asm volatile("" : "+v"(tid));
    const int lane = tid & 63, wid = __builtin_amdgcn_readfirstlane(tid >> 6), ch8 = lane & 7;
    const int b = cu >> 7, c = cu & 127;
    const size_t row0 = (size_t)b * SEQ + 64 * c;
    LAS float* ssq = (LAS float*)lds; LAS float* rsl = ssq + 8 * 64 + 512;
    const v4u (&hl)[8] = q.hl; const v4u (&pc)[8] = q.pc; const v4u (&gg)[8] = q.gg;
    const f32x4 c0 = *(const LAS f32x4*)(car + wid * 64 + 8 * ch8), c1 = *(const LAS f32x4*)(car + wid * 64 + 8 * ch8 + 4);
    float rec[8][8];
#pragma unroll
    for (int i = 0; i < 8; ++i) { float s = 0.f;
#pragma unroll
        for (int e = 0; e < 4; ++e) { const float ca = (e == 0) ? c0.x : (e == 1) ? c0.z : (e == 2) ? c1.x : c1.z, cb_ = (e == 0) ? c0.y : (e == 1) ? c0.w : (e == 2) ? c1.y : c1.w;
            const float h0 = bf_lo(hl[i][e]) + bf_lo(pc[i][e]) * ca, h1 = bf_hi(hl[i][e]) + bf_hi(pc[i][e]) * cb_;
            const float r0 = gelu_tanh(bf_lo(gg[i][e])) * h0, r1 = gelu_tanh(bf_hi(gg[i][e])) * h1;
            rec[i][2 * e] = r0; rec[i][2 * e + 1] = r1; s += r0 * r0 + r1 * r1; }
        s = DPP_ADD(s, 0xB1); s = DPP_ADD(s, 0x4E); s = DPP_ADD(s, 0x141);
        if (ch8 == 0) ssq[wid * 64 + 8 * i + (lane >> 3)] = s; }
    __syncthreads();
    if (tid < 64) { float s = 0.f;
#pragma unroll
        for (int w = 0; w < 8; ++w) s += ssq[w * 64 + tid];
        rsl[tid] = __builtin_amdgcn_rsqf(s * (1.f / LW) + RMS_EPS); }
    __syncthreads();
    const f32x4 g0 = q.g0, g1 = q.g1;
#pragma unroll
    for (int i = 0; i < 8; ++i) { const int tk = 8 * i + (lane >> 3); const float rs = rsl[tk];
        v4u o; o.x = pk2(rec[i][0] * rs * g0.x, rec[i][1] * rs * g0.y); o.y = pk2(rec[i][2] * rs * g0.z, rec[i][3] * rs * g0.w);
        o.z = pk2(rec[i][4] * rs * g1.x, rec[i][5] * rs * g1.y); o.w = pk2(rec[i][6] * rs * g1.z, rec[i][7] * rs * g1.w);
        *(GAS v4u*)(MIX + (row0 + tk) * D + AW + wid * 64 + 8 * ch8) = o; }
    __syncthreads();
}
}

__device__ __forceinline__ void attn_combine(int cu, int layer, const bf16* OBR, const float* LSE, const float* gain, bf16* MIX) {
    int tid = threadIdx.x; asm volatile("" : "+v"(tid));
    const int lane = tid & 63, wid = __builtin_amdgcn_readfirstlane(tid >> 6), head = lane >> 3;
    const f32x4 g0 = *(const GAS f32x4*)(gain + layer * AW + 8 * lane), g1 = *(const GAS f32x4*)(gain + layer * AW + 8 * lane + 4);
    const size_t rowb = (size_t)(cu >> 7) * SEQ + 64 * (cu & 127) + wid;
#pragma unroll
    for (int bt = 0; bt < 2; ++bt) {
        float l0[4], l1[4], l2[4]; v4u a[4], b[4], d[4];
#pragma unroll
        for (int k = 0; k < 4; ++k) { const size_t row = rowb + 8 * (4 * bt + k);
            l0[k] = LSE[((size_t)0 * T + row) * NH + head]; l1[k] = LSE[((size_t)1 * T + row) * NH + head]; l2[k] = LSE[((size_t)2 * T + row) * NH + head];
            a[k] = *(const GAS v4u*)(OBR + ((size_t)0 * T + row) * AW + 8 * lane); b[k] = *(const GAS v4u*)(OBR + ((size_t)1 * T + row) * AW + 8 * lane); d[k] = *(const GAS v4u*)(OBR + ((size_t)2 * T + row) * AW + 8 * lane); }
        __builtin_amdgcn_sched_barrier(0);
#pragma unroll
        for (int k = 0; k < 4; ++k) { const size_t row = rowb + 8 * (4 * bt + k);
            const float mx = fmaxf(l0[k], fmaxf(l1[k], l2[k]));
            float w0 = __builtin_amdgcn_exp2f(l0[k] - mx), w1 = __builtin_amdgcn_exp2f(l1[k] - mx), w2 = __builtin_amdgcn_exp2f(l2[k] - mx);
            const float iw = __builtin_amdgcn_rcpf(w0 + w1 + w2); w0 *= iw; w1 *= iw; w2 *= iw;
            float acc[8]; float ss = 0.f;
#pragma unroll
            for (int e = 0; e < 4; ++e) { const float lo = w0 * bf_lo(a[k][e]) + w1 * bf_lo(b[k][e]) + w2 * bf_lo(d[k][e]), hh = w0 * bf_hi(a[k][e]) + w1 * bf_hi(b[k][e]) + w2 * bf_hi(d[k][e]);
                acc[2 * e] = lo; acc[2 * e + 1] = hh; ss += lo * lo + hh * hh; }
            const float rstd = __builtin_amdgcn_rsqf(wave_sum(ss) * (1.f / AW) + RMS_EPS);
            v4u w; w.x = pk2(acc[0] * rstd * g0.x, acc[1] * rstd * g0.y); w.y = pk2(acc[2] * rstd * g0.z, acc[3] * rstd * g0.w);
            w.z = pk2(acc[4] * rstd * g1.x, acc[5] * rstd * g1.y); w.w = pk2(acc[6] * rstd * g1.z, acc[7] * rstd * g1.w);
            *(GAS v4u*)(MIX + row * D + 8 * lane) = w; }
    }
}

__device__ __forceinline__ void mix_unit(int cu, int layer, const bf16* OBR, const float* LSE, const float* again, const bf16* HL, const bf16* PC, const bf16* Gt, const LAS float* car, const float* lgain, bf16* MIX) {
    int tid = threadIdx.x; asm volatile("" : "+v"(tid));
    const int lane = tid & 63, wid = __builtin_amdgcn_readfirstlane(tid >> 6), head = lane >> 3;
    const f32x4 g0 = *(const GAS f32x4*)(again + layer * AW + 8 * lane), g1 = *(const GAS f32x4*)(again + layer * AW + 8 * lane + 4);
    const f32x4 h0 = *(const GAS f32x4*)(lgain + layer * LW + 8 * lane), h1 = *(const GAS f32x4*)(lgain + layer * LW + 8 * lane + 4);
    const f32x4 c0 = *(const LAS f32x4*)(car + 8 * lane), c1 = *(const LAS f32x4*)(car + 8 * lane + 4);
    const size_t rowb = (size_t)(cu >> 7) * SEQ + 64 * (cu & 127) + 8 * wid;
#pragma unroll
    for (int bt = 0; bt < 2; ++bt) {
        float l0[4], l1[4], l2[4]; v4u a[4], b[4], d[4], hl[4], pc[4], gg[4];
#pragma unroll
        for (int k = 0; k < 4; ++k) { const size_t row = rowb + 4 * bt + k;
            l0[k] = LSE[((size_t)0 * T + row) * NH + head]; l1[k] = LSE[((size_t)1 * T + row) * NH + head]; l2[k] = LSE[((size_t)2 * T + row) * NH + head];
            a[k] = *(const GAS v4u*)(OBR + ((size_t)0 * T + row) * AW + 8 * lane); b[k] = *(const GAS v4u*)(OBR + ((size_t)1 * T + row) * AW + 8 * lane); d[k] = *(const GAS v4u*)(OBR + ((size_t)2 * T + row) * AW + 8 * lane);
            hl[k] = *(const GAS v4u*)(HL + row * LW + 8 * lane); pc[k] = *(const GAS v4u*)(PC + row * LW + 8 * lane); gg[k] = *(const GAS v4u*)(Gt + row * LW + 8 * lane); }
        __builtin_amdgcn_sched_barrier(0);
#pragma unroll
        for (int k = 0; k < 4; ++k) { const size_t row = rowb + 4 * bt + k;
            const float mx = fmaxf(l0[k], fmaxf(l1[k], l2[k]));
            float w0 = __builtin_amdgcn_exp2f(l0[k] - mx), w1 = __builtin_amdgcn_exp2f(l1[k] - mx), w2 = __builtin_amdgcn_exp2f(l2[k] - mx);
            const float iw = __builtin_amdgcn_rcpf(w0 + w1 + w2); w0 *= iw; w1 *= iw; w2 *= iw;
            float acc[8], rec[8]; float ss = 0.f, s2 = 0.f;
#pragma unroll
            for (int e = 0; e < 4; ++e) { const float lo = w0 * bf_lo(a[k][e]) + w1 * bf_lo(b[k][e]) + w2 * bf_lo(d[k][e]), hh = w0 * bf_hi(a[k][e]) + w1 * bf_hi(b[k][e]) + w2 * bf_hi(d[k][e]);
                acc[2 * e] = lo; acc[2 * e + 1] = hh; ss += lo * lo + hh * hh;
                const float ca = (e == 0) ? c0.x : (e == 1) ? c0.z : (e == 2) ? c1.x : c1.z, cb_ = (e == 0) ? c0.y : (e == 1) ? c0.w : (e == 2) ? c1.y : c1.w;
                const float x0 = bf_lo(hl[k][e]) + bf_lo(pc[k][e]) * ca, x1 = bf_hi(hl[k][e]) + bf_hi(pc[k][e]) * cb_;
                const float r0 = lru::gelu_tanh(bf_lo(gg[k][e])) * x0, r1 = lru::gelu_tanh(bf_hi(gg[k][e])) * x1;
                rec[2 * e] = r0; rec[2 * e + 1] = r1; s2 += r0 * r0 + r1 * r1; }
            const float rstd = __builtin_amdgcn_rsqf(wave_sum(ss) * (1.f / AW) + RMS_EPS), rstd2 = __builtin_amdgcn_rsqf(wave_sum(s2) * (1.f / LW) + RMS_EPS);
            v4u w; w.x = pk2(acc[0] * rstd * g0.x, acc[1] * rstd * g0.y); w.y = pk2(acc[2] * rstd * g0.z, acc[3] * rstd * g0.w);
            w.z = pk2(acc[4] * rstd * g1.x, acc[5] * rstd * g1.y); w.w = pk2(acc[6] * rstd * g1.z, acc[7] * rstd * g1.w);
            *(GAS v4u*)(MIX + row * D + 8 * lane) = w;
            v4u o; o.x = pk2(rec[0] * rstd2 * h0.x, rec[1] * rstd2 * h0.y); o.y = pk2(rec[2] * rstd2 * h0.z, rec[3] * rstd2 * h0.w);
            o.z = pk2(rec[4] * rstd2 * h1.x, rec[5] * rstd2 * h1.y); o.w = pk2(rec[6] * rstd2 * h1.z, rec[7] * rstd2 * h1.w);
            *(GAS v4u*)(MIX + row * D + AW + 8 * lane) = o; }
    }
}
__device__ __forceinline__ void post_mix_row(const RawRow& mraw, const RawRow& xraw, bf16* xout, const Gain4& gpost, const Gain4& gpre2, bf16* hrow, unsigned char* h8row, float* rstd_out, f32x4 (&hn)[4], int lane) {
    f32x4 m[4], xv[4]; unpack_raw(mraw, m); unpack_raw(xraw, xv);
    float s = 0.f;
#pragma unroll
    for (int j = 0; j < 4; ++j) s += (m[j].x * m[j].x + m[j].y * m[j].y) + (m[j].z * m[j].z + m[j].w * m[j].w);
    const float rstd = __builtin_amdgcn_rsqf(wave_sum(s) * (1.f / D) + RMS_EPS);
    float s2 = 0.f;
    GAS unsigned long long* x8 = (GAS unsigned long long*)xout + lane;
#pragma unroll
    for (int j = 0; j < 4; ++j) { const f32x4 gg = gpost.g[j];
        f32x4 y; y.x = xv[j].x + m[j].x * rstd * gg.x; y.y = xv[j].y + m[j].y * rstd * gg.y; y.z = xv[j].z + m[j].z * rstd * gg.z; y.w = xv[j].w + m[j].w * rstd * gg.w;
        x8[64 * j] = (unsigned long long)pk2(y.x, y.y) | ((unsigned long long)pk2(y.z, y.w) << 32); hn[j] = y; s2 += (y.x * y.x + y.y * y.y) + (y.z * y.z + y.w * y.w); }
    const float rstd2 = __builtin_amdgcn_rsqf(wave_sum(s2) * (1.f / D) + RMS_EPS);
    if (rstd_out && lane == 0) *rstd_out = rstd2;
    GAS unsigned long long* o8 = (GAS unsigned long long*)hrow + lane;
#pragma unroll
    for (int j = 0; j < 4; ++j) { const f32x4 gg = gpre2.g[j];
        hn[j].x *= rstd2 * gg.x; hn[j].y *= rstd2 * gg.y; hn[j].z *= rstd2 * gg.z; hn[j].w *= rstd2 * gg.w;
        if (hrow) o8[64 * j] = (unsigned long long)pk2(hn[j].x, hn[j].y) | ((unsigned long long)pk2(hn[j].z, hn[j].w) << 32);
        if (h8row) *((GAS unsigned*)h8row + lane + 64 * j) = pg8::pk4_fp8(hn[j].x, hn[j].y, hn[j].z, hn[j].w); }
}
__device__ __forceinline__ void post_ffn_row(f32x4 (&f)[4], const RawRow& xraw, bf16* xout, float* orow32, const Gain4& gpost, const float* gnext, bf16* hrow, float* rstd_out, int lane) {
    f32x4 xv[4]; unpack_raw(xraw, xv);
    float s = 0.f;
#pragma unroll
    for (int j = 0; j < 4; ++j) s += (f[j].x * f[j].x + f[j].y * f[j].y) + (f[j].z * f[j].z + f[j].w * f[j].w);
    const float rstd = __builtin_amdgcn_rsqf(wave_sum(s) * (1.f / D) + RMS_EPS);
    f32x4 y[4];
    GAS unsigned long long* x8 = (GAS unsigned long long*)xout + lane;
#pragma unroll
    for (int j = 0; j < 4; ++j) { const f32x4 gg = gpost.g[j];
        y[j].x = xv[j].x + f[j].x * rstd * gg.x; y[j].y = xv[j].y + f[j].y * rstd * gg.y; y[j].z = xv[j].z + f[j].z * rstd * gg.z; y[j].w = xv[j].w + f[j].w * rstd * gg.w;
        if (orow32) *((GAS f32x4*)orow32 + lane + 64 * j) = y[j];
        if (xout) x8[64 * j] = (unsigned long long)pk2(y[j].x, y[j].y) | ((unsigned long long)pk2(y[j].z, y[j].w) << 32); }
    if (gnext) rms_store_bf16(y, gnext, hrow, lane);
    if (rstd_out) { float s2 = 0.f;
#pragma unroll
        for (int j = 0; j < 4; ++j) s2 += (y[j].x * y[j].x + y[j].y * y[j].y) + (y[j].z * y[j].z + y[j].w * y[j].w);
        const float r2 = __builtin_amdgcn_rsqf(wave_sum(s2) * (1.f / D) + RMS_EPS); if (lane == 0) *rstd_out = r2; }
}

constexpr int I_IN = 8 * 10, I_OUT = 8 * 4, I_G = 8 * 14, I_D = 28 * 4, I_E = 2 * I_G + I_D, NIT_DENSE = 2 * I_IN + 2 * I_OUT + 2 * I_G + I_D;
constexpr int EDEF = 5, NIT_P0 = NIT_DENSE + EDEF * I_E, NIT_DEF = (NE - EDEF) * I_E;
__device__ __forceinline__ WItem w_item_of(const Args& a, unsigned char* ws, int it) {
            WItem q; q.gko = -1; q.GU = -1; q.f8 = 0; q.scale = 1.f; int r = it;
            if (r < 2 * I_IN) { const int l = r / I_IN, s = r % I_IN; q.W = a.w_in + (size_t)l * D * INC; q.K = D; q.N = INC; q.WT = (unsigned char*)((bf16*)(ws + WS_WIN) + (size_t)l * INC * D); q.k0 = 128 * (s / 10); q.n0 = 256 * (s % 10); q.gko = l * D; return q; } r -= 2 * I_IN;
            if (r < 2 * I_OUT) { const int l = r / I_OUT, s = r % I_OUT; q.W = a.w_out + (size_t)l * D * D; q.K = D; q.N = D; q.WT = (unsigned char*)((bf16*)(ws + WS_WOUT) + (size_t)l * D * D); q.k0 = 128 * (s / 4); q.n0 = 256 * (s % 4); return q; } r -= 2 * I_OUT;
            if (r < 2 * I_G) { const int up = r / I_G, s = r % I_G; q.W = up ? a.dw_up : a.dw_gate; q.K = D; q.N = FF; q.WT = (unsigned char*)(ws + WS_WGU); q.k0 = 128 * (s / 14); q.n0 = 256 * (s % 14); q.GU = up; q.f8 = 1; q.scale = MOE_WGU_SCALE; return q; } r -= 2 * I_G;
            if (r < I_D) { q.W = a.dw_down; q.K = FF; q.N = D; q.WT = (unsigned char*)(ws + WS_WD); q.k0 = 128 * (r / 4); q.n0 = 256 * (r % 4); q.f8 = 1; q.scale = MOE_WD_SCALE; return q; } r -= I_D;
            const int e = r / (2 * I_G + I_D); r -= e * (2 * I_G + I_D);
            unsigned char* we = (unsigned char*)(ws + WS_MOEW) + (size_t)e * (3 * (size_t)D * FF);
            q.f8 = 1;
            if (r < 2 * I_G) { const int up = r / I_G, s = r % I_G; q.W = (up ? a.mw_up : a.mw_gate) + (size_t)e * D * FF; q.K = D; q.N = FF; q.WT = we; q.k0 = 128 * (s / 14); q.n0 = 256 * (s % 14); q.GU = up; q.scale = MOE_WGU_SCALE; return q; } r -= 2 * I_G;
            q.W = a.mw_down + (size_t)e * FF * D; q.K = FF; q.N = D; q.WT = we + (size_t)2 * D * FF; q.k0 = 128 * (r / 4); q.n0 = 256 * (r % 4); q.scale = MOE_WD_SCALE; return q; }
__device__ __forceinline__ void convert_items(const Args& a, unsigned char* ws, LAS unsigned char* lds, int first, int cnt, int slot, int nslots, int wave, int lane) {
        if (slot < 0 || slot >= cnt) return;
        const int n = (cnt - slot + nslots - 1) / nslots;
        WRegs ra, rb; WItem ia = w_item_of(a, ws, first + slot), ib = ia;
        w_load(ia, ra, wave, lane);
        int k = 0;
        for (;;) {
            if (k + 1 >= n) { w_finish(ia, ra, lds, wave, lane); break; }
            ib = w_item_of(a, ws, first + slot + (k + 1) * nslots); w_load(ib, rb, wave, lane);
            w_finish(ia, ra, lds, wave, lane);
            if (k + 2 >= n) { w_finish(ib, rb, lds, wave, lane); break; }
            ia = w_item_of(a, ws, first + slot + (k + 2) * nslots); w_load(ia, ra, wave, lane);
            w_finish(ib, rb, lds, wave, lane);
            k += 2;
        }
}


#ifndef ONLY
#define PH(n) 1
#else
#define PH(n) (ONLY == (n))
#endif
#define CAS __attribute__((address_space(4)))
__global__ void __launch_bounds__(NWAVES * 64, 2) hymba_fwd(Args a) {
    extern __shared__ __attribute__((aligned(16))) unsigned char lds_raw[];
    Frame F;
    F.lds = (LAS unsigned char*)lds_raw;
    F.G = gridDim.x; { const int bx = blockIdx.x; F.vcu = (F.G % 8 == 0) ? (bx % 8) * (F.G / 8) + bx / 8 : bx; }
    unsigned char* const ws0 = a.ws; size_t wso = 0; unsigned char* ws = ws0;
#define ctl ((gu32*)(ws + WS_CTL))
    volatile LAS unsigned* MISC = (volatile LAS unsigned*)(F.lds + LDSCTL_OFF);
    for (int u = threadIdx.x; u < (LDS_BYTES - LDSCTL_OFF) / 4; u += NWAVES * 64) ((LAS unsigned*)(F.lds + LDSCTL_OFF))[u] = 0u;
    __syncthreads();
    __builtin_amdgcn_s_setreg(1 | (23 << 6) | (0 << 11), 1);
    XcdBarrier bar = xcd_barrier_post((unsigned*)(ctl + CW_BAR), MISC + 8);
#define GRID_BAR() xcd_barrier(bar)
#define FRESH() int tid_ = threadIdx.x; asm volatile("" : "+v"(tid_)); const int lane_ = tid_ & 63, wave_ = __builtin_amdgcn_readfirstlane(tid_ >> 6); \
    int vcu_ = F.vcu, G_ = F.G, bidx_ = blockIdx.x; asm volatile("" : "+s"(vcu_), "+s"(G_), "+s"(bidx_)); const int gw = vcu_ * NWAVES + wave_, NGW = G_ * NWAVES; (void)lane_; (void)gw; (void)NGW; (void)bidx_
#define SUM ((f32x2*)(ws + WS_SUM))
#define ROWTOK ((int*)(ws + WS_ROWTOK))
#define ROWGATE ((float*)(ws + WS_ROWGATE))
#define COST ((float*)(ws + WS_ROPE))
#define SINT ((float*)(ws + WS_ROPE) + (size_t)T * 8)
#define LSE ((float*)(ws + WS_LSE))
#define WFR ((bf16*)(ws + WS_WFR))
#define WIN ((bf16*)(ws + WS_WIN))
#define WOUT ((bf16*)(ws + WS_WOUT))
#define WGU ((bf16*)(ws + WS_WGU))
#define WD ((bf16*)(ws + WS_WD))
#define MOEW ((bf16*)(ws + WS_MOEW))
#define RA ((bf16*)(ws + WS_RA))
#define ZB ((bf16*)(ws + WS_RB))
#define OBR ((bf16*)(ws + WS_RC))
#define QB ZB
#define KB (ZB + (size_t)T * 512)
#define VB (ZB + (size_t)2 * T * 512)
#define UB (ZB + (size_t)3 * T * 512)
#define GB (ZB + (size_t)4 * T * 512)
#define MIXB RA
#define MB VB
#define HLB RA
#define PCB (RA + (size_t)T * 512)
#define ACT ZB
#define ACTM ((bf16*)(ws + WS_ACTM))
#define FSLOT ((bf16*)(ws + WS_FSLOT))
#define RSTDA ((float*)(ws + WS_RSTDA))
#define RSTDF ((float*)(ws + WS_RSTDF))
#define XB ((bf16*)(ws + WS_XB))

#if PH(0)
    {
        FRESH();
        for (int i = tid_; i < 3 * D; i += NWAVES * 64) ((LAS float*)(F.lds + WGAIN_OFF))[i] = (i < 2 * D) ? a.pre_mix_g[i] : a.pre_ffn_g[i - 2 * D];
        __syncthreads();
        convert_items(a, ws, F.lds, 0, NIT_P0, vcu_, G_, wave_, lane_);
        const int gt = vcu_ * (NWAVES * 64) + tid_, NGT = G_ * NWAVES * 64;
        for (int i = gt; i < T * 8; i += NGT) { const int row = i >> 3, f = i & 7;
            const float inv = powf(500000.0f, -(float)f * 0.125f); const float ang = (float)a.pos[row] * inv; float sn, cs; sincosf(ang, &sn, &cs); COST[i] = cs; SINT[i] = sn; }
        for (int i = gt; i < NE * T; i += NGT) ROWTOK[i] = -1;
        for (int i = gt; i < 2 * LW; i += NGT) { const float lm = a.lam[i]; const float sp = (lm > 15.f) ? __expf(-lm) : log1pf(__expf(-lm));
            ((float*)(ws + WS_CCV))[i] = -8.f * sp * 1.4426950408889634f; }
        for (int i = gt; i < 2 * 8 * 16 * 64; i += NGT) {
            const int ln = i & 63, s_ = (i >> 6) & 3, mb = (i >> 8) & 1, gate = (i >> 9) & 1, lg = i >> 10;
            const float* w = (gate ? a.w_igate : a.w_rgate) + (size_t)lg * 64 * 64; const int i0 = 16 * s_ + 8 * (ln >> 5), j = 32 * mb + (ln & 31);
            const float sg = -1.4426950408889634f;
            v4u o; o.x = pk2(sg * w[(i0 + 0) * 64 + j], sg * w[(i0 + 1) * 64 + j]); o.y = pk2(sg * w[(i0 + 2) * 64 + j], sg * w[(i0 + 3) * 64 + j]); o.z = pk2(sg * w[(i0 + 4) * 64 + j], sg * w[(i0 + 5) * 64 + j]); o.w = pk2(sg * w[(i0 + 6) * 64 + j], sg * w[(i0 + 7) * 64 + j]);
            *(GAS v4u*)(WFR + (size_t)i * 8) = o; }
        {
            struct XS { f32x4 v[4]; };
            const float* xin = a.x;
            row_pipe<XS>(gw, NGW, T,
                [&](int m, XS& q) {
#pragma unroll
                    for (int j = 0; j < 4; ++j) q.v[j] = *((const GAS f32x4*)(xin + (size_t)m * D) + lane_ + 64 * j); },
                [&](int m, XS& q) { float s = 0.f;
#pragma unroll
                    for (int j = 0; j < 4; ++j) s += (q.v[j].x * q.v[j].x + q.v[j].y * q.v[j].y) + (q.v[j].z * q.v[j].z + q.v[j].w * q.v[j].w);
                    const float rs = __builtin_amdgcn_rsqf(wave_sum(s) * (1.f / D) + RMS_EPS); if (lane_ == 0) RSTDA[m] = rs;
                    GAS unsigned long long* x8 = (GAS unsigned long long*)(XB + (size_t)m * D) + lane_;
#pragma unroll
                    for (int j = 0; j < 4; ++j) x8[64 * j] = (unsigned long long)pk2(q.v[j].x, q.v[j].y) | ((unsigned long long)pk2(q.v[j].z, q.v[j].w) << 32); });
        }
    }
#endif
    GRID_BAR();

    for (int layer = 0; layer < 2; ++layer) {
        asm volatile("" : "+s"(wso)); ws = ws0 + wso;
#if PH(2)
        {
            FRESH();
            pg8::Gemm g{XB, WIN + (size_t)layer * INC * D, T, INC, D, 0, nullptr}; pg8::StaticOrder S; S.init(T, INC, G_, bidx_);
            pg8::EpiZ E{ZB, (size_t)T * 512, COST, SINT, QSCALE, RSTDA};
            pg8::gemm_phase<pg8::EpiZ, pg8::StaticOrder, false>(F.lds, g, S, E);
        }
#endif
        GRID_BAR();
#if PH(3)
        {
            FRESH();
            lru::LruConst kc; lru::load_const(layer, WFR, a.conv_w, a.conv_b, a.b_rgate, a.b_igate, (const float*)(ws + WS_CCV), kc);
            for (int cu = vcu_; cu < BATCH * 128; cu += G_) { lru::URegs ua; lru::u_load(cu, UB, ua);
                lru::local_unit(cu, layer, kc, ua, GB, SUM, (unsigned*)(ctl + CW_LRU + 64 * (4 * layer + (cu >> 7))), a.lru_out_g, MIXB, F.lds); }
        }
        { FRESH();
          for (int u = vcu_; u < 768; u += G_) { const int bh = u / 24, kq = u % 24;
              if (kq < 8) att::item(bh * 8 + kq, QB, KB, VB, OBR, LSE, F.lds);
              else if (kq < 16) att::item(256 + bh * 8 + (kq - 8), QB, KB, VB, OBR, LSE, F.lds);
              else { att::item(512 + bh * 16 + 2 * (kq - 16), QB, KB, VB, OBR, LSE, F.lds); att::item(513 + bh * 16 + 2 * (kq - 16), QB, KB, VB, OBR, LSE, F.lds); } } }
#endif
        GRID_BAR();
#if PH(4)
        {
            FRESH();
            for (int cu = vcu_; cu < BATCH * 128; cu += G_) attn_combine(cu, layer, OBR, LSE, a.attn_out_g, MIXB);
        }
#endif
        GRID_BAR();
#if PH(5)
        {
            FRESH();
            pg8::Gemm g{MIXB, WOUT + (size_t)layer * D * D, T, D, D, 0, nullptr}; pg8::StaticOrder S; S.init(T, D, G_, bidx_);
            pg8::EpiBf16 E{MB, D};
            pg8::gemm_phase<pg8::EpiBf16, pg8::StaticOrder, false, false, true>(F.lds, g, S, E);
        }
#endif
        GRID_BAR();
#if PH(6)
        {
        FRESH();
        if (layer == 0) {
            struct MX { RawRow m, x; };
            const Gain4 gpost = ld_gain(a.post_mix_g + layer * D, lane_), gpre2 = ld_gain(a.pre_ffn_g + layer * D, lane_);
            row_pipe<MX>(gw, NGW, T,
                [&](int m, MX& q) { ld_raw(MB + (size_t)m * D, q.m, lane_); ld_raw(XB + (size_t)m * D, q.x, lane_); },
                [&](int m, MX& q) { f32x4 hn[4]; post_mix_row(q.m, q.x, XB + (size_t)m * D, gpost, gpre2, nullptr, (unsigned char*)RA + (size_t)m * D, nullptr, hn, lane_); });
        } else {
            LAS float* rt = (LAS float*)F.lds; LAS int* lcnt = (LAS int*)(F.lds + 32768); LAS int* gbase = lcnt + 8; LAS int* lsel = lcnt + 16; LAS float* lprob = (LAS float*)(lcnt + 16 + 4 * 128);
            for (int i = tid_; i < D * NE; i += NWAVES * 64) { const int k = i >> 3, e = i & 7; rt[e * D + k] = a.router_w[i]; }
            if (tid_ < 8) lcnt[tid_] = 0;
            __syncthreads();
            const int rows_per_wg = T / G_;
            for (int rb = 0; rb < rows_per_wg; rb += 128) {
                struct MX { RawRow m, x; };
                const Gain4 gpost = ld_gain(a.post_mix_g + layer * D, lane_), gpre2 = ld_gain(a.pre_ffn_g + layer * D, lane_); const int mbase = vcu_ * rows_per_wg + rb + wave_ * 16;
                row_pipe<MX>(0, 1, 16,
                  [&](int i, MX& q) { const int m = mbase + i; ld_raw(MB + (size_t)m * D, q.m, lane_); ld_raw(XB + (size_t)m * D, q.x, lane_); },
                  [&](int i, MX& q) {
                    const int lr = wave_ * 16 + i; const int m = mbase + i;
                    f32x4 hn[4];
                    post_mix_row(q.m, q.x, XB + (size_t)m * D, gpost, gpre2, nullptr, (unsigned char*)RA + (size_t)m * D, nullptr, hn, lane_);
                    float lg[8];
#pragma unroll
                    for (int e = 0; e < 8; ++e) { float s = 0.f;
#pragma unroll
                        for (int j = 0; j < 4; ++j) { const f32x4 w = *((const LAS f32x4*)(rt + e * D) + lane_ + 64 * j); s += (hn[j].x * w.x + hn[j].y * w.y) + (hn[j].z * w.z + hn[j].w * w.w); }
                        lg[e] = wave_sum(s); }
                    int e1 = 0; float v1 = lg[0];
#pragma unroll
                    for (int e = 1; e < 8; ++e) if (lg[e] > v1) { v1 = lg[e]; e1 = e; }
                    int e2 = -1; float v2 = -3.0e38f;
#pragma unroll
                    for (int e = 0; e < 8; ++e) if (e != e1 && lg[e] > v2) { v2 = lg[e]; e2 = e; }
                    if (lane_ == 0) { const float p2 = __builtin_amdgcn_rcpf(1.f + __builtin_amdgcn_exp2f(1.4426950408889634f * (v1 - v2))); const float p1 = 1.f - p2;
                        const int r1 = __hip_atomic_fetch_add(&lcnt[e1], 1, __ATOMIC_RELAXED, __HIP_MEMORY_SCOPE_WORKGROUP), r2 = __hip_atomic_fetch_add(&lcnt[e2], 1, __ATOMIC_RELAXED, __HIP_MEMORY_SCOPE_WORKGROUP);
                        lsel[lr * 4 + 0] = e1; lsel[lr * 4 + 1] = e2; lsel[lr * 4 + 2] = r1; lsel[lr * 4 + 3] = r2; lprob[lr * 2 + 0] = p1; lprob[lr * 2 + 1] = p2; }
                  });
                __syncthreads();
                if (tid_ < 8) { gbase[tid_] = (int)__hip_atomic_fetch_add(ctl + CW_CNT + 64 * tid_, (unsigned)lcnt[tid_], RLX_AGENT); }
                __syncthreads();
                if (tid_ < 128) { const int m = vcu_ * rows_per_wg + rb + tid_; const int e1 = lsel[tid_ * 4 + 0], e2 = lsel[tid_ * 4 + 1];
                    const int s1 = e1 * T + gbase[e1] + lsel[tid_ * 4 + 2], s2 = e2 * T + gbase[e2] + lsel[tid_ * 4 + 3];
                    ROWTOK[s1] = 2 * m; ROWGATE[s1] = lprob[tid_ * 2]; ROWTOK[s2] = 2 * m + 1; ROWGATE[s2] = lprob[tid_ * 2 + 1]; }
                __syncthreads();
                if (tid_ < 8) lcnt[tid_] = 0;
                __syncthreads();
            }
        }
        }
#endif
        GRID_BAR();
        if (layer == 0) {
#if PH(7)
            {
                FRESH();
                pg8::Gemm g{RA, WGU, T, 2 * FF, D / 2, 0, nullptr}; pg8::StaticOrder S; S.init(T, 2 * FF, G_, bidx_);
                pg8::EpiSwigluF8 E{(unsigned char*)ACT, FF, 1.f / MOE_WGU_SCALE, MOE_ACT_SCALE};
                pg8::gemm_phase<pg8::EpiSwigluF8, pg8::StaticOrder, false, true, true>(F.lds, g, S, E);
            }
#endif
            GRID_BAR();
#if PH(8)
            {
                FRESH();
                pg8::Gemm g{ACT, WD, T, D, FF / 2, 0, nullptr}; pg8::StaticOrder S; S.init(T, D, G_, bidx_);
                pg8::EpiBf16 E{RA, D, 1.f / (MOE_WD_SCALE * MOE_ACT_SCALE)};
                pg8::gemm_phase<pg8::EpiBf16, pg8::StaticOrder, false, true, true>(F.lds, g, S, E);
            }
#endif
            GRID_BAR();
            { FRESH();
            struct FX { RawRow f, x; };
            const Gain4 gpost = ld_gain(a.post_ffn_g + layer * D, lane_);
            row_pipe<FX>(gw, NGW, T,
                [&](int m, FX& q) { ld_raw(RA + (size_t)m * D, q.f, lane_); ld_raw(XB + (size_t)m * D, q.x, lane_); },
                [&](int m, FX& q) { f32x4 f[4]; unpack_raw(q.f, f); post_ffn_row(f, q.x, XB + (size_t)m * D, nullptr, gpost, nullptr, nullptr, RSTDA + m, lane_); }); }
            GRID_BAR();
        } else {
            int ps[9]; ps[0] = 0;
#pragma unroll
            for (int e = 0; e < 8; ++e) { const int c = __builtin_amdgcn_readfirstlane((int)__hip_atomic_load(ctl + CW_CNT + 64 * e, RLX_AGENT)); ps[e + 1] = ps[e] + ((c + 255) >> 8); }
            const int P = ps[8];
            bool first = true;
            for (int p0 = 0; p0 < P || first; ) {
                int np = (P - p0) < CHPAN ? (P - p0) : CHPAN;
                if (first) { if (P > 128 && P - 128 < np) np = P - 128;
                             if (ps[EDEF] < np) np = ps[EDEF]; }
#if PH(10)
                {   FRESH();
                    pg8::Gemm g{RA, MOEW, T, 2 * FF, D / 2, (size_t)3 * D * FF, ROWTOK};
                    pg8::MoeOrder S{p0, np, 2 * FF / 256, np * (2 * FF / 256), G_, bidx_, T, ps[1], ps[2], ps[3], ps[4], ps[5], ps[6], ps[7]};
                    pg8::EpiSwigluF8 E{(unsigned char*)ACTM, FF, 1.f / MOE_WGU_SCALE, MOE_ACT_SCALE};
                    pg8::gemm_phase<pg8::EpiSwigluF8, pg8::MoeOrder, true, true, true>(F.lds, g, S, E);
                }
#endif
                const int Gn = F.G; const int tailg = (np * (2 * FF / 256)) % Gn; const int n1 = (first && tailg > 0) ? ((Gn - tailg) < NIT_DEF ? (Gn - tailg) : NIT_DEF) : 0;
                if (first) { FRESH(); const int it = bidx_ - tailg;
                    if (it >= 0 && it < n1) { WRegs r1; const WItem q = w_item_of(a, ws, NIT_P0 + it); w_load(q, r1, wave_, lane_); w_finish(q, r1, F.lds, wave_, lane_); } }
                GRID_BAR();
#if PH(11)
                {   FRESH();
                    pg8::Gemm g{ACTM, MOEW + (size_t)D * FF, np * 256, D, FF / 2, (size_t)3 * D * FF, nullptr};
                    pg8::MoeOrder S{p0, np, D / 256, np * (D / 256), G_, bidx_, T, ps[1], ps[2], ps[3], ps[4], ps[5], ps[6], ps[7]};
                    pg8::EpiMoeDown E{FSLOT, (size_t)T * D, ROWTOK, ROWGATE, 1.f / (MOE_WD_SCALE * MOE_ACT_SCALE)};
                    pg8::gemm_phase<pg8::EpiMoeDown, pg8::MoeOrder, false, true, true>(F.lds, g, S, E);
                }
#endif
                if (first) {
                    FRESH();
                    const int tail = (np * (D / 256)) % G_;
                    { const int slot = bidx_ - tail, nslots = G_ - tail;
                      if (slot >= 0) for (int it = n1 + slot; it < NIT_DEF; it += nslots) { WRegs r1; const WItem q = w_item_of(a, ws, NIT_P0 + it); w_load(q, r1, wave_, lane_); w_finish(q, r1, F.lds, wave_, lane_); } }
                }
                GRID_BAR();
                p0 += np; first = false;
            }
            { FRESH();
            struct FFX { RawRow f0, f1, x; };
            const Gain4 gpost = ld_gain(a.post_ffn_g + layer * D, lane_); float* outp = a.out;
            row_pipe<FFX>(gw, NGW, T,
                [&](int m, FFX& q) { ld_raw(FSLOT + (size_t)m * D, q.f0, lane_); ld_raw(FSLOT + (size_t)T * D + (size_t)m * D, q.f1, lane_); ld_raw(XB + (size_t)m * D, q.x, lane_); },
                [&](int m, FFX& q) { f32x4 f0[4], f1[4]; unpack_raw(q.f0, f0); unpack_raw(q.f1, f1);
#pragma unroll
                    for (int j = 0; j < 4; ++j) f0[j] = f0[j] + f1[j];
                    post_ffn_row(f0, q.x, nullptr, outp + (size_t)m * D, gpost, nullptr, nullptr, nullptr, lane_); }); }
        }
    }
#undef GRID_BAR
#undef FRESH
#undef ctl
}

extern "C" void kernel_launch(void* const* d_in, const int* in_sizes, int n_in, void* d_out, int out_size, void* d_ws, size_t ws_size, hipStream_t stream) {
    static int grid = 0;
    if (grid == 0) {
        if (n_in != 24 || in_sizes[0] != T * D || out_size != T * D || ws_size < WS_END) { fprintf(stderr, "kernel_launch: unexpected shapes / workspace (n_in %d, ws %zu, need %zu); nothing launched\n", n_in, ws_size, (size_t)WS_END); grid = -1; return; }
        int dev = 0, cus = 0, per_cu = 0;
        if (hipGetDevice(&dev) != hipSuccess || hipDeviceGetAttribute(&cus, hipDeviceAttributeMultiprocessorCount, dev) != hipSuccess) { grid = -1; return; }
        if (hipFuncSetAttribute((const void*)hymba_fwd, hipFuncAttributeMaxDynamicSharedMemorySize, LDS_BYTES) != hipSuccess) { fprintf(stderr, "kernel_launch: hipFuncSetAttribute failed\n"); grid = -1; return; }
        if (hipOccupancyMaxActiveBlocksPerMultiprocessor(&per_cu, (const void*)hymba_fwd, NWAVES * 64, LDS_BYTES) != hipSuccess || per_cu < 1) { fprintf(stderr, "kernel_launch: occupancy query says %d\n", per_cu); }
        (void)hipGetLastError();
        grid = cus;
    }
    if (grid < 0) return;
    if (hipMemsetAsync((char*)d_ws + WS_CTL, 0, CTL_ZERO_BYTES, stream) != hipSuccess) return;
    Args a{};
    a.x = (const float*)d_in[0]; a.pos = (const int*)d_in[1]; a.pre_mix_g = (const float*)d_in[2]; a.w_in = (const float*)d_in[3]; a.conv_w = (const float*)d_in[4]; a.conv_b = (const float*)d_in[5];
    a.w_rgate = (const float*)d_in[6]; a.b_rgate = (const float*)d_in[7]; a.w_igate = (const float*)d_in[8]; a.b_igate = (const float*)d_in[9]; a.lam = (const float*)d_in[10];
    a.attn_out_g = (const float*)d_in[11]; a.lru_out_g = (const float*)d_in[12]; a.w_out = (const float*)d_in[13]; a.post_mix_g = (const float*)d_in[14]; a.pre_ffn_g = (const float*)d_in[15]; a.post_ffn_g = (const float*)d_in[16];
    a.dw_gate = (const float*)d_in[17]; a.dw_up = (const float*)d_in[18]; a.dw_down = (const float*)d_in[19]; a.router_w = (const float*)d_in[20]; a.mw_gate = (const float*)d_in[21]; a.mw_up = (const float*)d_in[22]; a.mw_down = (const float*)d_in[23];
    a.out = (float*)d_out; a.ws = (unsigned char*)d_ws;
    hipLaunchKernelGGL(hymba_fwd, dim3(grid), dim3(NWAVES * 64), LDS_BYTES, stream, a);
}
```
